# Optimizing an MI355X kernel written in HIP

```python
import math
import jax, jax.numpy as jnp
from jax import lax
import numpy as np

D_MODEL = 1024
BATCH = 8
SEQ = 2048
DEPTH = 4

MEM_LEN = 256
N_MIXERS = 2
N_CONV_LAYERS = (DEPTH + 1) // 2
N_POOL_LAYERS = DEPTH // 2
N_XHEADS = 4
XHEAD_DIM = D_MODEL // N_XHEADS
D_FF = 4 * D_MODEL
CONV_WIDTH = 31
POOL_WINDOWS = (2, 4, 8, 16)
N_POOL_GROUPS = len(POOL_WINDOWS)
POOL_GROUP_DIM = D_MODEL // N_POOL_GROUPS
RMS_EPS = 1e-6
LN_EPS = 1e-5

kernel_name = "hybrid_conv_pool_memxattn_trunk"


def rmsnorm(x, g):
    xf = x.astype(jnp.float32)
    y = xf * lax.rsqrt(jnp.mean(xf * xf, axis=-1, keepdims=True) + RMS_EPS)
    return (y * g.astype(jnp.float32)).astype(x.dtype)


def layernorm(x, g, b):
    xf = x.astype(jnp.float32)
    mu = jnp.mean(xf, axis=-1, keepdims=True)
    var = jnp.mean(jnp.square(xf - mu), axis=-1, keepdims=True)
    y = (xf - mu) * lax.rsqrt(var + LN_EPS)
    return (y * g.astype(jnp.float32) + b.astype(jnp.float32)).astype(x.dtype)


def conv_mixer(h, w_in, b_in, w_dw, b_dw, ln_g, ln_b, w_out, b_out):
    u = h @ w_in + b_in
    a, gate = jnp.split(u, 2, axis=-1)
    u = a * jax.nn.sigmoid(gate)
    u = lax.conv_general_dilated(
        u, w_dw[:, None, :].astype(u.dtype),
        window_strides=(1,), padding=[(CONV_WIDTH - 1, 0)],
        dimension_numbers=("NWC", "WIO", "NWC"),
        feature_group_count=D_MODEL) + b_dw
    u = jax.nn.silu(layernorm(u, ln_g, ln_b))
    return u @ w_out + b_out


def pool_mixer(h, w_pool, scale):
    B, S, D = h.shape
    hf = h.astype(jnp.float32)
    cs = jnp.cumsum(hf, axis=1)
    count = jnp.arange(1, S + 1, dtype=jnp.float32)
    groups = []
    for g, w in enumerate(POOL_WINDOWS):
        sl = slice(g * POOL_GROUP_DIM, (g + 1) * POOL_GROUP_DIM)
        c = cs[..., sl]
        lagged = jnp.pad(c, ((0, 0), (w, 0), (0, 0)))[:, :S]
        mean = (c - lagged) / jnp.minimum(count, float(w))[None, :, None]
        groups.append(mean - hf[..., sl])
    p = jnp.stack(groups, axis=2).astype(h.dtype)
    y = jnp.einsum("bsgc,gcd->bsgd", p, w_pool).reshape(B, S, D)
    return y * scale


def mem_cross_attn(h, memn, wq, wk, wv, wo):
    B, S, D = h.shape
    q = (h @ wq).reshape(B, S, N_XHEADS, XHEAD_DIM)
    k = (memn @ wk).reshape(B, MEM_LEN, N_XHEADS, XHEAD_DIM)
    v = (memn @ wv).reshape(B, MEM_LEN, N_XHEADS, XHEAD_DIM)
    s = jnp.einsum("bshd,bmhd->bhsm", q, k).astype(jnp.float32) * (1.0 / math.sqrt(XHEAD_DIM))
    p = jax.nn.softmax(s, axis=-1).astype(v.dtype)
    o = jnp.einsum("bhsm,bmhd->bshd", p, v).reshape(B, S, D)
    return o @ wo


def sqrelu_mlp(h, w1, w2):
    return jnp.square(jax.nn.relu(h @ w1)) @ w2


def setup_inputs(seed: int = 0) -> dict:
    key = jax.random.key(seed)
    ks = jax.random.split(key, 24)
    D = D_MODEL
    nrm = lambda k, shape, fan_in: jax.random.normal(k, shape, jnp.float32) * (fan_in ** -0.5)
    gain = lambda k, shape: 1.0 + 0.05 * jax.random.normal(k, shape, jnp.float32)
    small = lambda k, shape: 0.02 * jax.random.normal(k, shape, jnp.float32)
    return {
        "x": jax.random.normal(ks[0], (BATCH, SEQ, D), jnp.float32),
        "mem": jax.random.normal(ks[1], (BATCH, MEM_LEN, D), jnp.float32),
        "mem_norm": gain(ks[2], (D,)),
        "norm_mix": gain(ks[3], (DEPTH, D)),
        "norm_xattn": gain(ks[4], (DEPTH, D)),
        "norm_mlp": gain(ks[5], (DEPTH, D)),
        "conv_w_in": nrm(ks[6], (N_CONV_LAYERS, D, 2 * D), D),
        "conv_b_in": small(ks[7], (N_CONV_LAYERS, 2 * D)),
        "conv_w_dw": nrm(ks[8], (N_CONV_LAYERS, CONV_WIDTH, D), CONV_WIDTH),
        "conv_b_dw": small(ks[9], (N_CONV_LAYERS, D)),
        "conv_ln_g": gain(ks[10], (N_CONV_LAYERS, D)),
        "conv_ln_b": small(ks[11], (N_CONV_LAYERS, D)),
        "conv_w_out": nrm(ks[12], (N_CONV_LAYERS, D, D), D),
        "conv_b_out": small(ks[13], (N_CONV_LAYERS, D)),
        "pool_w": nrm(ks[14], (N_POOL_LAYERS, N_POOL_GROUPS, POOL_GROUP_DIM, POOL_GROUP_DIM), POOL_GROUP_DIM),
        "pool_scale": gain(ks[15], (N_POOL_LAYERS, D)),
        "xattn_wq": nrm(ks[16], (DEPTH, D, D), D),
        "xattn_wk": nrm(ks[17], (DEPTH, D, D), D),
        "xattn_wv": nrm(ks[18], (DEPTH, D, D), D),
        "xattn_wo": nrm(ks[19], (DEPTH, D, D), D),
        "mlp_w1": nrm(ks[20], (DEPTH, D, D_FF), D),
        "mlp_w2": nrm(ks[21], (DEPTH, D_FF, D), D_FF),
        "final_norm": gain(ks[22], (D,)),
    }


def reference(x, mem, mem_norm, norm_mix, norm_xattn, norm_mlp,
              conv_w_in, conv_b_in, conv_w_dw, conv_b_dw, conv_ln_g, conv_ln_b,
              conv_w_out, conv_b_out, pool_w, pool_scale,
              xattn_wq, xattn_wk, xattn_wv, xattn_wo, mlp_w1, mlp_w2, final_norm):
    memn = rmsnorm(mem, mem_norm)
    for i in range(DEPTH):
        j = i // N_MIXERS
        h = rmsnorm(x, norm_mix[i])
        if i % N_MIXERS == 0:
            x = x + conv_mixer(h, conv_w_in[j], conv_b_in[j], conv_w_dw[j], conv_b_dw[j],
                               conv_ln_g[j], conv_ln_b[j], conv_w_out[j], conv_b_out[j])
        else:
            x = x + pool_mixer(h, pool_w[j], pool_scale[j])
        x = x + mem_cross_attn(rmsnorm(x, norm_xattn[i]), memn,
                               xattn_wq[i], xattn_wk[i], xattn_wv[i], xattn_wo[i])
        x = x + sqrelu_mlp(rmsnorm(x, norm_mlp[i]), mlp_w1[i], mlp_w2[i])
    return rmsnorm(x, final_norm)
```

```cpp
#include <hip/hip_runtime.h>
#include <hip/hip_cooperative_groups.h>
#include <cstdio>
#include <cstdint>
namespace cg = cooperative_groups;

#ifndef MK_PER_PHASE
#define MK_PER_PHASE 0
#endif

#ifndef LAST_PH
#define LAST_PH 99
#endif
#define LAS __attribute__((address_space(3)))
typedef unsigned short bf16_t;
typedef short bf16x8 __attribute__((ext_vector_type(8)));
typedef float f32x4 __attribute__((ext_vector_type(4)));
typedef float f32x2 __attribute__((ext_vector_type(2)));
typedef unsigned u32x4 __attribute__((ext_vector_type(4)));
typedef unsigned u32x2 __attribute__((ext_vector_type(2)));

constexpr int D = 1024, NB = 8, SEQ = 2048, M = NB * SEQ, FF = 4096, MEML = 256, MEMR = NB * MEML, CW = 31;
constexpr float RMS_EPS = 1e-6f, LN_EPS = 1e-5f;
constexpr float LOG2E = 1.4426950408889634f;
typedef unsigned long long u64;
constexpr float SSQ_SCALE = 1048576.0f, SSQ_INV = 1.0f / (1048576.0f * 1024.0f);
__device__ __forceinline__ float rstd_of(u64 q) { return rsqrtf((float)q * SSQ_INV + 1e-6f); }

constexpr size_t MiB = 1u << 20;
constexpr size_t WS_SSQ = 0;
constexpr size_t WS_BAR = 2 * MiB - 32768;
constexpr size_t WS_LW = 2 * MiB;
constexpr size_t LW_SET = 26 * MiB;
constexpr size_t LW_WIN = 0, LW_WOUT = 4 * MiB, LW_WQ = 6 * MiB, LW_WO = 8 * MiB, LW_W1 = 10 * MiB, LW_W2 = 18 * MiB;
constexpr size_t WS_XB = WS_LW + 2 * LW_SET;
constexpr size_t WS_KALL = WS_XB + 32 * MiB;
constexpr size_t WS_VT = WS_KALL + 16 * MiB;
constexpr size_t WS_H = WS_VT + 16 * MiB;
constexpr size_t WS_S0 = WS_H, WS_S1 = WS_H + 32 * MiB, WS_S2 = WS_H + 64 * MiB, WS_S3 = WS_H + 96 * MiB;
constexpr size_t WS_WKT = WS_S3, WS_WVT = WS_S3 + 8 * MiB, WS_MEMN = WS_S3 + 16 * MiB;
constexpr size_t WS_END = WS_H + 128 * MiB;

constexpr int RING_BYTES = 131072, EX_OFF = RING_BYTES, BARST_OFF = RING_BYTES + 8192, PTAB_OFF = BARST_OFF + 64, LDS_BYTES = RING_BYTES + 8192 + 2048;

__device__ __forceinline__ unsigned cvt_pk_bf16(float lo, float hi) { unsigned r; asm volatile("v_cvt_pk_bf16_f32 %0, %1, %2" : "=v"(r) : "v"(lo), "v"(hi)); return r; }
__device__ __forceinline__ float shx(float v, int lane, int o) { return __int_as_float(__builtin_amdgcn_ds_bpermute((lane ^ o) << 2, __float_as_int(v))); }
__device__ __forceinline__ float wave_sum(float v, int lane) {
#pragma unroll
    for (int o = 1; o < 64; o <<= 1) v += shx(v, lane, o);
    return v;
}
__device__ __forceinline__ float bf_lo(unsigned u) { return __uint_as_float(u << 16); }
__device__ __forceinline__ float bf_hi(unsigned u) { return __uint_as_float(u & 0xffff0000u); }

namespace pg8 {
constexpr int BM = 256, BK = 64, HALF = 128, HTB = HALF * BK * 2, STAGE_BYTES = 8 * HTB, NXCD = 8, WGM = 8;
__host__ __device__ __forceinline__ int lds_byte(int r, int c) { const int st = (r >> 4) * 2 + (c >> 5), rr = r & 15, cc = c & 31, ob = rr * 64 + cc * 2; return st * 1024 + (ob ^ (((ob >> 9) & 1) << 5)); }
__host__ __device__ __forceinline__ void stage_rc(int b, int& R, int& C) { const int st = b / 1024, sb = b % 1024, swz = sb ^ (((sb >> 9) & 1) << 5); R = (st >> 1) * 16 + swz / 64; C = (st & 1) * 32 + (swz % 64) / 2; }
__host__ __device__ __forceinline__ int perm32(int rho) { const int n = rho >> 4, i = rho & 15; return 8 * (i >> 2) + 4 * n + (i & 3); }

struct Unit { int pm, pn; };
struct Gemm { const bf16_t* A; const bf16_t* Bt; int lda, ldb, K; long a_pm, a_pn, b_pn, b_b; };

struct Order {
    int nM, nN, nwg, G, c;
    __device__ __forceinline__ void init(int nM_, int nN_, int G_, int c_) { nM = nM_; nN = nN_; nwg = nM * nN; G = G_; c = c_; }
    __device__ __forceinline__ bool next(int i, Unit& u) const {
        const long L = (long)i * G + c; if (L >= nwg) return false;
        int wgid = (int)L; { const int q = nwg / NXCD, r = nwg % NXCD, xcd = wgid % NXCD, off = wgid / NXCD; wgid = (xcd < r ? xcd * (q + 1) : r * (q + 1) + (xcd - r) * q) + off; }
        const int nig = WGM * nN, gid = wgid / nig, fm = gid * WGM, gsz = (nM - fm) < WGM ? (nM - fm) : WGM;
        u.pm = fm + ((wgid % nig) % gsz); u.pn = (wgid % nig) / gsz; return true;
    }
};


struct EpiBf {
    bf16_t* O; int ldc; const u64* ssq; float cs; int act;
    __device__ __forceinline__ void operator()(f32x4 (&acc)[2][2][4][2], const Unit& u, int wid, int lane_) const {
        int lane = lane_; asm volatile("" : "+v"(lane));
        const int wr = wid >> 2, wc = wid & 3, fr = lane & 15, fq = lane >> 4;
        const int row0 = u.pm * BM + wr * 64 + fr, col0 = u.pn * BM + wc * 32 + 8 * fq;
#pragma unroll
        for (int ai = 0; ai < 2; ++ai)
#pragma unroll
            for (int m = 0; m < 4; ++m) {
                const int r = row0 + ai * HALF + m * 16;
                float rs = cs; if (ssq) rs *= rstd_of(ssq[r]);
                bf16_t* rowp = O + (size_t)r * ldc + col0;
#pragma unroll
                for (int bj = 0; bj < 2; ++bj) {
                    f32x4 v0 = acc[ai][bj][m][0] * rs, v1 = acc[ai][bj][m][1] * rs;
                    if (act) {
#pragma unroll
                        for (int j = 0; j < 4; ++j) { const float a = fmaxf(v0[j], 0.f), b = fmaxf(v1[j], 0.f); v0[j] = a * a; v1[j] = b * b; }
                    }
                    u32x4 w; w.x = cvt_pk_bf16(v0[0], v0[1]); w.y = cvt_pk_bf16(v0[2], v0[3]); w.z = cvt_pk_bf16(v1[0], v1[1]); w.w = cvt_pk_bf16(v1[2], v1[3]);
                    *(u32x4*)(rowp + bj * HALF) = w;
                }
            }
    }
};
struct EpiGlu {
    bf16_t* O; const float* bias; const u64* ssq;
    __device__ __forceinline__ void operator()(f32x4 (&acc)[2][2][4][2], const Unit& u, int wid, int lane_) const {
        int lane = lane_; asm volatile("" : "+v"(lane));
        const int wr = wid >> 2, wc = wid & 3, fr = lane & 15, fq = lane >> 4;
        const int row0 = u.pm * BM + wr * 64 + fr, ch0 = u.pn * HALF + wc * 32 + 8 * fq;
        f32x4 ba[2], bg[2];
#pragma unroll
        for (int n = 0; n < 2; ++n) { ba[n] = *(const f32x4*)(bias + ch0 + 4 * n); bg[n] = *(const f32x4*)(bias + D + ch0 + 4 * n); }
#pragma unroll
        for (int ai = 0; ai < 2; ++ai)
#pragma unroll
            for (int m = 0; m < 4; ++m) {
                const int r = row0 + ai * HALF + m * 16;
                const float rs = rstd_of(ssq[r]);
                f32x4 o[2];
#pragma unroll
                for (int n = 0; n < 2; ++n) {
                    const f32x4 a = acc[ai][0][m][n] * rs + ba[n], g = acc[ai][1][m][n] * rs + bg[n];
#pragma unroll
                    for (int j = 0; j < 4; ++j) o[n][j] = a[j] * __builtin_amdgcn_rcpf(1.0f + __builtin_amdgcn_exp2f(-g[j] * LOG2E));
                }
                u32x4 w; w.x = cvt_pk_bf16(o[0][0], o[0][1]); w.y = cvt_pk_bf16(o[0][2], o[0][3]); w.z = cvt_pk_bf16(o[1][0], o[1][1]); w.w = cvt_pk_bf16(o[1][2], o[1][3]);
                *(u32x4*)(O + (size_t)r * D + ch0) = w;
            }
    }
};
struct EpiRes {
    bf16_t* xb; const float* bias; u64* ssq_next;
    __device__ __forceinline__ void operator()(f32x4 (&acc)[2][2][4][2], const Unit& u, int wid, int lane_) const {
        int lane = lane_; asm volatile("" : "+v"(lane));
        const int wr = wid >> 2, wc = wid & 3, fr = lane & 15, fq = lane >> 4;
        const int row0 = u.pm * BM + wr * 64 + fr, col0 = u.pn * BM + wc * 32 + 8 * fq;
        f32x4 bv[2][2];
#pragma unroll
        for (int bj = 0; bj < 2; ++bj)
#pragma unroll
            for (int n = 0; n < 2; ++n) bv[bj][n] = bias ? *(const f32x4*)(bias + col0 + bj * HALF + 4 * n) : (f32x4){0.f, 0.f, 0.f, 0.f};
#pragma unroll
        for (int ai = 0; ai < 2; ++ai)
#pragma unroll
            for (int m = 0; m < 4; ++m) {
                const int r = row0 + ai * HALF + m * 16; const size_t off = (size_t)r * D + col0;
                float ss = 0.f;
#pragma unroll
                for (int bj = 0; bj < 2; ++bj) {
                    const u32x4 xo = *(const u32x4*)(xb + off + bj * HALF);
                    f32x4 x0 = (f32x4){bf_lo(xo.x), bf_hi(xo.x), bf_lo(xo.y), bf_hi(xo.y)}, x1 = (f32x4){bf_lo(xo.z), bf_hi(xo.z), bf_lo(xo.w), bf_hi(xo.w)};
                    x0 += acc[ai][bj][m][0] + bv[bj][0]; x1 += acc[ai][bj][m][1] + bv[bj][1];
                    u32x4 w; w.x = cvt_pk_bf16(x0[0], x0[1]); w.y = cvt_pk_bf16(x0[2], x0[3]); w.z = cvt_pk_bf16(x1[0], x1[1]); w.w = cvt_pk_bf16(x1[2], x1[3]);
                    *(u32x4*)(xb + off + bj * HALF) = w;
                    x0 = (f32x4){bf_lo(w.x), bf_hi(w.x), bf_lo(w.y), bf_hi(w.y)}; x1 = (f32x4){bf_lo(w.z), bf_hi(w.z), bf_lo(w.w), bf_hi(w.w)};
                    ss += (x0[0] * x0[0] + x0[1] * x0[1]) + (x0[2] * x0[2] + x0[3] * x0[3]) + (x1[0] * x1[0] + x1[1] * x1[1]) + (x1[2] * x1[2] + x1[3] * x1[3]);
                }
                ss += shx(ss, lane, 16); ss += shx(ss, lane, 32);
                if (fq == 0) __hip_atomic_fetch_add(ssq_next + r, (u64)(ss * SSQ_SCALE), __ATOMIC_RELAXED, __HIP_MEMORY_SCOPE_AGENT);
            }
    }
};
struct EpiSoftmax {
    bf16_t* P; LAS f32x2* ex;
    __device__ __forceinline__ void operator()(f32x4 (&acc)[2][2][4][2], const Unit& u, int wid, int lane_) const {
        int lane = lane_; asm volatile("" : "+v"(lane));
        const int wr = wid >> 2, wc = wid & 3, fr = lane & 15, fq = lane >> 4;
        const int row0 = u.pm * BM + wr * 64 + fr, col0 = u.pn * BM + wc * 32 + 8 * fq;
        float mxs[2][4];
#pragma unroll
        for (int ai = 0; ai < 2; ++ai)
#pragma unroll
            for (int m = 0; m < 4; ++m) {
                float mx = -3.0e38f;
#pragma unroll
                for (int bj = 0; bj < 2; ++bj)
#pragma unroll
                    for (int n = 0; n < 2; ++n) { const f32x4 v = acc[ai][bj][m][n]; mx = fmaxf(mx, fmaxf(fmaxf(v[0], v[1]), fmaxf(v[2], v[3]))); }
                mx = fmaxf(mx, shx(mx, lane, 16)); mx = fmaxf(mx, shx(mx, lane, 32));
                float l = 0.f;
#pragma unroll
                for (int bj = 0; bj < 2; ++bj)
#pragma unroll
                    for (int n = 0; n < 2; ++n) { f32x4 v = acc[ai][bj][m][n];
#pragma unroll
                        for (int j = 0; j < 4; ++j) { v[j] = __builtin_amdgcn_exp2f((v[j] - mx) * LOG2E); l += v[j]; }
                        acc[ai][bj][m][n] = v; }
                l += shx(l, lane, 16); l += shx(l, lane, 32);
                mxs[ai][m] = mx;
                if (fq == 0) ex[(ai * HALF + wr * 64 + m * 16 + fr) * 4 + wc] = (f32x2){mx, l};
            }
        asm volatile("s_waitcnt lgkmcnt(0)" ::: "memory"); __builtin_amdgcn_s_barrier(); asm volatile("" ::: "memory");
#pragma unroll
        for (int ai = 0; ai < 2; ++ai)
#pragma unroll
            for (int m = 0; m < 4; ++m) {
                const int lr = ai * HALF + wr * 64 + m * 16 + fr;
                const f32x2 a = ex[lr * 4 + 0], b = ex[lr * 4 + 1], c = ex[lr * 4 + 2], d = ex[lr * 4 + 3];
                const float MX = fmaxf(fmaxf(a.x, b.x), fmaxf(c.x, d.x));
                const float L = a.y * __builtin_amdgcn_exp2f((a.x - MX) * LOG2E) + b.y * __builtin_amdgcn_exp2f((b.x - MX) * LOG2E)
                              + c.y * __builtin_amdgcn_exp2f((c.x - MX) * LOG2E) + d.y * __builtin_amdgcn_exp2f((d.x - MX) * LOG2E);
                const float f = __builtin_amdgcn_exp2f((mxs[ai][m] - MX) * LOG2E) / L;
                bf16_t* rowp = P + (size_t)(row0 + ai * HALF + m * 16) * D + col0;
#pragma unroll
                for (int bj = 0; bj < 2; ++bj) {
                    const f32x4 v0 = acc[ai][bj][m][0] * f, v1 = acc[ai][bj][m][1] * f;
                    u32x4 w; w.x = cvt_pk_bf16(v0[0], v0[1]); w.y = cvt_pk_bf16(v0[2], v0[3]); w.z = cvt_pk_bf16(v1[0], v1[1]); w.w = cvt_pk_bf16(v1[2], v1[3]);
                    *(u32x4*)(rowp + bj * HALF) = w;
                }
            }
        asm volatile("s_waitcnt lgkmcnt(0)" ::: "memory"); __builtin_amdgcn_s_barrier(); asm volatile("" ::: "memory");
    }
};

__device__ __forceinline__ void glds_s(const char* sbase, unsigned voff, unsigned lds_dst) {
    asm volatile("s_mov_b32 m0, %2\n\ts_nop 0\n\tglobal_load_lds_dwordx4 %0, %1" :: "v"(voff), "s"(sbase), "s"(lds_dst) : "memory", "m0");
}
template <class Epi, bool ALIGN_EPI>
__device__ __forceinline__ void gemm_phase(LAS unsigned char* lds, const Gemm g, const Order& S, const Epi& E, const int tid) {
    const int wid = __builtin_amdgcn_readfirstlane(tid >> 6), lane = tid & 63, wr = wid >> 2, wc = wid & 3, fr = lane & 15, fq = lane >> 4;
    const int nt = g.K / BK;
    unsigned voffA[2], voffB[2];
#pragma unroll
    for (int i = 0; i < 2; ++i) { int R, C; stage_rc(tid * 16 + i * 8192, R, C); const int Rb = (R & ~31) + perm32(R & 31);
        voffA[i] = (unsigned)(R * g.lda + C) * 2u; voffB[i] = (unsigned)(Rb * g.ldb + C) * 2u; }
    const size_t kstep = (size_t)(BK * 2);
    const size_t hstepA = (size_t)HALF * g.lda * 2, hstepB = (size_t)HALF * g.ldb * 2;
    const unsigned ldsbase = (unsigned)(size_t)lds + (unsigned)wid * 1024u;
    const int aoff = lds_byte(wr * 64 + fr, fq * 8), boff = lds_byte(wc * 32 + fr, fq * 8);
#define PG8_SA(b, h) (((b) * 2 + (h)) * HTB)
#define PG8_SB(b, h) ((4 + (b) * 2 + (h)) * HTB)
#define PG8_STAGE(bufoff, gbase, voff) do { _Pragma("unroll") for (int _i = 0; _i < 2; ++_i) \
        glds_s((const char*)(gbase), (voff)[_i], ldsbase + (unsigned)((bufoff) + _i * 8192)); } while (0)
#define PG8_LDA(dst, b, h) do { _Pragma("unroll") for (int m = 0; m < 4; ++m) _Pragma("unroll") for (int k = 0; k < 2; ++k) dst[m][k] = *(const LAS bf16x8*)(lds + PG8_SA(b, h) + aoff + m * 2048 + k * 1024); } while (0)
#define PG8_LDB(dst, b, h) do { _Pragma("unroll") for (int n = 0; n < 2; ++n) _Pragma("unroll") for (int k = 0; k < 2; ++k) dst[n][k] = *(const LAS bf16x8*)(lds + PG8_SB(b, h) + boff + n * 2048 + k * 1024); } while (0)
#define PG8_MMA(ai, bj, At, Bt) do { __builtin_amdgcn_s_setprio(1); _Pragma("unroll") for (int m = 0; m < 4; ++m) _Pragma("unroll") for (int n = 0; n < 2; ++n) _Pragma("unroll") for (int k = 0; k < 2; ++k) \
        acc[ai][bj][m][n] = __builtin_amdgcn_mfma_f32_16x16x32_bf16(Bt[n][k], At[m][k], acc[ai][bj][m][n], 0, 0, 0); __builtin_amdgcn_s_setprio(0); } while (0)
#define PG8_WAIT_V(n) asm volatile("s_waitcnt vmcnt(" #n ")" ::: "memory")
#define PG8_WAIT_L(n) asm volatile("s_waitcnt lgkmcnt(" #n ")" ::: "memory")
#define PG8_BAR __builtin_amdgcn_s_barrier()
#define PG8_SCHED __builtin_amdgcn_sched_barrier(0)
#define PG8_ABASE(u) ((const char*)(g.A + (size_t)(u).pm * g.a_pm + (size_t)(u).pn * g.a_pn))
#define PG8_BBASE(u) ((const char*)(g.Bt + (size_t)(u).pn * g.b_pn + (size_t)((u).pm >> 3) * g.b_b))
    Unit cur, nxt; int ui = 0;
    if (!S.next(0, cur)) return;
    f32x4 acc[2][2][4][2];
#pragma unroll
    for (int a = 0; a < 2; ++a)
#pragma unroll
        for (int b = 0; b < 2; ++b)
#pragma unroll
            for (int m = 0; m < 4; ++m)
#pragma unroll
                for (int n = 0; n < 2; ++n) acc[a][b][m][n] = (f32x4){0.f, 0.f, 0.f, 0.f};
    bf16x8 At[4][2], B0[2][2], B1[2][2];
    const char* cA = PG8_ABASE(cur); const char* cB = PG8_BBASE(cur);
    PG8_STAGE(PG8_SB(0, 0), cB, voffB); PG8_STAGE(PG8_SB(0, 1), cB + hstepB, voffB); PG8_STAGE(PG8_SA(0, 0), cA, voffA); PG8_STAGE(PG8_SA(0, 1), cA + hstepA, voffA);
    if (wr == 1) PG8_BAR;
    PG8_WAIT_V(2); PG8_BAR;
    PG8_STAGE(PG8_SB(1, 0), cB + kstep, voffB); PG8_STAGE(PG8_SA(1, 0), cA + kstep, voffA); PG8_STAGE(PG8_SB(1, 1), cB + hstepB + kstep, voffB);
    PG8_WAIT_V(6); PG8_BAR;
    for (;;) {
        const bool has_next = S.next(ui + 1, nxt);
        const char* nA = has_next ? PG8_ABASE(nxt) : cA; const char* nB = has_next ? PG8_BBASE(nxt) : cB;
        for (int t = 0; t < nt; t += 2) {
            const bool last = (t == nt - 2);
            const char* a1 = cA + (size_t)(t + 1) * kstep;
            const char* a2 = last ? nA : cA + (size_t)(t + 2) * kstep; const char* b2 = last ? nB : cB + (size_t)(t + 2) * kstep;
            const char* a3 = a2 + kstep; const char* b3 = b2 + kstep;
            PG8_LDB(B0, 0, 0); PG8_LDB(B1, 0, 1); PG8_SCHED; PG8_LDA(At, 0, 0); PG8_STAGE(PG8_SA(1, 1), a1 + hstepA, voffA);
            PG8_WAIT_V(8); PG8_WAIT_L(0); PG8_BAR; PG8_MMA(0, 0, At, B0); PG8_MMA(0, 1, At, B1); PG8_BAR; PG8_SCHED;
            PG8_LDA(At, 0, 1); PG8_STAGE(PG8_SB(0, 0), b2, voffB); PG8_STAGE(PG8_SB(0, 1), b2 + hstepB, voffB); PG8_STAGE(PG8_SA(0, 0), a2, voffA);
            PG8_WAIT_V(8); PG8_WAIT_L(0); PG8_BAR; PG8_MMA(1, 0, At, B0); PG8_MMA(1, 1, At, B1); PG8_BAR; PG8_SCHED;
            PG8_LDB(B0, 1, 0); PG8_LDB(B1, 1, 1); PG8_SCHED; PG8_LDA(At, 1, 0); PG8_STAGE(PG8_SA(0, 1), a2 + hstepA, voffA);
            PG8_WAIT_V(8); PG8_WAIT_L(0); PG8_BAR; PG8_MMA(0, 0, At, B0); PG8_MMA(0, 1, At, B1); PG8_BAR; PG8_SCHED;
            PG8_LDA(At, 1, 1); PG8_STAGE(PG8_SB(1, 0), b3, voffB); PG8_STAGE(PG8_SB(1, 1), b3 + hstepB, voffB); PG8_STAGE(PG8_SA(1, 0), a3, voffA);
            PG8_WAIT_V(8); PG8_WAIT_L(0); PG8_BAR; PG8_MMA(1, 0, At, B0); PG8_MMA(1, 1, At, B1); PG8_BAR; PG8_SCHED;
        }
        if constexpr (ALIGN_EPI) { if (wr == 0) PG8_BAR; }
        E(acc, cur, wid, lane);
        if (!has_next) break;
#pragma unroll
        for (int a = 0; a < 2; ++a)
#pragma unroll
            for (int b = 0; b < 2; ++b)
#pragma unroll
                for (int m = 0; m < 4; ++m)
#pragma unroll
                    for (int n = 0; n < 2; ++n) acc[a][b][m][n] = (f32x4){0.f, 0.f, 0.f, 0.f};
        cur = nxt; cA = nA; cB = nB; ++ui;
        if constexpr (ALIGN_EPI) { if (wr == 1) PG8_BAR; }
    }
    PG8_WAIT_V(0);
    if constexpr (!ALIGN_EPI) { if (wr == 0) PG8_BAR; }
    PG8_BAR;
#undef PG8_SA
#undef PG8_SB
#undef PG8_STAGE
#undef PG8_LDA
#undef PG8_LDB
#undef PG8_MMA
#undef PG8_WAIT_V
#undef PG8_WAIT_L
#undef PG8_BAR
#undef PG8_SCHED
#undef PG8_ABASE
#undef PG8_BBASE
}
}

struct TrItem { const float* W; int ldw, src_n0, k0; bf16_t* WT; int ldt, dst_n0; const float* rs; const float* cs; };
__device__ __forceinline__ void tr_load(const TrItem& d, float (&v)[32], int lane) {
    const float* wp = d.W + (size_t)(d.k0 + (lane >> 5)) * d.ldw + d.src_n0 + (lane & 31);
#pragma unroll
    for (int i = 0; i < 32; ++i) v[i] = wp[(size_t)(2 * i) * d.ldw];
}
__device__ __forceinline__ void tr_finish(const TrItem& d, const float (&v)[32], LAS float* scr, int lane) {
    const float csv = d.cs ? d.cs[d.src_n0 + (lane & 31)] : 1.0f;
#pragma unroll
    for (int i = 0; i < 32; ++i) { const int kk = 2 * i + (lane >> 5); float t = v[i]; if (d.rs) t *= d.rs[d.k0 + kk]; scr[kk * 33 + (lane & 31)] = t * csv; }
    asm volatile("s_waitcnt lgkmcnt(0)" ::: "memory");
    const int c = lane & 7;
#pragma unroll
    for (int j = 0; j < 4; ++j) { const int n = (lane >> 3) + 8 * j; const LAS float* s = scr + (8 * c) * 33 + n;
        u32x4 o; o.x = cvt_pk_bf16(s[0 * 33], s[1 * 33]); o.y = cvt_pk_bf16(s[2 * 33], s[3 * 33]); o.z = cvt_pk_bf16(s[4 * 33], s[5 * 33]); o.w = cvt_pk_bf16(s[6 * 33], s[7 * 33]);
        *(u32x4*)(d.WT + (size_t)(d.dst_n0 + n) * d.ldt + d.k0 + 8 * c) = o; }
    asm volatile("s_waitcnt lgkmcnt(0)" ::: "memory");
}
__device__ __forceinline__ bool conv_mat(int& r, const float* W, int K, int N, bf16_t* WT, const float* rs, const float* cs, bool glu, TrItem& d) {
    const int nblk = N / 32, items = (K / 64) * nblk;
    if (r >= items) { r -= items; return false; }
    const int kb = r / nblk, nb = r % nblk, n0 = nb * 32;
    d.W = W; d.ldw = N; d.src_n0 = glu ? ((n0 >> 8) * 128 + (n0 & 127) + ((n0 >> 7) & 1) * D) : n0; d.k0 = kb * 64; d.WT = WT; d.ldt = K; d.dst_n0 = n0; d.rs = rs; d.cs = cs;
    return true;
}

struct Args { const float* in[23]; float* out; unsigned char* ws; int lo, hi; };
typedef LAS const unsigned long long* PtrTab;
__device__ __forceinline__ const float* inptr(PtrTab tab, int k) {
    const unsigned long long v = tab[k];
    return (const float*)(((unsigned long long)(unsigned)__builtin_amdgcn_readfirstlane((int)(v >> 32)) << 32) | (unsigned long long)(unsigned)__builtin_amdgcn_readfirstlane((int)v));
}
#define INP(k) inptr(tab, (k))

__device__ __forceinline__ void decode_item(PtrTab tab, unsigned char* ws_, int i, int it, TrItem& d) {
    int r = it;
    if (i < 0) { constexpr int I1 = (D / 64) * (D / 32); const int mtx = it / I1, l = mtx & 3; r = it % I1;
        conv_mat(r, (mtx < 4 ? INP(17) : INP(18)) + (size_t)l * D * D, D, D, (bf16_t*)(ws_ + (mtx < 4 ? WS_WKT : WS_WVT)) + (size_t)l * D * D, nullptr, nullptr, false, d); return; }
    unsigned char* lw = ws_ + WS_LW + (size_t)(i & 1) * LW_SET; const int j = i >> 1;
    if (!(i & 1)) {
        if (conv_mat(r, INP(6) + (size_t)j * D * 2 * D, D, 2 * D, (bf16_t*)(lw + LW_WIN), INP(3) + i * D, nullptr, true, d)) return;
        if (conv_mat(r, INP(12) + (size_t)j * D * D, D, D, (bf16_t*)(lw + LW_WOUT), nullptr, nullptr, false, d)) return;
    } else {
        const int g = r >> 5;
        if (g < 4) { r &= 31; conv_mat(r, INP(14) + ((size_t)j * 4 + g) * 65536, 256, 256, (bf16_t*)(lw + LW_WIN) + (size_t)g * 65536, nullptr, INP(15) + j * D + g * 256, false, d); return; }
        r -= 128;
    }
    if (conv_mat(r, INP(16) + (size_t)i * D * D, D, D, (bf16_t*)(lw + LW_WQ), INP(4) + i * D, nullptr, false, d)) return;
    if (conv_mat(r, INP(19) + (size_t)i * D * D, D, D, (bf16_t*)(lw + LW_WO), nullptr, nullptr, false, d)) return;
    if (conv_mat(r, INP(20) + (size_t)i * D * FF, D, FF, (bf16_t*)(lw + LW_W1), INP(5) + i * D, nullptr, false, d)) return;
    conv_mat(r, INP(21) + (size_t)i * FF * D, FF, D, (bf16_t*)(lw + LW_W2), nullptr, nullptr, false, d);
}
__device__ __forceinline__ void convert_job(PtrTab tab, unsigned char* ws_, int i, LAS float* scr, int gw, int NGW, int lane) {
    const int I_MIX = !(i & 1) ? (D / 64) * (2 * D / 32) + (D / 64) * (D / 32) : 4 * (256 / 64) * (256 / 32);
    const int NITEMS = (i < 0) ? 8 * (D / 64) * (D / 32) : I_MIX + 2 * (D / 64) * (D / 32) + 2 * (D / 64) * (FF / 32);
    int it = gw; if (it >= NITEMS) return;
    TrItem d0; float v0[32];
    decode_item(tab, ws_, i, it, d0); tr_load(d0, v0, lane);
    for (;;) {
        const int it2 = it + NGW; const bool has = it2 < NITEMS;
        TrItem d1; float v1[32];
        if (has) { decode_item(tab, ws_, i, it2, d1); tr_load(d1, v1, lane); }
        tr_finish(d0, v0, scr, lane);
        if (!has) break;
        d0 = d1; it = it2;
#pragma unroll
        for (int q = 0; q < 32; ++q) v0[q] = v1[q];
    }
}

__device__ __forceinline__ void dw_phase(const bf16_t* GLU, bf16_t* V, const float* wdw, const float* bdw, const float* lng, const float* lnb, LAS float* red, int bid, int G, int tid) {
    const int lane = tid & 63, wave = tid >> 6;
    f32x2 wk[CW];
#pragma unroll
    for (int k = 0; k < CW; ++k) wk[k] = *(const f32x2*)(wdw + k * D + 2 * tid);
    const f32x2 bd = *(const f32x2*)(bdw + 2 * tid), lg = *(const f32x2*)(lng + 2 * tid), lb = *(const f32x2*)(lnb + 2 * tid);
    const unsigned* G32 = (const unsigned*)GLU; unsigned* V32 = (unsigned*)V;
    LAS f32x2* part = (LAS f32x2*)red;
    LAS f32x2* stat = (LAS f32x2*)(red + 256);
    const int ustart = (G == 256) ? (bid & 7) * 128 + (bid >> 3) * 4 : bid, ustep = (G == 256) ? 1 : G, uend = (G == 256) ? ustart + 4 : M / 16;
    unsigned raw[46];
    if (ustart < uend) { const int t0 = (ustart & 127) * 16; int vb = (ustart * 16 - 30) * 512 + tid; asm volatile("" : "+v"(vb));
#pragma unroll
        for (int r = 0; r < 46; ++r) raw[r] = (t0 - 30 + r >= 0) ? G32[vb + r * 512] : 0u; }
    for (int unit = ustart; unit < uend; unit += ustep) {
        const int t0 = (unit & 127) * 16, rowbase = unit * 16;
        f32x2 win[46];
#pragma unroll
        for (int r = 0; r < 46; ++r) win[r] = (f32x2){bf_lo(raw[r]), bf_hi(raw[r])};
        f32x2 o[16];
#pragma unroll
        for (int t = 0; t < 16; ++t) { f32x2 a = bd;
#pragma unroll
            for (int k = 0; k < CW; ++k) a = __builtin_elementwise_fma(wk[k], win[t + k], a);
            o[t] = a; }
        if (unit + ustep < uend) { const int nu = unit + ustep, nt0 = (nu & 127) * 16; int vb = (nu * 16 - 30) * 512 + tid; asm volatile("" : "+v"(vb));
#pragma unroll
            for (int r = 0; r < 46; ++r) raw[r] = (nt0 - 30 + r >= 0) ? G32[vb + r * 512] : 0u; }
#pragma unroll
        for (int t = 0; t < 16; ++t) {
            const float s1 = wave_sum(o[t].x + o[t].y, lane), s2 = wave_sum(o[t].x * o[t].x + o[t].y * o[t].y, lane);
            if (lane == 0) part[wave * 16 + t] = (f32x2){s1, s2};
        }
        asm volatile("s_waitcnt lgkmcnt(0)" ::: "memory"); __builtin_amdgcn_s_barrier(); asm volatile("" ::: "memory");
        if (tid < 16) { float s1 = 0.f, s2 = 0.f;
#pragma unroll
            for (int w = 0; w < 8; ++w) { const f32x2 p = part[w * 16 + tid]; s1 += p.x; s2 += p.y; }
            const float mean = s1 * (1.0f / D), var = fmaxf(s2 * (1.0f / D) - mean * mean, 0.f);
            stat[tid] = (f32x2){mean, rsqrtf(var + LN_EPS)}; }
        asm volatile("s_waitcnt lgkmcnt(0)" ::: "memory"); __builtin_amdgcn_s_barrier(); asm volatile("" ::: "memory");
#pragma unroll
        for (int t = 0; t < 16; ++t) {
            const f32x2 st = stat[t];
            float y0 = (o[t].x - st.x) * st.y * lg.x + lb.x, y1 = (o[t].y - st.x) * st.y * lg.y + lb.y;
            y0 = y0 * __builtin_amdgcn_rcpf(1.0f + __builtin_amdgcn_exp2f(-y0 * LOG2E)); y1 = y1 * __builtin_amdgcn_rcpf(1.0f + __builtin_amdgcn_exp2f(-y1 * LOG2E));
            V32[(size_t)(rowbase + t) * 512 + tid] = cvt_pk_bf16(y0, y1);
        }
        asm volatile("s_waitcnt lgkmcnt(0)" ::: "memory"); __builtin_amdgcn_s_barrier(); asm volatile("" ::: "memory");
    }
}

template <int W>
__device__ __forceinline__ void pl_unit(const bf16_t* XBs, const u64* ssq, bf16_t* PP, int rowbase, int t0, int tid, f32x2 g) {
    float h0[31], h1[31];
#pragma unroll
    for (int r = 16 - W; r < 31; ++r) {
        const int t = t0 - 15 + r;
        if (t >= 0) { const int row = rowbase - 15 + r; const float rs = rstd_of(ssq[row]);
            const unsigned v = ((const unsigned*)XBs)[(size_t)row * 512 + tid]; h0[r] = bf_lo(v) * rs * g.x; h1[r] = bf_hi(v) * rs * g.y; }
        else { h0[r] = 0.f; h1[r] = 0.f; }
    }
    unsigned* P32 = (unsigned*)PP;
#pragma unroll
    for (int t = 0; t < 16; ++t) {
        float s0 = 0.f, s1 = 0.f;
#pragma unroll
        for (int j = 0; j < W; ++j) { s0 += h0[15 + t - j]; s1 += h1[15 + t - j]; }
        const int cnt = (t0 + t + 1) < W ? (t0 + t + 1) : W; const float inv = 1.0f / (float)cnt;
        P32[(size_t)(rowbase + t) * 512 + tid] = cvt_pk_bf16(s0 * inv - h0[15 + t], s1 * inv - h1[15 + t]);
    }
}
__device__ __forceinline__ void pl_phase(const bf16_t* X, const u64* ssq, const float* gain, bf16_t* PP, int bid, int G, int tid) {
    const f32x2 g = *(const f32x2*)(gain + 2 * tid); const int grp = __builtin_amdgcn_readfirstlane(tid >> 7);
    const int ustart = (G == 256) ? (bid & 7) * 128 + (bid >> 3) * 4 : bid, ustep = (G == 256) ? 1 : G, uend = (G == 256) ? ustart + 4 : M / 16;
    for (int unit = ustart; unit < uend; unit += ustep) {
        const int t0 = (unit & 127) * 16, rowbase = unit * 16;
        if (grp == 0) pl_unit<2>(X, ssq, PP, rowbase, t0, tid, g);
        else if (grp == 1) pl_unit<4>(X, ssq, PP, rowbase, t0, tid, g);
        else if (grp == 2) pl_unit<8>(X, ssq, PP, rowbase, t0, tid, g);
        else pl_unit<16>(X, ssq, PP, rowbase, t0, tid, g);
    }
}

#define XB_TMO      128
#define XB_XCNT(j)  (256  + 64 * (j))
#define XB_XSUB(j)  (1280 + 64 * (j))
#define XB_XGEN(j)  (2304 + 64 * (j))
#define XB_TOP      3328
#define XB_TOPGEN   3392
#define XB_LSUB(j)  (3456 + 64 * (j))
#define XB_LGEN(j)  (4480 + 64 * (j))
#define XB_GMASK(j) (5504 + (j))
#define XCD_BAR_WORDS 5632
#define XB_SPIN_CAP (1u << 18)
__device__ __forceinline__ unsigned xb_ld(unsigned* p)              { return __hip_atomic_load(p, __ATOMIC_RELAXED, __HIP_MEMORY_SCOPE_AGENT); }
__device__ __forceinline__ unsigned xb_add(unsigned* p, unsigned v) { return __hip_atomic_fetch_add(p, v, __ATOMIC_RELAXED, __HIP_MEMORY_SCOPE_AGENT); }
__device__ __forceinline__ unsigned xb_xcc_id() { return (unsigned)__builtin_amdgcn_s_getreg((3 << 11) | 20) & 0xFu; }
#define XB_SPIN(cond, bar) do { unsigned _sp = 0; while (cond) { __builtin_amdgcn_s_sleep(1); \
    if ((++_sp & 255u) == 0u) { if (xb_ld(&(bar)[XB_TMO])) break; if (_sp > XB_SPIN_CAP) { atomicAdd(&(bar)[XB_TMO], 1u); break; } } } } while (0)
struct XcdBarrier { unsigned* bar; unsigned x; volatile LAS unsigned* st; };
__device__ __forceinline__ void xcd_barrier_complete(unsigned* bar, unsigned x, unsigned& nloc, unsigned& nx) {
    const unsigned G = gridDim.x * gridDim.y * gridDim.z;
    unsigned sum, cnt, mine, sp = 0u;
    for (;;) {
        sum = 0u; cnt = 0u; mine = 0u;
#pragma unroll
        for (unsigned j = 0; j < 16; ++j) { const unsigned c = xb_ld(&bar[XB_XCNT(j)]); sum += c; cnt += (c > 0u) ? 1u : 0u; mine = (j == x) ? c : mine; }
        if (sum == G) break;
        __builtin_amdgcn_s_sleep(1);
        if ((++sp & 255u) == 0u) { if (xb_ld(&bar[XB_TMO])) break; if (sp > XB_SPIN_CAP) { atomicAdd(&bar[XB_TMO], 1u); break; } }
    }
    nloc = mine > 0u ? mine : 1u; nx = cnt > 0u ? cnt : 1u;
}
__device__ __forceinline__ void xcd_barrier(unsigned* bar_, volatile LAS unsigned* st_) {
    XcdBarrier b; b.bar = bar_; b.st = st_; b.x = xb_xcc_id();
    asm volatile("s_waitcnt vmcnt(0)" ::: "memory");
    __syncthreads();
    if (threadIdx.x == 0) {
        unsigned* bar = b.bar;
        __builtin_amdgcn_s_waitcnt(0);
        unsigned nloc = b.st[0], nx = b.st[1];
        if (nloc == 0u) { xcd_barrier_complete(bar, b.x, nloc, nx); b.st[0] = nloc; b.st[1] = nx; }
        const unsigned old = xb_add(&bar[XB_XSUB(b.x)], 1u);
        const unsigned gen = old / nloc;
        if (old + 1u == (gen + 1u) * nloc) {
            __builtin_amdgcn_fence(__ATOMIC_RELEASE, "agent");
            asm volatile("s_waitcnt vmcnt(0)" ::: "memory");
            const unsigned og = xb_add(&bar[XB_TOP], 1u);
            const unsigned tg = og / nx;
            if (og + 1u == (tg + 1u) * nx) xb_add(&bar[XB_TOPGEN], 1u);
            else XB_SPIN(xb_ld(&bar[XB_TOPGEN]) == tg, bar);
            __builtin_amdgcn_fence(__ATOMIC_ACQUIRE, "agent");
            xb_add(&bar[XB_XGEN(b.x)], 1u);
            asm volatile("s_waitcnt vmcnt(0)" ::: "memory");
        } else {
            XB_SPIN(xb_ld(&bar[XB_XGEN(b.x)]) == gen, bar);
            __builtin_amdgcn_fence(__ATOMIC_ACQUIRE, "agent");
            asm volatile("s_waitcnt vmcnt(0)" ::: "memory");
        }
    }
    __syncthreads();
}

__device__ __forceinline__ void xcd_local_barrier(unsigned* bar, unsigned grp, unsigned nloc) {
    asm volatile("s_waitcnt vmcnt(0)" ::: "memory");
    __syncthreads();
    if (threadIdx.x == 0) {
        __builtin_amdgcn_s_waitcnt(0);
        const unsigned old = xb_add(&bar[XB_LSUB(grp)], 1u);
        const unsigned gen = old / nloc;
        if (old + 1u == (gen + 1u) * nloc) xb_add(&bar[XB_LGEN(grp)], 1u);
        else XB_SPIN(xb_ld(&bar[XB_LGEN(grp)]) == gen, bar);
        __builtin_amdgcn_fence(__ATOMIC_ACQUIRE, "agent");
        asm volatile("s_waitcnt vmcnt(0)" ::: "memory");
    }
    __syncthreads();
}

enum { K_PRO = 0, K_KV, K_G1, K_DW, K_G2, K_PL, K_GP, K_GQ, K_S, K_PV, K_WO, K_UP, K_DOWN, K_FINAL };
constexpr int N_PHASES = 2 + 2 * 17 + 1;
__host__ __device__ __forceinline__ void decode_phase(int ph, int& kind, int& layer) {
    if (ph == 0) { kind = K_PRO; layer = 0; return; }
    if (ph == 1) { kind = K_KV; layer = 0; return; }
    if (ph == N_PHASES - 1) { kind = K_FINAL; layer = 0; return; }
    const int q = ph - 2, pair = q / 17, r = q % 17;
    if (r < 9) { layer = 2 * pair; kind = (r < 3) ? (K_G1 + r) : (K_GQ + (r - 3)); }
    else { layer = 2 * pair + 1; const int s = r - 9; kind = (s < 2) ? (K_PL + s) : (K_GQ + (s - 2)); }
}

__global__ void __launch_bounds__(512, 2) fwd_megakernel(Args args) {
    extern __shared__ __attribute__((aligned(16))) unsigned char lds_raw[];
    LAS unsigned char* lds = (LAS unsigned char*)lds_raw;
    const int G = gridDim.x, bid = blockIdx.x;
    const int wave_s = __builtin_amdgcn_readfirstlane(threadIdx.x >> 6);
    unsigned char* ws = args.ws;
    u64* SSQ = (u64*)(ws + WS_SSQ);
    float* X = args.out;
    bf16_t* XB = (bf16_t*)(ws + WS_XB);
    bf16_t* KALL = (bf16_t*)(ws + WS_KALL); bf16_t* VT = (bf16_t*)(ws + WS_VT);
    bf16_t* S0 = (bf16_t*)(ws + WS_S0); bf16_t* S1 = (bf16_t*)(ws + WS_S1); bf16_t* S2 = (bf16_t*)(ws + WS_S2); bf16_t* HM = (bf16_t*)(ws + WS_H);
    LAS float* exf = (LAS float*)(lds + EX_OFF);
    if (threadIdx.x < 4) ((volatile LAS unsigned*)(lds + BARST_OFF))[threadIdx.x] = 0u;
    if (threadIdx.x == 0) {
#pragma unroll
        for (int k = 0; k < 23; ++k) ((LAS unsigned long long*)(lds + PTAB_OFF))[k] = (unsigned long long)args.in[k];
    }
    __syncthreads();
    PtrTab tab = (PtrTab)(lds + PTAB_OFF);
    if (threadIdx.x == 0) {
        unsigned* bar0 = (unsigned*)(args.ws + WS_BAR); const unsigned x = xb_xcc_id();
        (void)xb_add(bar0 + XB_XCNT(x), 1u); (void)__hip_atomic_fetch_or(bar0 + XB_GMASK(bid & 7), 1u << x, __ATOMIC_RELAXED, __HIP_MEMORY_SCOPE_AGENT);
    }
    if (args.lo < 0) cg::this_grid().sync();

#pragma unroll 1
    for (int ph = args.lo; ph < args.hi; ++ph) {
        int lane; asm volatile("v_mbcnt_lo_u32_b32 %0, -1, 0\n\tv_mbcnt_hi_u32_b32 %0, -1, %0" : "=v"(lane));
        const int wave = wave_s, tid = wave * 64 + lane;
        const int gw = bid * 8 + wave, NGW = G * 8;
        LAS float* scr = (LAS float*)(lds + wave * 16384);
        int kind, i; decode_phase(ph, kind, i);
        if (ph >= LAST_PH && ph < N_PHASES - 1) kind = -1;
        const int j = i >> 1;
        unsigned char* lw = ws + WS_LW + (size_t)(i & 1) * LW_SET;
        switch (kind) {
        case K_PRO: {
            for (int u = bid * 512 + tid; u < 12 * M / 2; u += G * 512) ((u32x4*)(SSQ + M))[u] = (u32x4){0u, 0u, 0u, 0u};
            convert_job(tab, ws, -1, scr, gw, NGW, lane);
            for (int m = gw; m < MEMR; m += NGW) {
                const f32x4* xr = (const f32x4*)(INP(1) + (size_t)m * D) + lane; f32x4 v[4]; float s = 0.f;
#pragma unroll
                for (int q = 0; q < 4; ++q) { v[q] = xr[64 * q]; s += (v[q].x * v[q].x + v[q].y * v[q].y) + (v[q].z * v[q].z + v[q].w * v[q].w); }
                const float rs = rsqrtf(wave_sum(s, lane) * (1.0f / D) + RMS_EPS);
                u32x2* o8 = (u32x2*)((bf16_t*)(ws + WS_MEMN) + (size_t)m * D) + lane;
#pragma unroll
                for (int q = 0; q < 4; ++q) { const f32x4 gq = ((const f32x4*)INP(2))[lane + 64 * q]; u32x2 w; w.x = cvt_pk_bf16(v[q].x * rs * gq.x, v[q].y * rs * gq.y); w.y = cvt_pk_bf16(v[q].z * rs * gq.z, v[q].w * rs * gq.w); o8[64 * q] = w; }
            }
            for (int m = gw; m < M; m += NGW) {
                const f32x4* xr = (const f32x4*)(INP(0) + (size_t)m * D) + lane; f32x4 v[4]; float s = 0.f;
                u32x2* o8 = (u32x2*)(XB + (size_t)m * D) + lane;
#pragma unroll
                for (int q = 0; q < 4; ++q) { v[q] = xr[64 * q]; u32x2 w; w.x = cvt_pk_bf16(v[q].x, v[q].y); w.y = cvt_pk_bf16(v[q].z, v[q].w); o8[64 * q] = w;
                    const float a = bf_lo(w.x), b = bf_hi(w.x), c = bf_lo(w.y), d = bf_hi(w.y); s += (a * a + b * b) + (c * c + d * d); }
                s = wave_sum(s, lane);
                if (lane == 0) SSQ[m] = (u64)(s * SSQ_SCALE);
            }
            convert_job(tab, ws, 0, scr, gw, NGW, lane);
        } break;
        case K_KV: {
            {
                pg8::Gemm g{(const bf16_t*)(ws + WS_MEMN), (const bf16_t*)(ws + WS_WKT), D, D, D, 256L * D, 0, 256L * D, 0};
                pg8::Order S; S.init(MEMR / 256, 4 * D / 256, G, bid);
                pg8::EpiBf E{KALL, 4 * D, nullptr, 1.0f, 0};
                pg8::gemm_phase<pg8::EpiBf, true>(lds, g, S, E, tid);
            }
            {
                pg8::Gemm g{(const bf16_t*)(ws + WS_WVT), (const bf16_t*)(ws + WS_MEMN), D, D, D, 256L * D, 0, 256L * D, 0};
                pg8::Order S; S.init(4 * D / 256, MEMR / 256, G, (bid + G / 2) % G);
                pg8::EpiBf E{VT, MEMR, nullptr, 1.0f, 0};
                pg8::gemm_phase<pg8::EpiBf, true>(lds, g, S, E, tid);
            }
        } break;
        case K_G1: {
            pg8::Gemm g{XB, (const bf16_t*)(lw + LW_WIN), D, D, D, 256L * D, 0, 256L * D, 0};
            pg8::Order S; S.init(M / 256, 2 * D / 256, G, bid);
            pg8::EpiGlu E{S0, INP(7) + j * 2 * D, SSQ + (size_t)(3 * i) * M};
            pg8::gemm_phase<pg8::EpiGlu, true>(lds, g, S, E, tid);
        } break;
        case K_DW: {
            dw_phase(S0, S1, INP(8) + (size_t)j * CW * D, INP(9) + j * D, INP(10) + j * D, INP(11) + j * D, exf, bid, G, tid);
        } break;
        case K_PL: {
            pl_phase(XB, SSQ + (size_t)(3 * i) * M, INP(3) + i * D, S0, bid, G, tid);
        } break;
        case K_G2: case K_GP: case K_WO: case K_DOWN: {
            pg8::Gemm g; pg8::EpiRes E; E.xb = XB; E.bias = nullptr;
            if (kind == K_G2) { g = pg8::Gemm{S1, (const bf16_t*)(lw + LW_WOUT), D, D, D, 256L * D, 0, 256L * D, 0}; E.bias = INP(13) + j * D; E.ssq_next = SSQ + (size_t)(3 * i + 1) * M; }
            else if (kind == K_GP) { g = pg8::Gemm{S0, (const bf16_t*)(lw + LW_WIN), D, 256, 256, 256L * D, 256, 65536, 0}; E.ssq_next = SSQ + (size_t)(3 * i + 1) * M; }
            else if (kind == K_WO) { g = pg8::Gemm{S2, (const bf16_t*)(lw + LW_WO), D, D, D, 256L * D, 0, 256L * D, 0}; E.ssq_next = SSQ + (size_t)(3 * i + 2) * M; }
            else { g = pg8::Gemm{HM, (const bf16_t*)(lw + LW_W2), FF, FF, FF, 256L * FF, 0, 256L * FF, 0}; E.ssq_next = SSQ + (size_t)(3 * i + 3) * M; }
            pg8::Order S; S.init(M / 256, D / 256, G, bid);
            pg8::gemm_phase<pg8::EpiRes, true>(lds, g, S, E, tid);
        } break;
        case K_GQ: case K_UP: case K_PV: {
            pg8::Gemm g; pg8::EpiBf E; int nN = D / 256;
            if (kind == K_GQ) { g = pg8::Gemm{XB, (const bf16_t*)(lw + LW_WQ), D, D, D, 256L * D, 0, 256L * D, 0}; E = pg8::EpiBf{S0, D, SSQ + (size_t)(3 * i + 1) * M, 0.0625f, 0}; }
            else if (kind == K_UP) { g = pg8::Gemm{XB, (const bf16_t*)(lw + LW_W1), D, D, D, 256L * D, 0, 256L * D, 0}; E = pg8::EpiBf{HM, FF, SSQ + (size_t)(3 * i + 2) * M, 1.0f, 1}; nN = FF / 256; }
            else { g = pg8::Gemm{S1, VT + (size_t)i * D * MEMR, D, MEMR, 256, 256L * D, 256, 256L * MEMR, 256}; E = pg8::EpiBf{S2, D, nullptr, 1.0f, 0}; }
            pg8::Order S; S.init(M / 256, nN, G, bid);
            pg8::gemm_phase<pg8::EpiBf, true>(lds, g, S, E, tid);
            if (kind == K_PV && i + 1 < 4) convert_job(tab, ws, i + 1, scr, gw, NGW, lane);
        } break;
        case K_S: {
            pg8::Gemm g{S0, KALL + (size_t)i * D, D, 4 * D, 256, 256L * D, 256, 256, 256L * 4 * D};
            pg8::Order S; S.init(M / 256, D / 256, G, bid);
            pg8::EpiSoftmax E{S1, (LAS f32x2*)exf};
            pg8::gemm_phase<pg8::EpiSoftmax, true>(lds, g, S, E, tid);
        } break;
        case K_FINAL: {
            for (int m = gw; m < M; m += NGW) {
                f32x4* xr = (f32x4*)(X + (size_t)m * D) + lane; const u32x2* xi = (const u32x2*)(XB + (size_t)m * D) + lane; f32x4 v[4]; float s = 0.f;
#pragma unroll
                for (int q = 0; q < 4; ++q) { const u32x2 w = xi[64 * q]; v[q] = (f32x4){bf_lo(w.x), bf_hi(w.x), bf_lo(w.y), bf_hi(w.y)}; s += (v[q].x * v[q].x + v[q].y * v[q].y) + (v[q].z * v[q].z + v[q].w * v[q].w); }
                const float rs = rsqrtf(wave_sum(s, lane) * (1.0f / D) + RMS_EPS);
#pragma unroll
                for (int q = 0; q < 4; ++q) { const f32x4 gq = ((const f32x4*)INP(22))[lane + 64 * q]; f32x4 o = v[q] * rs; o.x *= gq.x; o.y *= gq.y; o.z *= gq.z; o.w *= gq.w; xr[64 * q] = o; }
            }
        } break;
        }
        if (ph + 1 < args.hi) {
            unsigned* bar = (unsigned*)(args.ws + WS_BAR); volatile LAS unsigned* st = (volatile LAS unsigned*)(lds + BARST_OFF);
            if (kind == K_GQ || kind == K_S) {
                asm volatile("s_waitcnt vmcnt(0)" ::: "memory"); __syncthreads();
                if (threadIdx.x == 0) { __builtin_amdgcn_fence(__ATOMIC_ACQUIRE, "agent"); asm volatile("s_waitcnt vmcnt(0)" ::: "memory"); }
                __syncthreads();
            } else if (ph <= 1 || kind == K_DOWN || st[2] != 1u) {
                xcd_barrier(bar, st);
                if (ph == 1) {
                    if (threadIdx.x == 0) { bool pure = (G == 256 && st[0] == 32u && st[1] == 8u);
#pragma unroll
                        for (int g8 = 0; g8 < 8; ++g8) pure = pure && (__builtin_popcount(xb_ld(bar + XB_GMASK(g8))) == 1);
                        st[2] = pure ? 1u : 2u; }
                    __syncthreads();
                }
            } else xcd_local_barrier(bar, (unsigned)(bid & 7), 32u);
        }
    }
}

extern "C" void kernel_launch(void* const* d_in, const int* in_sizes, int n_in, void* d_out, int out_size, void* d_ws, size_t ws_size, hipStream_t stream) {
    static int grid = 0;
    if (grid == 0) {
        if (n_in != 23 || out_size != M * D || ws_size < WS_END) { fprintf(stderr, "kernel_launch: unexpected problem (n_in %d out %d ws %zu)\n", n_in, out_size, ws_size); grid = -1; return; }
        int dev = 0, cus = 0, per_cu = 0;
        hipGetDevice(&dev); hipDeviceGetAttribute(&cus, hipDeviceAttributeMultiprocessorCount, dev);
        hipFuncSetAttribute((const void*)fwd_megakernel, hipFuncAttributeMaxDynamicSharedMemorySize, LDS_BYTES);
        if (hipOccupancyMaxActiveBlocksPerMultiprocessor(&per_cu, (const void*)fwd_megakernel, 512, LDS_BYTES) != hipSuccess || per_cu < 1) { fprintf(stderr, "kernel_launch: occupancy query gave %d\n", per_cu); per_cu = 1; }
        (void)hipGetLastError();
        grid = cus * per_cu;
    }
    if (grid < 0) return;
    (void)hipMemsetAsync((unsigned char*)d_ws + WS_BAR, 0, XCD_BAR_WORDS * 4, stream);
    Args a{};
    for (int i = 0; i < 23; ++i) a.in[i] = (const float*)d_in[i];
    a.out = (float*)d_out; a.ws = (unsigned char*)d_ws;
#if MK_PER_PHASE
    for (int ph = 0; ph < N_PHASES; ++ph) { a.lo = ph; a.hi = ph + 1; hipLaunchKernelGGL(fwd_megakernel, dim3(grid), dim3(512), LDS_BYTES, stream, a); }
#else
    a.lo = 0; a.hi = N_PHASES;
    void* kargs[] = {&a};
    hipError_t e = hipLaunchCooperativeKernel((const void*)fwd_megakernel, dim3(grid), dim3(512), kargs, LDS_BYTES, stream);
    if (e != hipSuccess) fprintf(stderr, "cooperative launch failed: %s (grid %d)\n", hipGetErrorString(e), grid);
#endif
}
```

```cpp
#include <hip/hip_runtime.h>
#include <hip/hip_cooperative_groups.h>
#include <cstdio>
#include <cstdint>
namespace cg = cooperative_groups;

#ifndef MK_PER_PHASE
#define MK_PER_PHASE 0
#endif

#ifndef LAST_PH
#define LAST_PH 99
#endif
#define LAS __attribute__((address_space(3)))
typedef unsigned short bf16_t;
typedef short bf16x8 __attribute__((ext_vector_type(8)));
typedef float f32x4 __attribute__((ext_vector_type(4)));
typedef float f32x2 __attribute__((ext_vector_type(2)));
typedef unsigned u32x4 __attribute__((ext_vector_type(4)));
typedef unsigned u32x2 __attribute__((ext_vector_type(2)));

constexpr int D = 1024, NB = 8, SEQ = 2048, M = NB * SEQ, FF = 4096, MEML = 256, MEMR = NB * MEML, CW = 31;
constexpr float RMS_EPS = 1e-6f, LN_EPS = 1e-5f;
constexpr float LOG2E = 1.4426950408889634f;
typedef unsigned long long u64;
constexpr float SSQ_SCALE = 1048576.0f, SSQ_INV = 1.0f / (1048576.0f * 1024.0f);
__device__ __forceinline__ float rstd_of(u64 q) { return rsqrtf((float)q * SSQ_INV + 1e-6f); }

constexpr size_t MiB = 1u << 20;
constexpr size_t WS_SSQ = 0;
constexpr size_t WS_BAR = 2 * MiB - 32768;
constexpr size_t WS_LW = 2 * MiB;
constexpr size_t LW_SET = 26 * MiB;
constexpr size_t LW_WIN = 0, LW_WOUT = 4 * MiB, LW_WQ = 6 * MiB, LW_WO = 8 * MiB, LW_W1 = 10 * MiB, LW_W2 = 18 * MiB;
constexpr size_t WS_XB = WS_LW + 2 * LW_SET;
constexpr size_t WS_KALL = WS_XB + 32 * MiB;
constexpr size_t WS_VT = WS_KALL + 16 * MiB;
constexpr size_t WS_H = WS_VT + 16 * MiB;
constexpr size_t WS_S0 = WS_H, WS_S1 = WS_H + 32 * MiB, WS_S2 = WS_H + 64 * MiB, WS_S3 = WS_H + 96 * MiB;
constexpr size_t WS_WKT = WS_S3, WS_WVT = WS_S3 + 8 * MiB, WS_MEMN = WS_S3 + 16 * MiB;
constexpr size_t WS_END = WS_H + 128 * MiB;

constexpr int RING_BYTES = 131072, EX_OFF = RING_BYTES, BARST_OFF = RING_BYTES + 8192, PTAB_OFF = BARST_OFF + 64, LDS_BYTES = RING_BYTES + 8192 + 2048;

__device__ __forceinline__ unsigned cvt_pk_bf16(float lo, float hi) { unsigned r; asm volatile("v_cvt_pk_bf16_f32 %0, %1, %2" : "=v"(r) : "v"(lo), "v"(hi)); return r; }
__device__ __forceinline__ float shx(float v, int lane, int o) { return __int_as_float(__builtin_amdgcn_ds_bpermute((lane ^ o) << 2, __float_as_int(v))); }
__device__ __forceinline__ float wave_sum(float v, int lane) {
#pragma unroll
    for (int o = 1; o < 64; o <<= 1) v += shx(v, lane, o);
    return v;
}
__device__ __forceinline__ float bf_lo(unsigned u) { return __uint_as_float(u << 16); }
__device__ __forceinline__ float bf_hi(unsigned u) { return __uint_as_float(u & 0xffff0000u); }

namespace pg8 {
constexpr int BM = 256, BK = 64, HALF = 128, HTB = HALF * BK * 2, STAGE_BYTES = 8 * HTB, NXCD = 8, WGM = 8;
__host__ __device__ __forceinline__ int lds_byte(int r, int c) { const int st = (r >> 4) * 2 + (c >> 5), rr = r & 15, cc = c & 31, ob = rr * 64 + cc * 2; return st * 1024 + (ob ^ (((ob >> 9) & 1) << 5)); }
__host__ __device__ __forceinline__ void stage_rc(int b, int& R, int& C) { const int st = b / 1024, sb = b % 1024, swz = sb ^ (((sb >> 9) & 1) << 5); R = (st >> 1) * 16 + swz / 64; C = (st & 1) * 32 + (swz % 64) / 2; }
__host__ __device__ __forceinline__ int perm32(int rho) { const int n = rho >> 4, i = rho & 15; return 8 * (i >> 2) + 4 * n + (i & 3); }

struct Unit { int pm, pn; };
struct Gemm { const bf16_t* A; const bf16_t* Bt; int lda, ldb, K; long a_pm, a_pn, b_pn, b_b; };

struct Order {
    int nM, nN, nwg, G, c;
    __device__ __forceinline__ void init(int nM_, int nN_, int G_, int c_) { nM = nM_; nN = nN_; nwg = nM * nN; G = G_; c = c_; }
    __device__ __forceinline__ bool next(int i, Unit& u) const {
        const long L = (long)i * G + c; if (L >= nwg) return false;
        int wgid = (int)L; { const int q = nwg / NXCD, r = nwg % NXCD, xcd = wgid % NXCD, off = wgid / NXCD; wgid = (xcd < r ? xcd * (q + 1) : r * (q + 1) + (xcd - r) * q) + off; }
        const int nig = WGM * nN, gid = wgid / nig, fm = gid * WGM, gsz = (nM - fm) < WGM ? (nM - fm) : WGM;
        u.pm = fm + ((wgid % nig) % gsz); u.pn = (wgid % nig) / gsz; return true;
    }
};


struct EpiBf {
    bf16_t* O; int ldc; const u64* ssq; float cs; int act;
    __device__ __forceinline__ void operator()(f32x4 (&acc)[2][2][4][2], const Unit& u, int wid, int lane_) const {
        int lane = lane_; asm volatile("" : "+v"(lane));
        const int wr = wid >> 2, wc = wid & 3, fr = lane & 15, fq = lane >> 4;
        const int row0 = u.pm * BM + wr * 64 + fr, col0 = u.pn * BM + wc * 32 + 8 * fq;
#pragma unroll
        for (int ai = 0; ai < 2; ++ai)
#pragma unroll
            for (int m = 0; m < 4; ++m) {
                const int r = row0 + ai * HALF + m * 16;
                float rs = cs; if (ssq) rs *= rstd_of(ssq[r]);
                bf16_t* rowp = O + (size_t)r * ldc + col0;
#pragma unroll
                for (int bj = 0; bj < 2; ++bj) {
                    f32x4 v0 = acc[ai][bj][m][0] * rs, v1 = acc[ai][bj][m][1] * rs;
                    if (act) {
#pragma unroll
                        for (int j = 0; j < 4; ++j) { const float a = fmaxf(v0[j], 0.f), b = fmaxf(v1[j], 0.f); v0[j] = a * a; v1[j] = b * b; }
                    }
                    u32x4 w; w.x = cvt_pk_bf16(v0[0], v0[1]); w.y = cvt_pk_bf16(v0[2], v0[3]); w.z = cvt_pk_bf16(v1[0], v1[1]); w.w = cvt_pk_bf16(v1[2], v1[3]);
                    *(u32x4*)(rowp + bj * HALF) = w;
                }
            }
    }
};
struct EpiGlu {
    bf16_t* O; const float* bias; const u64* ssq;
    __device__ __forceinline__ void operator()(f32x4 (&acc)[2][2][4][2], const Unit& u, int wid, int lane_) const {
        int lane = lane_; asm volatile("" : "+v"(lane));
        const int wr = wid >> 2, wc = wid & 3, fr = lane & 15, fq = lane >> 4;
        const int row0 = u.pm * BM + wr * 64 + fr, ch0 = u.pn * HALF + wc * 32 + 8 * fq;
        f32x4 ba[2], bg[2];
#pragma unroll
        for (int n = 0; n < 2; ++n) { ba[n] = *(const f32x4*)(bias + ch0 + 4 * n); bg[n] = *(const f32x4*)(bias + D + ch0 + 4 * n); }
#pragma unroll
        for (int ai = 0; ai < 2; ++ai)
#pragma unroll
            for (int m = 0; m < 4; ++m) {
                const int r = row0 + ai * HALF + m * 16;
                const float rs = rstd_of(ssq[r]);
                f32x4 o[2];
#pragma unroll
                for (int n = 0; n < 2; ++n) {
                    const f32x4 a = acc[ai][0][m][n] * rs + ba[n], g = acc[ai][1][m][n] * rs + bg[n];
#pragma unroll
                    for (int j = 0; j < 4; ++j) o[n][j] = a[j] * __builtin_amdgcn_rcpf(1.0f + __builtin_amdgcn_exp2f(-g[j] * LOG2E));
                }
                u32x4 w; w.x = cvt_pk_bf16(o[0][0], o[0][1]); w.y = cvt_pk_bf16(o[0][2], o[0][3]); w.z = cvt_pk_bf16(o[1][0], o[1][1]); w.w = cvt_pk_bf16(o[1][2], o[1][3]);
                *(u32x4*)(O + (size_t)r * D + ch0) = w;
            }
    }
};
struct EpiRes {
    bf16_t* xb; const float* bias; u64* ssq_next;
    __device__ __forceinline__ void operator()(f32x4 (&acc)[2][2][4][2], const Unit& u, int wid, int lane_) const {
        int lane = lane_; asm volatile("" : "+v"(lane));
        const int wr = wid >> 2, wc = wid & 3, fr = lane & 15, fq = lane >> 4;
        const int row0 = u.pm * BM + wr * 64 + fr, col0 = u.pn * BM + wc * 32 + 8 * fq;
        f32x4 bv[2][2];
#pragma unroll
        for (int bj = 0; bj < 2; ++bj)
#pragma unroll
            for (int n = 0; n < 2; ++n) bv[bj][n] = bias ? *(const f32x4*)(bias + col0 + bj * HALF + 4 * n) : (f32x4){0.f, 0.f, 0.f, 0.f};
#pragma unroll
        for (int ai = 0; ai < 2; ++ai)
#pragma unroll
            for (int m = 0; m < 4; ++m) {
                const int r = row0 + ai * HALF + m * 16; const size_t off = (size_t)r * D + col0;
                float ss = 0.f;
#pragma unroll
                for (int bj = 0; bj < 2; ++bj) {
                    const u32x4 xo = *(const u32x4*)(xb + off + bj * HALF);
                    f32x4 x0 = (f32x4){bf_lo(xo.x), bf_hi(xo.x), bf_lo(xo.y), bf_hi(xo.y)}, x1 = (f32x4){bf_lo(xo.z), bf_hi(xo.z), bf_lo(xo.w), bf_hi(xo.w)};
                    x0 += acc[ai][bj][m][0] + bv[bj][0]; x1 += acc[ai][bj][m][1] + bv[bj][1];
                    u32x4 w; w.x = cvt_pk_bf16(x0[0], x0[1]); w.y = cvt_pk_bf16(x0[2], x0[3]); w.z = cvt_pk_bf16(x1[0], x1[1]); w.w = cvt_pk_bf16(x1[2], x1[3]);
                    *(u32x4*)(xb + off + bj * HALF) = w;
                    x0 = (f32x4){bf_lo(w.x), bf_hi(w.x), bf_lo(w.y), bf_hi(w.y)}; x1 = (f32x4){bf_lo(w.z), bf_hi(w.z), bf_lo(w.w), bf_hi(w.w)};
                    ss += (x0[0] * x0[0] + x0[1] * x0[1]) + (x0[2] * x0[2] + x0[3] * x0[3]) + (x1[0] * x1[0] + x1[1] * x1[1]) + (x1[2] * x1[2] + x1[3] * x1[3]);
                }
                ss += shx(ss, lane, 16); ss += shx(ss, lane, 32);
                if (fq == 0) __hip_atomic_fetch_add(ssq_next + r, (u64)(ss * SSQ_SCALE), __ATOMIC_RELAXED, __HIP_MEMORY_SCOPE_AGENT);
            }
    }
};
struct EpiSoftmax {
    bf16_t* P; LAS f32x2* ex;
    __device__ __forceinline__ void operator()(f32x4 (&acc)[2][2][4][2], const Unit& u, int wid, int lane_) const {
        int lane = lane_; asm volatile("" : "+v"(lane));
        const int wr = wid >> 2, wc = wid & 3, fr = lane & 15, fq = lane >> 4;
        const int row0 = u.pm * BM + wr * 64 + fr, col0 = u.pn * BM + wc * 32 + 8 * fq;
        float mxs[2][4];
#pragma unroll
        for (int ai = 0; ai < 2; ++ai)
#pragma unroll
            for (int m = 0; m < 4; ++m) {
                float mx = -3.0e38f;
#pragma unroll
                for (int bj = 0; bj < 2; ++bj)
#pragma unroll
                    for (int n = 0; n < 2; ++n) { const f32x4 v = acc[ai][bj][m][n]; mx = fmaxf(mx, fmaxf(fmaxf(v[0], v[1]), fmaxf(v[2], v[3]))); }
                mx = fmaxf(mx, shx(mx, lane, 16)); mx = fmaxf(mx, shx(mx, lane, 32));
                float l = 0.f;
#pragma unroll
                for (int bj = 0; bj < 2; ++bj)
#pragma unroll
                    for (int n = 0; n < 2; ++n) { f32x4 v = acc[ai][bj][m][n];
#pragma unroll
                        for (int j = 0; j < 4; ++j) { v[j] = __builtin_amdgcn_exp2f((v[j] - mx) * LOG2E); l += v[j]; }
                        acc[ai][bj][m][n] = v; }
                l += shx(l, lane, 16); l += shx(l, lane, 32);
                mxs[ai][m] = mx;
                if (fq == 0) ex[(ai * HALF + wr * 64 + m * 16 + fr) * 4 + wc] = (f32x2){mx, l};
            }
        asm volatile("s_waitcnt lgkmcnt(0)" ::: "memory"); __builtin_amdgcn_s_barrier(); asm volatile("" ::: "memory");
#pragma unroll
        for (int ai = 0; ai < 2; ++ai)
#pragma unroll
            for (int m = 0; m < 4; ++m) {
                const int lr = ai * HALF + wr * 64 + m * 16 + fr;
                const f32x2 a = ex[lr * 4 + 0], b = ex[lr * 4 + 1], c = ex[lr * 4 + 2], d = ex[lr * 4 + 3];
                const float MX = fmaxf(fmaxf(a.x, b.x), fmaxf(c.x, d.x));
                const float L = a.y * __builtin_amdgcn_exp2f((a.x - MX) * LOG2E) + b.y * __builtin_amdgcn_exp2f((b.x - MX) * LOG2E)
                              + c.y * __builtin_amdgcn_exp2f((c.x - MX) * LOG2E) + d.y * __builtin_amdgcn_exp2f((d.x - MX) * LOG2E);
                const float f = __builtin_amdgcn_exp2f((mxs[ai][m] - MX) * LOG2E) / L;
                bf16_t* rowp = P + (size_t)(row0 + ai * HALF + m * 16) * D + col0;
#pragma unroll
                for (int bj = 0; bj < 2; ++bj) {
                    const f32x4 v0 = acc[ai][bj][m][0] * f, v1 = acc[ai][bj][m][1] * f;
                    u32x4 w; w.x = cvt_pk_bf16(v0[0], v0[1]); w.y = cvt_pk_bf16(v0[2], v0[3]); w.z = cvt_pk_bf16(v1[0], v1[1]); w.w = cvt_pk_bf16(v1[2], v1[3]);
                    *(u32x4*)(rowp + bj * HALF) = w;
                }
            }
        asm volatile("s_waitcnt lgkmcnt(0)" ::: "memory"); __builtin_amdgcn_s_barrier(); asm volatile("" ::: "memory");
    }
};

template <int LDSIMM, int GOFF>
__device__ __forceinline__ void glds_s(const char* sbase, unsigned voff, unsigned ldsbase) {
    asm volatile("s_add_u32 m0, %2, %3\n\ts_nop 0\n\tglobal_load_lds_dwordx4 %0, %1 offset:%4" :: "v"(voff), "s"(sbase), "s"(ldsbase), "i"(LDSIMM), "i"(GOFF) : "memory", "m0", "scc");
}
template <class Epi, bool ALIGN_EPI>
__device__ __forceinline__ void gemm_phase(LAS unsigned char* lds, const Gemm g, const Order& S, const Epi& E, const int tid) {
    const int wid = __builtin_amdgcn_readfirstlane(tid >> 6), lane = tid & 63, wr = wid >> 2, wc = wid & 3, fr = lane & 15, fq = lane >> 4;
    const int nt = g.K / BK;
    unsigned voffA[2], voffB[2];
#pragma unroll
    for (int i = 0; i < 2; ++i) { int R, C; stage_rc(tid * 16 + i * 8192, R, C); const int Rb = (R & ~31) + perm32(R & 31);
        voffA[i] = (unsigned)(R * g.lda + C) * 2u; voffB[i] = (unsigned)(Rb * g.ldb + C) * 2u; }
    const size_t kstep = (size_t)(BK * 2);
    const size_t hstepA = (size_t)HALF * g.lda * 2, hstepB = (size_t)HALF * g.ldb * 2;
    const unsigned ldsbase = (unsigned)(size_t)lds + (unsigned)wid * 1024u;
    const int aoff = lds_byte(wr * 64 + fr, fq * 8), boff = lds_byte(wc * 32 + fr, fq * 8);
#define PG8_SA(b, h) (((b) * 2 + (h)) * HTB)
#define PG8_SB(b, h) ((4 + (b) * 2 + (h)) * HTB)
#define PG8_STAGE(bufoff, gbase, voff) do { glds_s<(bufoff), 0>((const char*)(gbase), (voff)[0], ldsbase); glds_s<(bufoff) + 8192, 0>((const char*)(gbase), (voff)[1], ldsbase); } while (0)
#define PG8_LDA(dst, b, h) do { _Pragma("unroll") for (int m = 0; m < 4; ++m) _Pragma("unroll") for (int k = 0; k < 2; ++k) dst[m][k] = *(const LAS bf16x8*)(lds + PG8_SA(b, h) + aoff + m * 2048 + k * 1024); } while (0)
#define PG8_LDB(dst, b, h) do { _Pragma("unroll") for (int n = 0; n < 2; ++n) _Pragma("unroll") for (int k = 0; k < 2; ++k) dst[n][k] = *(const LAS bf16x8*)(lds + PG8_SB(b, h) + boff + n * 2048 + k * 1024); } while (0)
#define PG8_MMA(ai, bj, At, Bt) do { __builtin_amdgcn_s_setprio(1); _Pragma("unroll") for (int m = 0; m < 4; ++m) _Pragma("unroll") for (int n = 0; n < 2; ++n) _Pragma("unroll") for (int k = 0; k < 2; ++k) \
        acc[ai][bj][m][n] = __builtin_amdgcn_mfma_f32_16x16x32_bf16(Bt[n][k], At[m][k], acc[ai][bj][m][n], 0, 0, 0); __builtin_amdgcn_s_setprio(0); } while (0)
#define PG8_WAIT_V(n) asm volatile("s_waitcnt vmcnt(" #n ")" ::: "memory")
#define PG8_WAIT_L(n) asm volatile("s_waitcnt lgkmcnt(" #n ")" ::: "memory")
#define PG8_BAR __builtin_amdgcn_s_barrier()
#define PG8_SCHED __builtin_amdgcn_sched_barrier(0)
#define PG8_ABASE(u) ((const char*)(g.A + (size_t)(u).pm * g.a_pm + (size_t)(u).pn * g.a_pn))
#define PG8_BBASE(u) ((const char*)(g.Bt + (size_t)(u).pn * g.b_pn + (size_t)((u).pm >> 3) * g.b_b))
    Unit cur, nxt; int ui = 0;
    if (!S.next(0, cur)) return;
    f32x4 acc[2][2][4][2];
#pragma unroll
    for (int a = 0; a < 2; ++a)
#pragma unroll
        for (int b = 0; b < 2; ++b)
#pragma unroll
            for (int m = 0; m < 4; ++m)
#pragma unroll
                for (int n = 0; n < 2; ++n) acc[a][b][m][n] = (f32x4){0.f, 0.f, 0.f, 0.f};
    bf16x8 At[4][2], B0[2][2], B1[2][2];
    const char* cA = PG8_ABASE(cur); const char* cB = PG8_BBASE(cur);
    PG8_STAGE(PG8_SB(0, 0), cB, voffB); PG8_STAGE(PG8_SB(0, 1), cB + hstepB, voffB); PG8_STAGE(PG8_SA(0, 0), cA, voffA); PG8_STAGE(PG8_SA(0, 1), cA + hstepA, voffA);
    if (wr == 1) PG8_BAR;
    PG8_WAIT_V(2); PG8_BAR;
    PG8_STAGE(PG8_SB(1, 0), cB + kstep, voffB); PG8_STAGE(PG8_SA(1, 0), cA + kstep, voffA); PG8_STAGE(PG8_SB(1, 1), cB + hstepB + kstep, voffB);
    PG8_WAIT_V(6); PG8_BAR;
    for (;;) {
        const bool has_next = S.next(ui + 1, nxt);
        const char* nA = has_next ? PG8_ABASE(nxt) : cA; const char* nB = has_next ? PG8_BBASE(nxt) : cB;
        for (int t = 0; t < nt; t += 2) {
            const bool last = (t == nt - 2);
            const char* a1 = cA + (size_t)(t + 1) * kstep;
            const char* a2 = last ? nA : cA + (size_t)(t + 2) * kstep; const char* b2 = last ? nB : cB + (size_t)(t + 2) * kstep;
            const char* a3 = a2 + kstep; const char* b3 = b2 + kstep;
            PG8_LDB(B0, 0, 0); PG8_LDB(B1, 0, 1); PG8_SCHED; PG8_LDA(At, 0, 0); PG8_STAGE(PG8_SA(1, 1), a1 + hstepA, voffA);
            PG8_WAIT_V(8); PG8_WAIT_L(0); PG8_BAR; PG8_MMA(0, 0, At, B0); PG8_MMA(0, 1, At, B1); PG8_BAR; PG8_SCHED;
            PG8_LDA(At, 0, 1); PG8_STAGE(PG8_SB(0, 0), b2, voffB); PG8_STAGE(PG8_SB(0, 1), b2 + hstepB, voffB); PG8_STAGE(PG8_SA(0, 0), a2, voffA);
            PG8_WAIT_V(8); PG8_WAIT_L(0); PG8_BAR; PG8_MMA(1, 0, At, B0); PG8_MMA(1, 1, At, B1); PG8_BAR; PG8_SCHED;
            PG8_LDB(B0, 1, 0); PG8_LDB(B1, 1, 1); PG8_SCHED; PG8_LDA(At, 1, 0); PG8_STAGE(PG8_SA(0, 1), a2 + hstepA, voffA);
            PG8_WAIT_V(8); PG8_WAIT_L(0); PG8_BAR; PG8_MMA(0, 0, At, B0); PG8_MMA(0, 1, At, B1); PG8_BAR; PG8_SCHED;
            PG8_LDA(At, 1, 1); PG8_STAGE(PG8_SB(1, 0), b3, voffB); PG8_STAGE(PG8_SB(1, 1), b3 + hstepB, voffB); PG8_STAGE(PG8_SA(1, 0), a3, voffA);
            PG8_WAIT_V(8); PG8_WAIT_L(0); PG8_BAR; PG8_MMA(1, 0, At, B0); PG8_MMA(1, 1, At, B1); PG8_BAR; PG8_SCHED;
        }
        if constexpr (ALIGN_EPI) { if (wr == 0) PG8_BAR; }
        E(acc, cur, wid, lane);
        if (!has_next) break;
#pragma unroll
        for (int a = 0; a < 2; ++a)
#pragma unroll
            for (int b = 0; b < 2; ++b)
#pragma unroll
                for (int m = 0; m < 4; ++m)
#pragma unroll
                    for (int n = 0; n < 2; ++n) acc[a][b][m][n] = (f32x4){0.f, 0.f, 0.f, 0.f};
        cur = nxt; cA = nA; cB = nB; ++ui;
        if constexpr (ALIGN_EPI) { if (wr == 1) PG8_BAR; }
    }
    PG8_WAIT_V(0);
    if constexpr (!ALIGN_EPI) { if (wr == 0) PG8_BAR; }
    PG8_BAR;
#undef PG8_SA
#undef PG8_SB
#undef PG8_STAGE
#undef PG8_LDA
#undef PG8_LDB
#undef PG8_MMA
#undef PG8_WAIT_V
#undef PG8_WAIT_L
#undef PG8_BAR
#undef PG8_SCHED
#undef PG8_ABASE
#undef PG8_BBASE
}
}

struct TrItem { const float* W; int ldw, src_n0, k0; bf16_t* WT; int ldt, dst_n0; const float* rs; const float* cs; };
__device__ __forceinline__ void tr_load(const TrItem& d, float (&v)[32], int lane) {
    const float* wp = d.W + (size_t)(d.k0 + (lane >> 5)) * d.ldw + d.src_n0 + (lane & 31);
#pragma unroll
    for (int i = 0; i < 32; ++i) v[i] = wp[(size_t)(2 * i) * d.ldw];
}
__device__ __forceinline__ void tr_finish(const TrItem& d, const float (&v)[32], LAS float* scr, int lane) {
    const float csv = d.cs ? d.cs[d.src_n0 + (lane & 31)] : 1.0f;
#pragma unroll
    for (int i = 0; i < 32; ++i) { const int kk = 2 * i + (lane >> 5); float t = v[i]; if (d.rs) t *= d.rs[d.k0 + kk]; scr[kk * 33 + (lane & 31)] = t * csv; }
    asm volatile("s_waitcnt lgkmcnt(0)" ::: "memory");
    const int c = lane & 7;
#pragma unroll
    for (int j = 0; j < 4; ++j) { const int n = (lane >> 3) + 8 * j; const LAS float* s = scr + (8 * c) * 33 + n;
        u32x4 o; o.x = cvt_pk_bf16(s[0 * 33], s[1 * 33]); o.y = cvt_pk_bf16(s[2 * 33], s[3 * 33]); o.z = cvt_pk_bf16(s[4 * 33], s[5 * 33]); o.w = cvt_pk_bf16(s[6 * 33], s[7 * 33]);
        *(u32x4*)(d.WT + (size_t)(d.dst_n0 + n) * d.ldt + d.k0 + 8 * c) = o; }
    asm volatile("s_waitcnt lgkmcnt(0)" ::: "memory");
}
__device__ __forceinline__ bool conv_mat(int& r, const float* W, int K, int N, bf16_t* WT, const float* rs, const float* cs, bool glu, TrItem& d) {
    const int nblk = N / 32, items = (K / 64) * nblk;
    if (r >= items) { r -= items; return false; }
    const int kb = r / nblk, nb = r % nblk, n0 = nb * 32;
    d.W = W; d.ldw = N; d.src_n0 = glu ? ((n0 >> 8) * 128 + (n0 & 127) + ((n0 >> 7) & 1) * D) : n0; d.k0 = kb * 64; d.WT = WT; d.ldt = K; d.dst_n0 = n0; d.rs = rs; d.cs = cs;
    return true;
}

struct Args { const float* in[23]; float* out; unsigned char* ws; int lo, hi; };
typedef LAS const unsigned long long* PtrTab;
__device__ __forceinline__ const float* inptr(PtrTab tab, int k) {
    const unsigned long long v = tab[k];
    return (const float*)(((unsigned long long)(unsigned)__builtin_amdgcn_readfirstlane((int)(v >> 32)) << 32) | (unsigned long long)(unsigned)__builtin_amdgcn_readfirstlane((int)v));
}
#define INP(k) inptr(tab, (k))

__device__ __forceinline__ void decode_item(PtrTab tab, unsigned char* ws_, int i, int it, TrItem& d) {
    int r = it;
    if (i < 0) { constexpr int I1 = (D / 64) * (D / 32); const int mtx = it / I1, l = mtx & 3; r = it % I1;
        conv_mat(r, (mtx < 4 ? INP(17) : INP(18)) + (size_t)l * D * D, D, D, (bf16_t*)(ws_ + (mtx < 4 ? WS_WKT : WS_WVT)) + (size_t)l * D * D, nullptr, nullptr, false, d); return; }
    unsigned char* lw = ws_ + WS_LW + (size_t)(i & 1) * LW_SET; const int j = i >> 1;
    if (!(i & 1)) {
        if (conv_mat(r, INP(6) + (size_t)j * D * 2 * D, D, 2 * D, (bf16_t*)(lw + LW_WIN), INP(3) + i * D, nullptr, true, d)) return;
        if (conv_mat(r, INP(12) + (size_t)j * D * D, D, D, (bf16_t*)(lw + LW_WOUT), nullptr, nullptr, false, d)) return;
    } else {
        const int g = r >> 5;
        if (g < 4) { r &= 31; conv_mat(r, INP(14) + ((size_t)j * 4 + g) * 65536, 256, 256, (bf16_t*)(lw + LW_WIN) + (size_t)g * 65536, nullptr, INP(15) + j * D + g * 256, false, d); return; }
        r -= 128;
    }
    if (conv_mat(r, INP(16) + (size_t)i * D * D, D, D, (bf16_t*)(lw + LW_WQ), INP(4) + i * D, nullptr, false, d)) return;
    if (conv_mat(r, INP(19) + (size_t)i * D * D, D, D, (bf16_t*)(lw + LW_WO), nullptr, nullptr, false, d)) return;
    if (conv_mat(r, INP(20) + (size_t)i * D * FF, D, FF, (bf16_t*)(lw + LW_W1), INP(5) + i * D, nullptr, false, d)) return;
    conv_mat(r, INP(21) + (size_t)i * FF * D, FF, D, (bf16_t*)(lw + LW_W2), nullptr, nullptr, false, d);
}
__device__ __forceinline__ void convert_job(PtrTab tab, unsigned char* ws_, int i, LAS float* scr, int gw, int NGW, int lane) {
    const int I_MIX = !(i & 1) ? (D / 64) * (2 * D / 32) + (D / 64) * (D / 32) : 4 * (256 / 64) * (256 / 32);
    const int NITEMS = (i < 0) ? 8 * (D / 64) * (D / 32) : I_MIX + 2 * (D / 64) * (D / 32) + 2 * (D / 64) * (FF / 32);
    int it = gw; if (it >= NITEMS) return;
    TrItem d0; float v0[32];
    decode_item(tab, ws_, i, it, d0); tr_load(d0, v0, lane);
    for (;;) {
        const int it2 = it + NGW; const bool has = it2 < NITEMS;
        TrItem d1; float v1[32];
        if (has) { decode_item(tab, ws_, i, it2, d1); tr_load(d1, v1, lane); }
        tr_finish(d0, v0, scr, lane);
        if (!has) break;
        d0 = d1; it = it2;
#pragma unroll
        for (int q = 0; q < 32; ++q) v0[q] = v1[q];
    }
}

__device__ __forceinline__ void dw_phase(const bf16_t* GLU, bf16_t* V, const float* wdw, const float* bdw, const float* lng, const float* lnb, LAS float* red, int bid, int G, int tid) {
    const int lane = tid & 63, wave = tid >> 6;
    f32x2 wk[CW];
#pragma unroll
    for (int k = 0; k < CW; ++k) wk[k] = *(const f32x2*)(wdw + k * D + 2 * tid);
    const f32x2 bd = *(const f32x2*)(bdw + 2 * tid), lg = *(const f32x2*)(lng + 2 * tid), lb = *(const f32x2*)(lnb + 2 * tid);
    const unsigned* G32 = (const unsigned*)GLU; unsigned* V32 = (unsigned*)V;
    LAS f32x2* part = (LAS f32x2*)red;
    LAS f32x2* stat = (LAS f32x2*)(red + 256);
    const int ustart = (G == 256) ? (bid & 7) * 128 + (bid >> 3) * 4 : bid, ustep = (G == 256) ? 1 : G, uend = (G == 256) ? ustart + 4 : M / 16;
    unsigned raw[46];
    if (ustart < uend) { const int t0 = (ustart & 127) * 16; int vb = (ustart * 16 - 30) * 512 + tid; asm volatile("" : "+v"(vb));
#pragma unroll
        for (int r = 0; r < 46; ++r) raw[r] = (t0 - 30 + r >= 0) ? G32[vb + r * 512] : 0u; }
    for (int unit = ustart; unit < uend; unit += ustep) {
        const int t0 = (unit & 127) * 16, rowbase = unit * 16;
        f32x2 win[46];
#pragma unroll
        for (int r = 0; r < 46; ++r) win[r] = (f32x2){bf_lo(raw[r]), bf_hi(raw[r])};
        f32x2 o[16];
#pragma unroll
        for (int t = 0; t < 16; ++t) { f32x2 a = bd;
#pragma unroll
            for (int k = 0; k < CW; ++k) a = __builtin_elementwise_fma(wk[k], win[t + k], a);
            o[t] = a; }
        if (unit + ustep < uend) { const int nu = unit + ustep, nt0 = (nu & 127) * 16; int vb = (nu * 16 - 30) * 512 + tid; asm volatile("" : "+v"(vb));
#pragma unroll
            for (int r = 0; r < 46; ++r) raw[r] = (nt0 - 30 + r >= 0) ? G32[vb + r * 512] : 0u; }
#pragma unroll
        for (int t = 0; t < 16; ++t) {
            const float s1 = wave_sum(o[t].x + o[t].y, lane), s2 = wave_sum(o[t].x * o[t].x + o[t].y * o[t].y, lane);
            if (lane == 0) part[wave * 16 + t] = (f32x2){s1, s2};
        }
        asm volatile("s_waitcnt lgkmcnt(0)" ::: "memory"); __builtin_amdgcn_s_barrier(); asm volatile("" ::: "memory");
        if (tid < 16) { float s1 = 0.f, s2 = 0.f;
#pragma unroll
            for (int w = 0; w < 8; ++w) { const f32x2 p = part[w * 16 + tid]; s1 += p.x; s2 += p.y; }
            const float mean = s1 * (1.0f / D), var = fmaxf(s2 * (1.0f / D) - mean * mean, 0.f);
            stat[tid] = (f32x2){mean, rsqrtf(var + LN_EPS)}; }
        asm volatile("s_waitcnt lgkmcnt(0)" ::: "memory"); __builtin_amdgcn_s_barrier(); asm volatile("" ::: "memory");
#pragma unroll
        for (int t = 0; t < 16; ++t) {
            const f32x2 st = stat[t];
            float y0 = (o[t].x - st.x) * st.y * lg.x + lb.x, y1 = (o[t].y - st.x) * st.y * lg.y + lb.y;
            y0 = y0 * __builtin_amdgcn_rcpf(1.0f + __builtin_amdgcn_exp2f(-y0 * LOG2E)); y1 = y1 * __builtin_amdgcn_rcpf(1.0f + __builtin_amdgcn_exp2f(-y1 * LOG2E));
            V32[(size_t)(rowbase + t) * 512 + tid] = cvt_pk_bf16(y0, y1);
        }
        asm volatile("s_waitcnt lgkmcnt(0)" ::: "memory"); __builtin_amdgcn_s_barrier(); asm volatile("" ::: "memory");
    }
}

__device__ __forceinline__ float bcast_lane(float v, int k) { return __int_as_float(__builtin_amdgcn_readlane(__float_as_int(v), k)); }
template <int W>
__device__ __forceinline__ void pl_span(const bf16_t* XBs, const u64* ssq, bf16_t* PP, int unit0, int nsub, int tid, int lane, f32x2 g) {
    const unsigned* X32 = (const unsigned*)XBs; unsigned* P32 = (unsigned*)PP;
    const int t0 = (unit0 & 127) * 16, rowbase = unit0 * 16;
    const bool first = (t0 == 0);
    int vb = rowbase * 512 + tid; asm volatile("" : "+v"(vb));
    unsigned xh[W - 1], xc[16];
#pragma unroll
    for (int j = 0; j < W - 1; ++j) xh[j] = X32[vb + (first ? 0 : (j - (W - 1))) * 512];
    const int l5 = lane & 31;
    u64 q = ssq[rowbase + (l5 < 16 ? l5 : (first ? 0 : l5 - 32))];
#pragma unroll
    for (int j = 0; j < 16; ++j) xc[j] = X32[vb + j * 512];
    float rsl = rstd_of(q);
    f32x2 hist[W - 1]; f32x2 S = (f32x2){0.f, 0.f};
#pragma unroll
    for (int j = 0; j < W - 1; ++j) { const float r0 = bcast_lane(rsl, 32 - (W - 1) + j), rs = first ? 0.f : r0; hist[j] = (f32x2){bf_lo(xh[j]) * rs, bf_hi(xh[j]) * rs}; S += hist[j]; }
    constexpr float INVW = 1.0f / (float)W;
    for (int c = 0; c < nsub; ++c) {
        const bool more = (c + 1 < nsub);
        f32x2 ext[W - 1 + 16];
#pragma unroll
        for (int j = 0; j < W - 1; ++j) ext[j] = hist[j];
#pragma unroll
        for (int j = 0; j < 16; ++j) { const float rs = bcast_lane(rsl, j); ext[W - 1 + j] = (f32x2){bf_lo(xc[j]) * rs, bf_hi(xc[j]) * rs}; }
        const bool head = first && c == 0;
#pragma unroll
        for (int j = 0; j < 16; ++j) {
            S += ext[W - 1 + j];
            const float inv = head ? (1.0f / (float)((j + 1 < W) ? j + 1 : W)) : INVW;
            const f32x2 p = (S * inv - ext[W - 1 + j]) * g;
            P32[vb + (16 * c + j) * 512] = cvt_pk_bf16(p.x, p.y);
            S -= ext[j];
        }
#pragma unroll
        for (int j = 0; j < W - 1; ++j) hist[j] = ext[16 + j];
        if (more) {
#pragma unroll
            for (int j = 0; j < 16; ++j) xc[j] = X32[vb + (16 * (c + 1) + j) * 512];
            rsl = rstd_of(ssq[rowbase + 16 * (c + 1) + (lane & 15)]);
        }
    }
}
__device__ __forceinline__ void pl_phase(const bf16_t* X, const u64* ssq, const float* gain, bf16_t* PP, int bid, int G, int tid) {
    const f32x2 g = *(const f32x2*)(gain + 2 * tid); const int grp = __builtin_amdgcn_readfirstlane(tid >> 7), lane = tid & 63;
    const int ustart = (G == 256) ? (bid & 7) * 128 + (bid >> 3) * 4 : bid, ustep = (G == 256) ? 4 : G, uend = (G == 256) ? ustart + 4 : M / 16, nsub = (G == 256) ? 4 : 1;
    for (int unit = ustart; unit < uend; unit += ustep) {
        if (grp == 0) pl_span<2>(X, ssq, PP, unit, nsub, tid, lane, g);
        else if (grp == 1) pl_span<4>(X, ssq, PP, unit, nsub, tid, lane, g);
        else if (grp == 2) pl_span<8>(X, ssq, PP, unit, nsub, tid, lane, g);
        else pl_span<16>(X, ssq, PP, unit, nsub, tid, lane, g);
    }
}

#define XB_TMO      128
#define XB_XCNT(j)  (256  + 64 * (j))
#define XB_XSUB(j)  (1280 + 64 * (j))
#define XB_XGEN(j)  (2304 + 64 * (j))
#define XB_TOP      3328
#define XB_TOPGEN   3392
#define XB_LSUB(j)  (3456 + 64 * (j))
#define XB_LGEN(j)  (4480 + 64 * (j))
#define XB_GMASK(j) (5504 + (j))
#define XCD_BAR_WORDS 5632
#define XB_SPIN_CAP (1u << 18)
__device__ __forceinline__ unsigned xb_ld(unsigned* p)              { return __hip_atomic_load(p, __ATOMIC_RELAXED, __HIP_MEMORY_SCOPE_AGENT); }
__device__ __forceinline__ unsigned xb_add(unsigned* p, unsigned v) { return __hip_atomic_fetch_add(p, v, __ATOMIC_RELAXED, __HIP_MEMORY_SCOPE_AGENT); }
__device__ __forceinline__ unsigned xb_xcc_id() { return (unsigned)__builtin_amdgcn_s_getreg((3 << 11) | 20) & 0xFu; }
#define XB_SPIN(cond, bar) do { unsigned _sp = 0; while (cond) { __builtin_amdgcn_s_sleep(1); \
    if ((++_sp & 255u) == 0u) { if (xb_ld(&(bar)[XB_TMO])) break; if (_sp > XB_SPIN_CAP) { atomicAdd(&(bar)[XB_TMO], 1u); break; } } } } while (0)
struct XcdBarrier { unsigned* bar; unsigned x; volatile LAS unsigned* st; };
__device__ __forceinline__ void xcd_barrier_complete(unsigned* bar, unsigned x, unsigned& nloc, unsigned& nx) {
    const unsigned G = gridDim.x * gridDim.y * gridDim.z;
    unsigned sum, cnt, mine, sp = 0u;
    for (;;) {
        sum = 0u; cnt = 0u; mine = 0u;
#pragma unroll
        for (unsigned j = 0; j < 16; ++j) { const unsigned c = xb_ld(&bar[XB_XCNT(j)]); sum += c; cnt += (c > 0u) ? 1u : 0u; mine = (j == x) ? c : mine; }
        if (sum == G) break;
        __builtin_amdgcn_s_sleep(1);
        if ((++sp & 255u) == 0u) { if (xb_ld(&bar[XB_TMO])) break; if (sp > XB_SPIN_CAP) { atomicAdd(&bar[XB_TMO], 1u); break; } }
    }
    nloc = mine > 0u ? mine : 1u; nx = cnt > 0u ? cnt : 1u;
}
__device__ __forceinline__ void xcd_barrier(unsigned* bar_, volatile LAS unsigned* st_) {
    XcdBarrier b; b.bar = bar_; b.st = st_; b.x = xb_xcc_id();
    asm volatile("s_waitcnt vmcnt(0)" ::: "memory");
    __syncthreads();
    if (threadIdx.x == 0) {
        unsigned* bar = b.bar;
        __builtin_amdgcn_s_waitcnt(0);
        unsigned nloc = b.st[0], nx = b.st[1];
        if (nloc == 0u) { xcd_barrier_complete(bar, b.x, nloc, nx); b.st[0] = nloc; b.st[1] = nx; }
        const unsigned old = xb_add(&bar[XB_XSUB(b.x)], 1u);
        const unsigned gen = old / nloc;
        if (old + 1u == (gen + 1u) * nloc) {
            __builtin_amdgcn_fence(__ATOMIC_RELEASE, "agent");
            asm volatile("s_waitcnt vmcnt(0)" ::: "memory");
            const unsigned og = xb_add(&bar[XB_TOP], 1u);
            const unsigned tg = og / nx;
            if (og + 1u == (tg + 1u) * nx) xb_add(&bar[XB_TOPGEN], 1u);
            else XB_SPIN(xb_ld(&bar[XB_TOPGEN]) == tg, bar);
            __builtin_amdgcn_fence(__ATOMIC_ACQUIRE, "agent");
            xb_add(&bar[XB_XGEN(b.x)], 1u);
            asm volatile("s_waitcnt vmcnt(0)" ::: "memory");
        } else {
            XB_SPIN(xb_ld(&bar[XB_XGEN(b.x)]) == gen, bar);
            __builtin_amdgcn_fence(__ATOMIC_ACQUIRE, "agent");
            asm volatile("s_waitcnt vmcnt(0)" ::: "memory");
        }
    }
    __syncthreads();
}

__device__ __forceinline__ void xcd_local_barrier(unsigned* bar, unsigned grp, unsigned nloc) {
    asm volatile("s_waitcnt vmcnt(0)" ::: "memory");
    __syncthreads();
    if (threadIdx.x == 0) {
        __builtin_amdgcn_s_waitcnt(0);
        const unsigned old = xb_add(&bar[XB_LSUB(grp)], 1u);
        const unsigned gen = old / nloc;
        if (old + 1u == (gen + 1u) * nloc) xb_add(&bar[XB_LGEN(grp)], 1u);
        else XB_SPIN(xb_ld(&bar[XB_LGEN(grp)]) == gen, bar);
        __builtin_amdgcn_fence(__ATOMIC_ACQUIRE, "agent");
        asm volatile("s_waitcnt vmcnt(0)" ::: "memory");
    }
    __syncthreads();
}

enum { K_PRO = 0, K_KV, K_G1, K_DW, K_G2, K_PL, K_GP, K_GQ, K_S, K_PV, K_WO, K_UP, K_DOWN, K_FINAL };
constexpr int N_PHASES = 2 + 2 * 17 + 1;
__host__ __device__ __forceinline__ void decode_phase(int ph, int& kind, int& layer) {
    if (ph == 0) { kind = K_PRO; layer = 0; return; }
    if (ph == 1) { kind = K_KV; layer = 0; return; }
    if (ph == N_PHASES - 1) { kind = K_FINAL; layer = 0; return; }
    const int q = ph - 2, pair = q / 17, r = q % 17;
    if (r < 9) { layer = 2 * pair; kind = (r < 3) ? (K_G1 + r) : (K_GQ + (r - 3)); }
    else { layer = 2 * pair + 1; const int s = r - 9; kind = (s < 2) ? (K_PL + s) : (K_GQ + (s - 2)); }
}

__global__ void __launch_bounds__(512, 2) fwd_megakernel(Args args) {
    extern __shared__ __attribute__((aligned(16))) unsigned char lds_raw[];
    LAS unsigned char* lds = (LAS unsigned char*)lds_raw;
    const int G0 = gridDim.x, bid0 = blockIdx.x, bid = bid0;
    const int wave_s = __builtin_amdgcn_readfirstlane(threadIdx.x >> 6);
    unsigned char* ws = args.ws;
    u64* SSQ = (u64*)(ws + WS_SSQ);
    float* X = args.out;
    bf16_t* XB = (bf16_t*)(ws + WS_XB);
    bf16_t* KALL = (bf16_t*)(ws + WS_KALL); bf16_t* VT = (bf16_t*)(ws + WS_VT);
    bf16_t* S0 = (bf16_t*)(ws + WS_S0); bf16_t* S1 = (bf16_t*)(ws + WS_S1); bf16_t* S2 = (bf16_t*)(ws + WS_S2); bf16_t* HM = (bf16_t*)(ws + WS_H);
    LAS float* exf = (LAS float*)(lds + EX_OFF);
    if (threadIdx.x < 4) ((volatile LAS unsigned*)(lds + BARST_OFF))[threadIdx.x] = 0u;
    if (threadIdx.x == 0) {
#pragma unroll
        for (int k = 0; k < 23; ++k) ((LAS unsigned long long*)(lds + PTAB_OFF))[k] = (unsigned long long)args.in[k];
    }
    __syncthreads();
    PtrTab tab = (PtrTab)(lds + PTAB_OFF);
    if (threadIdx.x == 0) {
        unsigned* bar0 = (unsigned*)(args.ws + WS_BAR); const unsigned x = xb_xcc_id();
        (void)xb_add(bar0 + XB_XCNT(x), 1u); (void)__hip_atomic_fetch_or(bar0 + XB_GMASK(bid & 7), 1u << x, __ATOMIC_RELAXED, __HIP_MEMORY_SCOPE_AGENT);
    }
    if (args.lo < 0) cg::this_grid().sync();

#pragma unroll 1
    for (int ph = args.lo; ph < args.hi; ++ph) {
        int lane; asm volatile("v_mbcnt_lo_u32_b32 %0, -1, 0\n\tv_mbcnt_hi_u32_b32 %0, -1, %0" : "=v"(lane));
        int G = G0, bid = bid0, wave = wave_s; asm volatile("" : "+s"(G), "+s"(bid), "+s"(wave));
        const int tid = wave * 64 + lane;
        const int gw = bid * 8 + wave, NGW = G * 8;
        LAS float* scr = (LAS float*)(lds + wave * 16384);
        int kind, i; decode_phase(ph, kind, i);
        if (ph >= LAST_PH && ph < N_PHASES - 1) kind = -1;
        const int j = i >> 1;
        unsigned char* lw = ws + WS_LW + (size_t)(i & 1) * LW_SET;
        switch (kind) {
        case K_PRO: {
            { unsigned z = 0u; asm volatile("" : "+v"(z));
              for (int u = bid * 512 + tid; u < 12 * M / 2; u += G * 512) ((u32x4*)(SSQ + M))[u] = (u32x4){z, z, z, z}; }
            convert_job(tab, ws, -1, scr, gw, NGW, lane);
            for (int m = gw; m < MEMR; m += NGW) {
                const f32x4* xr = (const f32x4*)(INP(1) + (size_t)m * D) + lane; f32x4 v[4]; float s = 0.f;
#pragma unroll
                for (int q = 0; q < 4; ++q) { v[q] = xr[64 * q]; s += (v[q].x * v[q].x + v[q].y * v[q].y) + (v[q].z * v[q].z + v[q].w * v[q].w); }
                const float rs = rsqrtf(wave_sum(s, lane) * (1.0f / D) + RMS_EPS);
                u32x2* o8 = (u32x2*)((bf16_t*)(ws + WS_MEMN) + (size_t)m * D) + lane;
#pragma unroll
                for (int q = 0; q < 4; ++q) { const f32x4 gq = ((const f32x4*)INP(2))[lane + 64 * q]; u32x2 w; w.x = cvt_pk_bf16(v[q].x * rs * gq.x, v[q].y * rs * gq.y); w.y = cvt_pk_bf16(v[q].z * rs * gq.z, v[q].w * rs * gq.w); o8[64 * q] = w; }
            }
            for (int m = gw; m < M; m += NGW) {
                const f32x4* xr = (const f32x4*)(INP(0) + (size_t)m * D) + lane; f32x4 v[4]; float s = 0.f;
                u32x2* o8 = (u32x2*)(XB + (size_t)m * D) + lane;
#pragma unroll
                for (int q = 0; q < 4; ++q) { v[q] = xr[64 * q]; u32x2 w; w.x = cvt_pk_bf16(v[q].x, v[q].y); w.y = cvt_pk_bf16(v[q].z, v[q].w); o8[64 * q] = w;
                    const float a = bf_lo(w.x), b = bf_hi(w.x), c = bf_lo(w.y), d = bf_hi(w.y); s += (a * a + b * b) + (c * c + d * d); }
                s = wave_sum(s, lane);
                if (lane == 0) SSQ[m] = (u64)(s * SSQ_SCALE);
            }
            convert_job(tab, ws, 0, scr, gw, NGW, lane);
        } break;
        case K_KV: {
            {
                pg8::Gemm g{(const bf16_t*)(ws + WS_MEMN), (const bf16_t*)(ws + WS_WKT), D, D, D, 256L * D, 0, 256L * D, 0};
                pg8::Order S; S.init(MEMR / 256, 4 * D / 256, G, bid);
                pg8::EpiBf E{KALL, 4 * D, nullptr, 1.0f, 0};
                pg8::gemm_phase<pg8::EpiBf, true>(lds, g, S, E, tid);
            }
            {
                pg8::Gemm g{(const bf16_t*)(ws + WS_WVT), (const bf16_t*)(ws + WS_MEMN), D, D, D, 256L * D, 0, 256L * D, 0};
                pg8::Order S; S.init(4 * D / 256, MEMR / 256, G, (bid + G / 2) % G);
                pg8::EpiBf E{VT, MEMR, nullptr, 1.0f, 0};
                pg8::gemm_phase<pg8::EpiBf, true>(lds, g, S, E, tid);
            }
        } break;
        case K_G1: {
            pg8::Gemm g{XB, (const bf16_t*)(lw + LW_WIN), D, D, D, 256L * D, 0, 256L * D, 0};
            pg8::Order S; S.init(M / 256, 2 * D / 256, G, bid);
            pg8::EpiGlu E{S0, INP(7) + j * 2 * D, SSQ + (size_t)(3 * i) * M};
            pg8::gemm_phase<pg8::EpiGlu, true>(lds, g, S, E, tid);
        } break;
        case K_DW: {
            dw_phase(S0, S1, INP(8) + (size_t)j * CW * D, INP(9) + j * D, INP(10) + j * D, INP(11) + j * D, exf, bid, G, tid);
        } break;
        case K_PL: {
            pl_phase(XB, SSQ + (size_t)(3 * i) * M, INP(3) + i * D, S0, bid, G, tid);
        } break;
        case K_G2: case K_GP: case K_WO: case K_DOWN: {
            pg8::Gemm g; pg8::EpiRes E; E.xb = XB; E.bias = nullptr;
            if (kind == K_G2) { g = pg8::Gemm{S1, (const bf16_t*)(lw + LW_WOUT), D, D, D, 256L * D, 0, 256L * D, 0}; E.bias = INP(13) + j * D; E.ssq_next = SSQ + (size_t)(3 * i + 1) * M; }
            else if (kind == K_GP) { g = pg8::Gemm{S0, (const bf16_t*)(lw + LW_WIN), D, 256, 256, 256L * D, 256, 65536, 0}; E.ssq_next = SSQ + (size_t)(3 * i + 1) * M; }
            else if (kind == K_WO) { g = pg8::Gemm{S2, (const bf16_t*)(lw + LW_WO), D, D, D, 256L * D, 0, 256L * D, 0}; E.ssq_next = SSQ + (size_t)(3 * i + 2) * M; }
            else { g = pg8::Gemm{HM, (const bf16_t*)(lw + LW_W2), FF, FF, FF, 256L * FF, 0, 256L * FF, 0}; E.ssq_next = SSQ + (size_t)(3 * i + 3) * M; }
            pg8::Order S; S.init(M / 256, D / 256, G, bid);
            pg8::gemm_phase<pg8::EpiRes, true>(lds, g, S, E, tid);
        } break;
        case K_GQ: case K_UP: case K_PV: {
            pg8::Gemm g; pg8::EpiBf E; int nN = D / 256;
            if (kind == K_GQ) { g = pg8::Gemm{XB, (const bf16_t*)(lw + LW_WQ), D, D, D, 256L * D, 0, 256L * D, 0}; E = pg8::EpiBf{S0, D, SSQ + (size_t)(3 * i + 1) * M, 0.0625f, 0}; }
            else if (kind == K_UP) { g = pg8::Gemm{XB, (const bf16_t*)(lw + LW_W1), D, D, D, 256L * D, 0, 256L * D, 0}; E = pg8::EpiBf{HM, FF, SSQ + (size_t)(3 * i + 2) * M, 1.0f, 1}; nN = FF / 256; }
            else { g = pg8::Gemm{S1, VT + (size_t)i * D * MEMR, D, MEMR, 256, 256L * D, 256, 256L * MEMR, 256}; E = pg8::EpiBf{S2, D, nullptr, 1.0f, 0}; }
            pg8::Order S; S.init(M / 256, nN, G, bid);
            pg8::gemm_phase<pg8::EpiBf, true>(lds, g, S, E, tid);
            if (kind == K_PV && i + 1 < 4) convert_job(tab, ws, i + 1, scr, gw, NGW, lane);
        } break;
        case K_S: {
            pg8::Gemm g{S0, KALL + (size_t)i * D, D, 4 * D, 256, 256L * D, 256, 256, 256L * 4 * D};
            pg8::Order S; S.init(M / 256, D / 256, G, bid);
            pg8::EpiSoftmax E{S1, (LAS f32x2*)exf};
            pg8::gemm_phase<pg8::EpiSoftmax, true>(lds, g, S, E, tid);
        } break;
        case K_FINAL: {
            for (int m = gw; m < M; m += NGW) {
                f32x4* xr = (f32x4*)(X + (size_t)m * D) + lane; const u32x2* xi = (const u32x2*)(XB + (size_t)m * D) + lane; f32x4 v[4]; float s = 0.f;
#pragma unroll
                for (int q = 0; q < 4; ++q) { const u32x2 w = xi[64 * q]; v[q] = (f32x4){bf_lo(w.x), bf_hi(w.x), bf_lo(w.y), bf_hi(w.y)}; s += (v[q].x * v[q].x + v[q].y * v[q].y) + (v[q].z * v[q].z + v[q].w * v[q].w); }
                const float rs = rsqrtf(wave_sum(s, lane) * (1.0f / D) + RMS_EPS);
#pragma unroll
                for (int q = 0; q < 4; ++q) { const f32x4 gq = ((const f32x4*)INP(22))[lane + 64 * q]; f32x4 o = v[q] * rs; o.x *= gq.x; o.y *= gq.y; o.z *= gq.z; o.w *= gq.w; xr[64 * q] = o; }
            }
        } break;
        }
        if (ph + 1 < args.hi) {
            unsigned* bar = (unsigned*)(args.ws + WS_BAR); volatile LAS unsigned* st = (volatile LAS unsigned*)(lds + BARST_OFF);
            if (kind == K_GQ || kind == K_S) {
                asm volatile("s_waitcnt vmcnt(0)" ::: "memory"); __syncthreads();
                if (threadIdx.x == 0) { __builtin_amdgcn_fence(__ATOMIC_ACQUIRE, "agent"); asm volatile("s_waitcnt vmcnt(0)" ::: "memory"); }
                __syncthreads();
            } else if (ph <= 1 || kind == K_DOWN || st[2] != 1u) {
                xcd_barrier(bar, st);
                if (ph == 1) {
                    if (threadIdx.x == 0) { bool pure = (G == 256 && st[0] == 32u && st[1] == 8u);
#pragma unroll
                        for (int g8 = 0; g8 < 8; ++g8) pure = pure && (__builtin_popcount(xb_ld(bar + XB_GMASK(g8))) == 1);
                        st[2] = pure ? 1u : 2u; }
                    __syncthreads();
                }
            } else xcd_local_barrier(bar, (unsigned)(bid & 7), 32u);
        }
    }
}

extern "C" void kernel_launch(void* const* d_in, const int* in_sizes, int n_in, void* d_out, int out_size, void* d_ws, size_t ws_size, hipStream_t stream) {
    static int grid = 0;
    if (grid == 0) {
        if (n_in != 23 || out_size != M * D || ws_size < WS_END) { fprintf(stderr, "kernel_launch: unexpected problem (n_in %d out %d ws %zu)\n", n_in, out_size, ws_size); grid = -1; return; }
        int dev = 0, cus = 0, per_cu = 0;
        hipGetDevice(&dev); hipDeviceGetAttribute(&cus, hipDeviceAttributeMultiprocessorCount, dev);
        hipFuncSetAttribute((const void*)fwd_megakernel, hipFuncAttributeMaxDynamicSharedMemorySize, LDS_BYTES);
        if (hipOccupancyMaxActiveBlocksPerMultiprocessor(&per_cu, (const void*)fwd_megakernel, 512, LDS_BYTES) != hipSuccess || per_cu < 1) { fprintf(stderr, "kernel_launch: occupancy query gave %d\n", per_cu); per_cu = 1; }
        (void)hipGetLastError();
        grid = cus * per_cu;
    }
    if (grid < 0) return;
    (void)hipMemsetAsync((unsigned char*)d_ws + WS_BAR, 0, XCD_BAR_WORDS * 4, stream);
    Args a{};
    for (int i = 0; i < 23; ++i) a.in[i] = (const float*)d_in[i];
    a.out = (float*)d_out; a.ws = (unsigned char*)d_ws;
#if MK_PER_PHASE
    for (int ph = 0; ph < N_PHASES; ++ph) { a.lo = ph; a.hi = ph + 1; hipLaunchKernelGGL(fwd_megakernel, dim3(grid), dim3(512), LDS_BYTES, stream, a); }
#else
    a.lo = 0; a.hi = N_PHASES;
    void* kargs[] = {&a};
    hipError_t e = hipLaunchCooperativeKernel((const void*)fwd_megakernel, dim3(grid), dim3(512), kargs, LDS_BYTES, stream);
    if (e != hipSuccess) fprintf(stderr, "cooperative launch failed: %s (grid %d)\n", hipGetErrorString(e), grid);
#endif
}
```

```cpp
#include <hip/hip_runtime.h>
#include <hip/hip_cooperative_groups.h>
#include <cstdio>
#include <cstdint>
namespace cg = cooperative_groups;

#ifndef MK_PER_PHASE
#define MK_PER_PHASE 0
#endif

#ifndef LAST_PH
#define LAST_PH 99
#endif
#define LAS __attribute__((address_space(3)))
typedef unsigned short bf16_t;
typedef short bf16x8 __attribute__((ext_vector_type(8)));
typedef float f32x4 __attribute__((ext_vector_type(4)));
typedef float f32x2 __attribute__((ext_vector_type(2)));
typedef unsigned u32x4 __attribute__((ext_vector_type(4)));
typedef unsigned u32x2 __attribute__((ext_vector_type(2)));

constexpr int D = 1024, NB = 8, SEQ = 2048, M = NB * SEQ, FF = 4096, MEML = 256, MEMR = NB * MEML, CW = 31;
constexpr float RMS_EPS = 1e-6f, LN_EPS = 1e-5f;
constexpr float LOG2E = 1.4426950408889634f;
typedef unsigned long long u64;
constexpr float SSQ_SCALE = 1048576.0f, SSQ_INV = 1.0f / (1048576.0f * 1024.0f);
__device__ __forceinline__ float rstd_of(u64 q) { return rsqrtf((float)q * SSQ_INV + 1e-6f); }

constexpr size_t MiB = 1u << 20;
constexpr size_t WS_SSQ = 0;
constexpr size_t WS_BAR = 2 * MiB - 32768;
constexpr size_t WS_LW = 2 * MiB;
constexpr size_t LW_SET = 26 * MiB;
constexpr size_t LW_WIN = 0, LW_WOUT = 4 * MiB, LW_WQ = 6 * MiB, LW_WO = 8 * MiB, LW_W1 = 10 * MiB, LW_W2 = 18 * MiB;
constexpr size_t WS_XB = WS_LW + 2 * LW_SET;
constexpr size_t WS_KALL = WS_XB + 32 * MiB;
constexpr size_t WS_VT = WS_KALL + 16 * MiB;
constexpr size_t WS_H = WS_VT + 16 * MiB;
constexpr size_t WS_S0 = WS_H, WS_S1 = WS_H + 32 * MiB, WS_S2 = WS_H + 64 * MiB, WS_S3 = WS_H + 96 * MiB;
constexpr size_t WS_WKT = WS_S3, WS_WVT = WS_S3 + 8 * MiB, WS_MEMN = WS_S3 + 16 * MiB;
constexpr size_t WS_END = WS_H + 128 * MiB;

constexpr int RING_BYTES = 131072, EX_OFF = RING_BYTES, BARST_OFF = RING_BYTES + 8192, PTAB_OFF = BARST_OFF + 64, LDS_BYTES = RING_BYTES + 8192 + 2048;

__device__ __forceinline__ unsigned cvt_pk_bf16(float lo, float hi) { unsigned r; asm volatile("v_cvt_pk_bf16_f32 %0, %1, %2" : "=v"(r) : "v"(lo), "v"(hi)); return r; }
__device__ __forceinline__ float shx(float v, int lane, int o) { return __int_as_float(__builtin_amdgcn_ds_bpermute((lane ^ o) << 2, __float_as_int(v))); }
__device__ __forceinline__ float wave_sum(float v, int lane) {
#pragma unroll
    for (int o = 1; o < 64; o <<= 1) v += shx(v, lane, o);
    return v;
}
__device__ __forceinline__ float bf_lo(unsigned u) { return __uint_as_float(u << 16); }
__device__ __forceinline__ float bf_hi(unsigned u) { return __uint_as_float(u & 0xffff0000u); }

namespace pg8 {
constexpr int BM = 256, BK = 64, HALF = 128, HTB = HALF * BK * 2, STAGE_BYTES = 8 * HTB, NXCD = 8, WGM = 8;
__host__ __device__ __forceinline__ int lds_byte(int r, int c) { const int st = (r >> 4) * 2 + (c >> 5), rr = r & 15, cc = c & 31, ob = rr * 64 + cc * 2; return st * 1024 + (ob ^ (((ob >> 9) & 1) << 5)); }
__host__ __device__ __forceinline__ void stage_rc(int b, int& R, int& C) { const int st = b / 1024, sb = b % 1024, swz = sb ^ (((sb >> 9) & 1) << 5); R = (st >> 1) * 16 + swz / 64; C = (st & 1) * 32 + (swz % 64) / 2; }
__host__ __device__ __forceinline__ int perm32(int rho) { const int n = rho >> 4, i = rho & 15; return 8 * (i >> 2) + 4 * n + (i & 3); }

struct Unit { int pm, pn; };
struct Gemm { const bf16_t* A; const bf16_t* Bt; int lda, ldb, K; long a_pm, a_pn, b_pn, b_b; };

struct Order {
    int nM, nN, nwg, G, c;
    __device__ __forceinline__ void init(int nM_, int nN_, int G_, int c_) { nM = nM_; nN = nN_; nwg = nM * nN; G = G_; c = c_; }
    __device__ __forceinline__ bool next(int i, Unit& u) const {
        const long L = (long)i * G + c; if (L >= nwg) return false;
        int wgid = (int)L; { const int q = nwg / NXCD, r = nwg % NXCD, xcd = wgid % NXCD, off = wgid / NXCD; wgid = (xcd < r ? xcd * (q + 1) : r * (q + 1) + (xcd - r) * q) + off; }
        const int nig = WGM * nN, gid = wgid / nig, fm = gid * WGM, gsz = (nM - fm) < WGM ? (nM - fm) : WGM;
        u.pm = fm + ((wgid % nig) % gsz); u.pn = (wgid % nig) / gsz; return true;
    }
};


struct EpiBf {
    bf16_t* O; int ldc; const u64* ssq; float cs; int act;
    __device__ __forceinline__ void operator()(f32x4 (&acc)[2][2][4][2], const Unit& u, int wid, int lane_) const {
        int lane = lane_; asm volatile("" : "+v"(lane));
        const int wr = wid >> 2, wc = wid & 3, fr = lane & 15, fq = lane >> 4;
        const int row0 = u.pm * BM + wr * 64 + fr, col0 = u.pn * BM + wc * 32 + 8 * fq;
#pragma unroll
        for (int ai = 0; ai < 2; ++ai)
#pragma unroll
            for (int m = 0; m < 4; ++m) {
                const int r = row0 + ai * HALF + m * 16;
                float rs = cs; if (ssq) rs *= rstd_of(ssq[r]);
                bf16_t* rowp = O + (size_t)r * ldc + col0;
#pragma unroll
                for (int bj = 0; bj < 2; ++bj) {
                    f32x4 v0 = acc[ai][bj][m][0] * rs, v1 = acc[ai][bj][m][1] * rs;
                    if (act) {
#pragma unroll
                        for (int j = 0; j < 4; ++j) { const float a = fmaxf(v0[j], 0.f), b = fmaxf(v1[j], 0.f); v0[j] = a * a; v1[j] = b * b; }
                    }
                    u32x4 w; w.x = cvt_pk_bf16(v0[0], v0[1]); w.y = cvt_pk_bf16(v0[2], v0[3]); w.z = cvt_pk_bf16(v1[0], v1[1]); w.w = cvt_pk_bf16(v1[2], v1[3]);
                    *(u32x4*)(rowp + bj * HALF) = w;
                }
            }
    }
};
struct EpiGlu {
    bf16_t* O; const float* bias; const u64* ssq;
    __device__ __forceinline__ void operator()(f32x4 (&acc)[2][2][4][2], const Unit& u, int wid, int lane_) const {
        int lane = lane_; asm volatile("" : "+v"(lane));
        const int wr = wid >> 2, wc = wid & 3, fr = lane & 15, fq = lane >> 4;
        const int row0 = u.pm * BM + wr * 64 + fr, ch0 = u.pn * HALF + wc * 32 + 8 * fq;
        f32x4 ba[2], bg[2];
#pragma unroll
        for (int n = 0; n < 2; ++n) { ba[n] = *(const f32x4*)(bias + ch0 + 4 * n); bg[n] = *(const f32x4*)(bias + D + ch0 + 4 * n); }
#pragma unroll
        for (int ai = 0; ai < 2; ++ai)
#pragma unroll
            for (int m = 0; m < 4; ++m) {
                const int r = row0 + ai * HALF + m * 16;
                const float rs = rstd_of(ssq[r]);
                f32x4 o[2];
#pragma unroll
                for (int n = 0; n < 2; ++n) {
                    const f32x4 a = acc[ai][0][m][n] * rs + ba[n], g = acc[ai][1][m][n] * rs + bg[n];
#pragma unroll
                    for (int j = 0; j < 4; ++j) o[n][j] = a[j] * __builtin_amdgcn_rcpf(1.0f + __builtin_amdgcn_exp2f(-g[j] * LOG2E));
                }
                u32x4 w; w.x = cvt_pk_bf16(o[0][0], o[0][1]); w.y = cvt_pk_bf16(o[0][2], o[0][3]); w.z = cvt_pk_bf16(o[1][0], o[1][1]); w.w = cvt_pk_bf16(o[1][2], o[1][3]);
                *(u32x4*)(O + (size_t)r * D + ch0) = w;
            }
    }
};
struct EpiRes {
    bf16_t* xb; const float* bias; u64* ssq_next;
    __device__ __forceinline__ void operator()(f32x4 (&acc)[2][2][4][2], const Unit& u, int wid, int lane_) const {
        int lane = lane_; asm volatile("" : "+v"(lane));
        const int wr = wid >> 2, wc = wid & 3, fr = lane & 15, fq = lane >> 4;
        const int row0 = u.pm * BM + wr * 64 + fr, col0 = u.pn * BM + wc * 32 + 8 * fq;
        f32x4 bv[2][2];
#pragma unroll
        for (int bj = 0; bj < 2; ++bj)
#pragma unroll
            for (int n = 0; n < 2; ++n) bv[bj][n] = bias ? *(const f32x4*)(bias + col0 + bj * HALF + 4 * n) : (f32x4){0.f, 0.f, 0.f, 0.f};
#pragma unroll
        for (int ai = 0; ai < 2; ++ai)
#pragma unroll
            for (int m = 0; m < 4; ++m) {
                const int r = row0 + ai * HALF + m * 16; const size_t off = (size_t)r * D + col0;
                float ss = 0.f;
#pragma unroll
                for (int bj = 0; bj < 2; ++bj) {
                    const u32x4 xo = *(const u32x4*)(xb + off + bj * HALF);
                    f32x4 x0 = (f32x4){bf_lo(xo.x), bf_hi(xo.x), bf_lo(xo.y), bf_hi(xo.y)}, x1 = (f32x4){bf_lo(xo.z), bf_hi(xo.z), bf_lo(xo.w), bf_hi(xo.w)};
                    x0 += acc[ai][bj][m][0] + bv[bj][0]; x1 += acc[ai][bj][m][1] + bv[bj][1];
                    u32x4 w; w.x = cvt_pk_bf16(x0[0], x0[1]); w.y = cvt_pk_bf16(x0[2], x0[3]); w.z = cvt_pk_bf16(x1[0], x1[1]); w.w = cvt_pk_bf16(x1[2], x1[3]);
                    *(u32x4*)(xb + off + bj * HALF) = w;
                    x0 = (f32x4){bf_lo(w.x), bf_hi(w.x), bf_lo(w.y), bf_hi(w.y)}; x1 = (f32x4){bf_lo(w.z), bf_hi(w.z), bf_lo(w.w), bf_hi(w.w)};
                    ss += (x0[0] * x0[0] + x0[1] * x0[1]) + (x0[2] * x0[2] + x0[3] * x0[3]) + (x1[0] * x1[0] + x1[1] * x1[1]) + (x1[2] * x1[2] + x1[3] * x1[3]);
                }
                ss += shx(ss, lane, 16); ss += shx(ss, lane, 32);
                if (fq == 0) __hip_atomic_fetch_add(ssq_next + r, (u64)(ss * SSQ_SCALE), __ATOMIC_RELAXED, __HIP_MEMORY_SCOPE_AGENT);
            }
    }
};
struct EpiSoftmax {
    bf16_t* P; LAS f32x2* ex;
    __device__ __forceinline__ void operator()(f32x4 (&acc)[2][2][4][2], const Unit& u, int wid, int lane_) const {
        int lane = lane_; asm volatile("" : "+v"(lane));
        const int wr = wid >> 2, wc = wid & 3, fr = lane & 15, fq = lane >> 4;
        const int row0 = u.pm * BM + wr * 64 + fr, col0 = u.pn * BM + wc * 32 + 8 * fq;
        float mxs[2][4];
#pragma unroll
        for (int ai = 0; ai < 2; ++ai)
#pragma unroll
            for (int m = 0; m < 4; ++m) {
                float mx = -3.0e38f;
#pragma unroll
                for (int bj = 0; bj < 2; ++bj)
#pragma unroll
                    for (int n = 0; n < 2; ++n) { const f32x4 v = acc[ai][bj][m][n]; mx = fmaxf(mx, fmaxf(fmaxf(v[0], v[1]), fmaxf(v[2], v[3]))); }
                mx = fmaxf(mx, shx(mx, lane, 16)); mx = fmaxf(mx, shx(mx, lane, 32));
                float l = 0.f;
#pragma unroll
                for (int bj = 0; bj < 2; ++bj)
#pragma unroll
                    for (int n = 0; n < 2; ++n) { f32x4 v = acc[ai][bj][m][n];
#pragma unroll
                        for (int j = 0; j < 4; ++j) { v[j] = __builtin_amdgcn_exp2f((v[j] - mx) * LOG2E); l += v[j]; }
                        acc[ai][bj][m][n] = v; }
                l += shx(l, lane, 16); l += shx(l, lane, 32);
                mxs[ai][m] = mx;
                if (fq == 0) ex[(ai * HALF + wr * 64 + m * 16 + fr) * 4 + wc] = (f32x2){mx, l};
            }
        asm volatile("s_waitcnt lgkmcnt(0)" ::: "memory"); __builtin_amdgcn_s_barrier(); asm volatile("" ::: "memory");
#pragma unroll
        for (int ai = 0; ai < 2; ++ai)
#pragma unroll
            for (int m = 0; m < 4; ++m) {
                const int lr = ai * HALF + wr * 64 + m * 16 + fr;
                const f32x2 a = ex[lr * 4 + 0], b = ex[lr * 4 + 1], c = ex[lr * 4 + 2], d = ex[lr * 4 + 3];
                const float MX = fmaxf(fmaxf(a.x, b.x), fmaxf(c.x, d.x));
                const float L = a.y * __builtin_amdgcn_exp2f((a.x - MX) * LOG2E) + b.y * __builtin_amdgcn_exp2f((b.x - MX) * LOG2E)
                              + c.y * __builtin_amdgcn_exp2f((c.x - MX) * LOG2E) + d.y * __builtin_amdgcn_exp2f((d.x - MX) * LOG2E);
                const float f = __builtin_amdgcn_exp2f((mxs[ai][m] - MX) * LOG2E) / L;
                bf16_t* rowp = P + (size_t)(row0 + ai * HALF + m * 16) * D + col0;
#pragma unroll
                for (int bj = 0; bj < 2; ++bj) {
                    const f32x4 v0 = acc[ai][bj][m][0] * f, v1 = acc[ai][bj][m][1] * f;
                    u32x4 w; w.x = cvt_pk_bf16(v0[0], v0[1]); w.y = cvt_pk_bf16(v0[2], v0[3]); w.z = cvt_pk_bf16(v1[0], v1[1]); w.w = cvt_pk_bf16(v1[2], v1[3]);
                    *(u32x4*)(rowp + bj * HALF) = w;
                }
            }
        asm volatile("s_waitcnt lgkmcnt(0)" ::: "memory"); __builtin_amdgcn_s_barrier(); asm volatile("" ::: "memory");
    }
};

template <int LDSIMM, int GOFF>
__device__ __forceinline__ void glds_s(const char* sbase, unsigned voff, unsigned ldsbase) {
    asm volatile("s_add_u32 m0, %2, %3\n\ts_nop 0\n\tglobal_load_lds_dwordx4 %0, %1 offset:%4" :: "v"(voff), "s"(sbase), "s"(ldsbase), "i"(LDSIMM), "i"(GOFF) : "memory", "m0", "scc");
}
template <class Epi, bool ALIGN_EPI>
__device__ __forceinline__ void gemm_phase(LAS unsigned char* lds, const Gemm g, const Order& S, const Epi& E, const int tid) {
    const int wid = __builtin_amdgcn_readfirstlane(tid >> 6), lane = tid & 63, wr = wid >> 2, wc = wid & 3, fr = lane & 15, fq = lane >> 4;
    const int nt = g.K / BK;
    unsigned voffA[2], voffB[2];
#pragma unroll
    for (int i = 0; i < 2; ++i) { int R, C; stage_rc(tid * 16 + i * 8192, R, C); const int Rb = (R & ~31) + perm32(R & 31);
        voffA[i] = (unsigned)(R * g.lda + C) * 2u; voffB[i] = (unsigned)(Rb * g.ldb + C) * 2u; }
    const size_t kstep = (size_t)(BK * 2);
    const size_t hstepA = (size_t)HALF * g.lda * 2, hstepB = (size_t)HALF * g.ldb * 2;
    const unsigned ldsbase = (unsigned)(size_t)lds + (unsigned)wid * 1024u;
    const int aoff = lds_byte(wr * 64 + fr, fq * 8), boff = lds_byte(wc * 32 + fr, fq * 8);
#define PG8_SA(b, h) (((b) * 2 + (h)) * HTB)
#define PG8_SB(b, h) ((4 + (b) * 2 + (h)) * HTB)
#define PG8_STAGE(bufoff, gbase, voff) do { glds_s<(bufoff), 0>((const char*)(gbase), (voff)[0], ldsbase); glds_s<(bufoff) + 8192, 0>((const char*)(gbase), (voff)[1], ldsbase); } while (0)
#define PG8_LDA(dst, b, h) do { _Pragma("unroll") for (int m = 0; m < 4; ++m) _Pragma("unroll") for (int k = 0; k < 2; ++k) dst[m][k] = *(const LAS bf16x8*)(lds + PG8_SA(b, h) + aoff + m * 2048 + k * 1024); } while (0)
#define PG8_LDB(dst, b, h) do { _Pragma("unroll") for (int n = 0; n < 2; ++n) _Pragma("unroll") for (int k = 0; k < 2; ++k) dst[n][k] = *(const LAS bf16x8*)(lds + PG8_SB(b, h) + boff + n * 2048 + k * 1024); } while (0)
#define PG8_MMA(ai, bj, At, Bt) do { __builtin_amdgcn_s_setprio(1); _Pragma("unroll") for (int m = 0; m < 4; ++m) _Pragma("unroll") for (int n = 0; n < 2; ++n) _Pragma("unroll") for (int k = 0; k < 2; ++k) \
        acc[ai][bj][m][n] = __builtin_amdgcn_mfma_f32_16x16x32_bf16(Bt[n][k], At[m][k], acc[ai][bj][m][n], 0, 0, 0); __builtin_amdgcn_s_setprio(0); } while (0)
#define PG8_WAIT_V(n) asm volatile("s_waitcnt vmcnt(" #n ")" ::: "memory")
#define PG8_WAIT_L(n) asm volatile("s_waitcnt lgkmcnt(" #n ")" ::: "memory")
#define PG8_BAR __builtin_amdgcn_s_barrier()
#define PG8_SCHED __builtin_amdgcn_sched_barrier(0)
#define PG8_ABASE(u) ((const char*)(g.A + (size_t)(u).pm * g.a_pm + (size_t)(u).pn * g.a_pn))
#define PG8_BBASE(u) ((const char*)(g.Bt + (size_t)(u).pn * g.b_pn + (size_t)((u).pm >> 3) * g.b_b))
    Unit cur, nxt; int ui = 0;
    if (!S.next(0, cur)) return;
    f32x4 acc[2][2][4][2];
#pragma unroll
    for (int a = 0; a < 2; ++a)
#pragma unroll
        for (int b = 0; b < 2; ++b)
#pragma unroll
            for (int m = 0; m < 4; ++m)
#pragma unroll
                for (int n = 0; n < 2; ++n) acc[a][b][m][n] = (f32x4){0.f, 0.f, 0.f, 0.f};
    bf16x8 At[4][2], B0[2][2], B1[2][2];
    const char* cA = PG8_ABASE(cur); const char* cB = PG8_BBASE(cur);
    PG8_STAGE(PG8_SB(0, 0), cB, voffB); PG8_STAGE(PG8_SB(0, 1), cB + hstepB, voffB); PG8_STAGE(PG8_SA(0, 0), cA, voffA); PG8_STAGE(PG8_SA(0, 1), cA + hstepA, voffA);
    if (wr == 1) PG8_BAR;
    PG8_WAIT_V(2); PG8_BAR;
    PG8_STAGE(PG8_SB(1, 0), cB + kstep, voffB); PG8_STAGE(PG8_SA(1, 0), cA + kstep, voffA); PG8_STAGE(PG8_SB(1, 1), cB + hstepB + kstep, voffB);
    PG8_WAIT_V(6); PG8_BAR;
    for (;;) {
        const bool has_next = S.next(ui + 1, nxt);
        const char* nA = has_next ? PG8_ABASE(nxt) : cA; const char* nB = has_next ? PG8_BBASE(nxt) : cB;
        for (int t = 0; t < nt; t += 2) {
            const bool last = (t == nt - 2);
            const char* a1 = cA + (size_t)(t + 1) * kstep;
            const char* a2 = last ? nA : cA + (size_t)(t + 2) * kstep; const char* b2 = last ? nB : cB + (size_t)(t + 2) * kstep;
            const char* a3 = a2 + kstep; const char* b3 = b2 + kstep;
            PG8_LDB(B0, 0, 0); PG8_LDB(B1, 0, 1); PG8_SCHED; PG8_LDA(At, 0, 0); PG8_STAGE(PG8_SA(1, 1), a1 + hstepA, voffA);
            PG8_WAIT_V(8); PG8_WAIT_L(0); PG8_BAR; PG8_MMA(0, 0, At, B0); PG8_MMA(0, 1, At, B1); PG8_BAR; PG8_SCHED;
            PG8_LDA(At, 0, 1); PG8_STAGE(PG8_SB(0, 0), b2, voffB); PG8_STAGE(PG8_SB(0, 1), b2 + hstepB, voffB); PG8_STAGE(PG8_SA(0, 0), a2, voffA);
            PG8_WAIT_V(8); PG8_WAIT_L(0); PG8_BAR; PG8_MMA(1, 0, At, B0); PG8_MMA(1, 1, At, B1); PG8_BAR; PG8_SCHED;
            PG8_LDB(B0, 1, 0); PG8_LDB(B1, 1, 1); PG8_SCHED; PG8_LDA(At, 1, 0); PG8_STAGE(PG8_SA(0, 1), a2 + hstepA, voffA);
            PG8_WAIT_V(8); PG8_WAIT_L(0); PG8_BAR; PG8_MMA(0, 0, At, B0); PG8_MMA(0, 1, At, B1); PG8_BAR; PG8_SCHED;
            PG8_LDA(At, 1, 1); PG8_STAGE(PG8_SB(1, 0), b3, voffB); PG8_STAGE(PG8_SB(1, 1), b3 + hstepB, voffB); PG8_STAGE(PG8_SA(1, 0), a3, voffA);
            PG8_WAIT_V(8); PG8_WAIT_L(0); PG8_BAR; PG8_MMA(1, 0, At, B0); PG8_MMA(1, 1, At, B1); PG8_BAR; PG8_SCHED;
        }
        if constexpr (ALIGN_EPI) { if (wr == 0) PG8_BAR; }
        E(acc, cur, wid, lane);
        if (!has_next) break;
#pragma unroll
        for (int a = 0; a < 2; ++a)
#pragma unroll
            for (int b = 0; b < 2; ++b)
#pragma unroll
                for (int m = 0; m < 4; ++m)
#pragma unroll
                    for (int n = 0; n < 2; ++n) acc[a][b][m][n] = (f32x4){0.f, 0.f, 0.f, 0.f};
        cur = nxt; cA = nA; cB = nB; ++ui;
        if constexpr (ALIGN_EPI) { if (wr == 1) PG8_BAR; }
    }
    PG8_WAIT_V(0);
    if constexpr (!ALIGN_EPI) { if (wr == 0) PG8_BAR; }
    PG8_BAR;
#undef PG8_SA
#undef PG8_SB
#undef PG8_STAGE
#undef PG8_LDA
#undef PG8_LDB
#undef PG8_MMA
#undef PG8_WAIT_V
#undef PG8_WAIT_L
#undef PG8_BAR
#undef PG8_SCHED
#undef PG8_ABASE
#undef PG8_BBASE
}
}

struct TrItem { const float* W; int ldw, src_n0, k0; bf16_t* WT; int ldt, dst_n0; const float* rs; const float* cs; };
__device__ __forceinline__ void tr_load(const TrItem& d, float (&v)[32], int lane) {
    const float* wp = d.W + (size_t)(d.k0 + (lane >> 5)) * d.ldw + d.src_n0 + (lane & 31);
#pragma unroll
    for (int i = 0; i < 32; ++i) v[i] = wp[(size_t)(2 * i) * d.ldw];
}
__device__ __forceinline__ void tr_finish(const TrItem& d, const float (&v)[32], LAS float* scr, int lane) {
    const float csv = d.cs ? d.cs[d.src_n0 + (lane & 31)] : 1.0f;
#pragma unroll
    for (int i = 0; i < 32; ++i) { const int kk = 2 * i + (lane >> 5); float t = v[i]; if (d.rs) t *= d.rs[d.k0 + kk]; scr[kk * 33 + (lane & 31)] = t * csv; }
    asm volatile("s_waitcnt lgkmcnt(0)" ::: "memory");
    const int c = lane & 7;
#pragma unroll
    for (int j = 0; j < 4; ++j) { const int n = (lane >> 3) + 8 * j; const LAS float* s = scr + (8 * c) * 33 + n;
        u32x4 o; o.x = cvt_pk_bf16(s[0 * 33], s[1 * 33]); o.y = cvt_pk_bf16(s[2 * 33], s[3 * 33]); o.z = cvt_pk_bf16(s[4 * 33], s[5 * 33]); o.w = cvt_pk_bf16(s[6 * 33], s[7 * 33]);
        *(u32x4*)(d.WT + (size_t)(d.dst_n0 + n) * d.ldt + d.k0 + 8 * c) = o; }
    asm volatile("s_waitcnt lgkmcnt(0)" ::: "memory");
}
__device__ __forceinline__ bool conv_mat(int& r, const float* W, int K, int N, bf16_t* WT, const float* rs, const float* cs, bool glu, TrItem& d) {
    const int nblk = N / 32, items = (K / 64) * nblk;
    if (r >= items) { r -= items; return false; }
    const int kb = r / nblk, nb = r % nblk, n0 = nb * 32;
    d.W = W; d.ldw = N; d.src_n0 = glu ? ((n0 >> 8) * 128 + (n0 & 127) + ((n0 >> 7) & 1) * D) : n0; d.k0 = kb * 64; d.WT = WT; d.ldt = K; d.dst_n0 = n0; d.rs = rs; d.cs = cs;
    return true;
}

struct Args { const float* in[23]; float* out; unsigned char* ws; int lo, hi; };
typedef LAS const unsigned long long* PtrTab;
__device__ __forceinline__ const float* inptr(PtrTab tab, int k) {
    const unsigned long long v = tab[k];
    return (const float*)(((unsigned long long)(unsigned)__builtin_amdgcn_readfirstlane((int)(v >> 32)) << 32) | (unsigned long long)(unsigned)__builtin_amdgcn_readfirstlane((int)v));
}
#define INP(k) inptr(tab, (k))

__device__ __forceinline__ void decode_item(PtrTab tab, unsigned char* ws_, int i, int it, TrItem& d) {
    int r = it;
    if (i < 0) { constexpr int I1 = (D / 64) * (D / 32); const int mtx = it / I1, l = mtx & 3; r = it % I1;
        conv_mat(r, (mtx < 4 ? INP(17) : INP(18)) + (size_t)l * D * D, D, D, (bf16_t*)(ws_ + (mtx < 4 ? WS_WKT : WS_WVT)) + (size_t)l * D * D, nullptr, nullptr, false, d); return; }
    unsigned char* lw = ws_ + WS_LW + (size_t)(i & 1) * LW_SET; const int j = i >> 1;
    if (!(i & 1)) {
        if (conv_mat(r, INP(6) + (size_t)j * D * 2 * D, D, 2 * D, (bf16_t*)(lw + LW_WIN), INP(3) + i * D, nullptr, true, d)) return;
        if (conv_mat(r, INP(12) + (size_t)j * D * D, D, D, (bf16_t*)(lw + LW_WOUT), nullptr, nullptr, false, d)) return;
    } else {
        const int g = r >> 5;
        if (g < 4) { r &= 31; conv_mat(r, INP(14) + ((size_t)j * 4 + g) * 65536, 256, 256, (bf16_t*)(lw + LW_WIN) + (size_t)g * 65536, nullptr, INP(15) + j * D + g * 256, false, d); return; }
        r -= 128;
    }
    if (conv_mat(r, INP(16) + (size_t)i * D * D, D, D, (bf16_t*)(lw + LW_WQ), INP(4) + i * D, nullptr, false, d)) return;
    if (conv_mat(r, INP(19) + (size_t)i * D * D, D, D, (bf16_t*)(lw + LW_WO), nullptr, nullptr, false, d)) return;
    if (conv_mat(r, INP(20) + (size_t)i * D * FF, D, FF, (bf16_t*)(lw + LW_W1), INP(5) + i * D, nullptr, false, d)) return;
    conv_mat(r, INP(21) + (size_t)i * FF * D, FF, D, (bf16_t*)(lw + LW_W2), nullptr, nullptr, false, d);
}
__device__ __forceinline__ void convert_job(PtrTab tab, unsigned char* ws_, int i, LAS float* scr, int gw, int NGW, int lane) {
    const int I_MIX = !(i & 1) ? (D / 64) * (2 * D / 32) + (D / 64) * (D / 32) : 4 * (256 / 64) * (256 / 32);
    const int NITEMS = (i < 0) ? 8 * (D / 64) * (D / 32) : I_MIX + 2 * (D / 64) * (D / 32) + 2 * (D / 64) * (FF / 32);
    int it = gw; if (it >= NITEMS) return;
    TrItem d0; float v0[32];
    decode_item(tab, ws_, i, it, d0); tr_load(d0, v0, lane);
    for (;;) {
        const int it2 = it + NGW; const bool has = it2 < NITEMS;
        TrItem d1; float v1[32];
        if (has) { decode_item(tab, ws_, i, it2, d1); tr_load(d1, v1, lane); }
        tr_finish(d0, v0, scr, lane);
        if (!has) break;
        d0 = d1; it = it2;
#pragma unroll
        for (int q = 0; q < 32; ++q) v0[q] = v1[q];
    }
}

__device__ __forceinline__ void dw_phase(const bf16_t* GLU, bf16_t* V, const float* wdw, const float* bdw, const float* lng, const float* lnb, LAS float* red, int bid, int G, int tid) {
    const int lane = tid & 63, wave = tid >> 6;
    f32x2 wk[CW];
#pragma unroll
    for (int k = 0; k < CW; ++k) wk[k] = *(const f32x2*)(wdw + k * D + 2 * tid);
    const f32x2 bd = *(const f32x2*)(bdw + 2 * tid), lg = *(const f32x2*)(lng + 2 * tid), lb = *(const f32x2*)(lnb + 2 * tid);
    const unsigned* G32 = (const unsigned*)GLU; unsigned* V32 = (unsigned*)V;
    LAS f32x2* part = (LAS f32x2*)red;
    LAS f32x2* stat = (LAS f32x2*)(red + 256);
    const int ustart = (G == 256) ? (bid & 7) * 128 + (bid >> 3) * 4 : bid, ustep = (G == 256) ? 1 : G, uend = (G == 256) ? ustart + 4 : M / 16;
    unsigned raw[46];
    if (ustart < uend) { const int t0 = (ustart & 127) * 16; int vb = (ustart * 16 - 30) * 512 + tid; asm volatile("" : "+v"(vb));
#pragma unroll
        for (int r = 0; r < 46; ++r) raw[r] = (t0 - 30 + r >= 0) ? G32[vb + r * 512] : 0u; }
    for (int unit = ustart; unit < uend; unit += ustep) {
        const int t0 = (unit & 127) * 16, rowbase = unit * 16;
        f32x2 win[46];
#pragma unroll
        for (int r = 0; r < 46; ++r) win[r] = (f32x2){bf_lo(raw[r]), bf_hi(raw[r])};
        f32x2 o[16];
#pragma unroll
        for (int t = 0; t < 16; ++t) { f32x2 a = bd;
#pragma unroll
            for (int k = 0; k < CW; ++k) a = __builtin_elementwise_fma(wk[k], win[t + k], a);
            o[t] = a; }
        if (unit + ustep < uend) { const int nu = unit + ustep, nt0 = (nu & 127) * 16; int vb = (nu * 16 - 30) * 512 + tid; asm volatile("" : "+v"(vb));
#pragma unroll
            for (int r = 0; r < 46; ++r) raw[r] = (nt0 - 30 + r >= 0) ? G32[vb + r * 512] : 0u; }
#pragma unroll
        for (int t = 0; t < 16; ++t) {
            const float s1 = wave_sum(o[t].x + o[t].y, lane), s2 = wave_sum(o[t].x * o[t].x + o[t].y * o[t].y, lane);
            if (lane == 0) part[wave * 16 + t] = (f32x2){s1, s2};
        }
        asm volatile("s_waitcnt lgkmcnt(0)" ::: "memory"); __builtin_amdgcn_s_barrier(); asm volatile("" ::: "memory");
        if (tid < 16) { float s1 = 0.f, s2 = 0.f;
#pragma unroll
            for (int w = 0; w < 8; ++w) { const f32x2 p = part[w * 16 + tid]; s1 += p.x; s2 += p.y; }
            const float mean = s1 * (1.0f / D), var = fmaxf(s2 * (1.0f / D) - mean * mean, 0.f);
            stat[tid] = (f32x2){mean, rsqrtf(var + LN_EPS)}; }
        asm volatile("s_waitcnt lgkmcnt(0)" ::: "memory"); __builtin_amdgcn_s_barrier(); asm volatile("" ::: "memory");
#pragma unroll
        for (int t = 0; t < 16; ++t) {
            const f32x2 st = stat[t];
            float y0 = (o[t].x - st.x) * st.y * lg.x + lb.x, y1 = (o[t].y - st.x) * st.y * lg.y + lb.y;
            y0 = y0 * __builtin_amdgcn_rcpf(1.0f + __builtin_amdgcn_exp2f(-y0 * LOG2E)); y1 = y1 * __builtin_amdgcn_rcpf(1.0f + __builtin_amdgcn_exp2f(-y1 * LOG2E));
            V32[(size_t)(rowbase + t) * 512 + tid] = cvt_pk_bf16(y0, y1);
        }
        asm volatile("s_waitcnt lgkmcnt(0)" ::: "memory"); __builtin_amdgcn_s_barrier(); asm volatile("" ::: "memory");
    }
}

__device__ __forceinline__ float bcast_lane(float v, int k) { return __int_as_float(__builtin_amdgcn_readlane(__float_as_int(v), k)); }
template <int W>
__device__ __forceinline__ void pl_span(const bf16_t* XBs, const u64* ssq, bf16_t* PP, int unit0, int nsub, int tid, int lane, f32x2 g) {
    const unsigned* X32 = (const unsigned*)XBs; unsigned* P32 = (unsigned*)PP;
    const int t0 = (unit0 & 127) * 16, rowbase = unit0 * 16;
    const bool first = (t0 == 0);
    int vb = rowbase * 512 + tid; asm volatile("" : "+v"(vb));
    unsigned xh[W - 1], xc[16];
#pragma unroll
    for (int j = 0; j < W - 1; ++j) xh[j] = X32[vb + (first ? 0 : (j - (W - 1))) * 512];
    const int l5 = lane & 31;
    u64 q = ssq[rowbase + (l5 < 16 ? l5 : (first ? 0 : l5 - 32))];
#pragma unroll
    for (int j = 0; j < 16; ++j) xc[j] = X32[vb + j * 512];
    float rsl = rstd_of(q);
    f32x2 hist[W - 1]; f32x2 S = (f32x2){0.f, 0.f};
#pragma unroll
    for (int j = 0; j < W - 1; ++j) { const float r0 = bcast_lane(rsl, 32 - (W - 1) + j), rs = first ? 0.f : r0; hist[j] = (f32x2){bf_lo(xh[j]) * rs, bf_hi(xh[j]) * rs}; S += hist[j]; }
    constexpr float INVW = 1.0f / (float)W;
    for (int c = 0; c < nsub; ++c) {
        const bool more = (c + 1 < nsub);
        f32x2 ext[W - 1 + 16];
#pragma unroll
        for (int j = 0; j < W - 1; ++j) ext[j] = hist[j];
#pragma unroll
        for (int j = 0; j < 16; ++j) { const float rs = bcast_lane(rsl, j); ext[W - 1 + j] = (f32x2){bf_lo(xc[j]) * rs, bf_hi(xc[j]) * rs}; }
        const bool head = first && c == 0;
#pragma unroll
        for (int j = 0; j < 16; ++j) {
            S += ext[W - 1 + j];
            const float inv = head ? (1.0f / (float)((j + 1 < W) ? j + 1 : W)) : INVW;
            const f32x2 p = (S * inv - ext[W - 1 + j]) * g;
            P32[vb + (16 * c + j) * 512] = cvt_pk_bf16(p.x, p.y);
            S -= ext[j];
        }
#pragma unroll
        for (int j = 0; j < W - 1; ++j) hist[j] = ext[16 + j];
        if (more) {
#pragma unroll
            for (int j = 0; j < 16; ++j) xc[j] = X32[vb + (16 * (c + 1) + j) * 512];
            rsl = rstd_of(ssq[rowbase + 16 * (c + 1) + (lane & 15)]);
        }
    }
}
__device__ __forceinline__ void pl_phase(const bf16_t* X, const u64* ssq, const float* gain, bf16_t* PP, int bid, int G, int tid) {
    const f32x2 g = *(const f32x2*)(gain + 2 * tid); const int grp = __builtin_amdgcn_readfirstlane(tid >> 7), lane = tid & 63;
    const int ustart = (G == 256) ? (bid & 7) * 128 + (bid >> 3) * 4 : bid, ustep = (G == 256) ? 4 : G, uend = (G == 256) ? ustart + 4 : M / 16, nsub = (G == 256) ? 4 : 1;
    for (int unit = ustart; unit < uend; unit += ustep) {
        if (grp == 0) pl_span<2>(X, ssq, PP, unit, nsub, tid, lane, g);
        else if (grp == 1) pl_span<4>(X, ssq, PP, unit, nsub, tid, lane, g);
        else if (grp == 2) pl_span<8>(X, ssq, PP, unit, nsub, tid, lane, g);
        else pl_span<16>(X, ssq, PP, unit, nsub, tid, lane, g);
    }
}

#define XB_TMO      128
#define XB_XCNT(j)  (256  + 64 * (j))
#define XB_XSUB(j)  (1280 + 64 * (j))
#define XB_XGEN(j)  (2304 + 64 * (j))
#define XB_TOP      3328
#define XB_TOPGEN   3392
#define XB_LSUB(j)  (3456 + 64 * (j))
#define XB_LGEN(j)  (4480 + 64 * (j))
#define XB_GMASK(j) (5504 + (j))
#define XCD_BAR_WORDS 5632
#define XB_SPIN_CAP (1u << 18)
__device__ __forceinline__ unsigned xb_ld(unsigned* p)              { return __hip_atomic_load(p, __ATOMIC_RELAXED, __HIP_MEMORY_SCOPE_AGENT); }
__device__ __forceinline__ unsigned xb_add(unsigned* p, unsigned v) { return __hip_atomic_fetch_add(p, v, __ATOMIC_RELAXED, __HIP_MEMORY_SCOPE_AGENT); }
__device__ __forceinline__ unsigned xb_xcc_id() { return (unsigned)__builtin_amdgcn_s_getreg((3 << 11) | 20) & 0xFu; }
#define XB_SPIN(cond, bar) do { unsigned _sp = 0; while (cond) { __builtin_amdgcn_s_sleep(1); \
    if ((++_sp & 255u) == 0u) { if (xb_ld(&(bar)[XB_TMO])) break; if (_sp > XB_SPIN_CAP) { atomicAdd(&(bar)[XB_TMO], 1u); break; } } } } while (0)
struct XcdBarrier { unsigned* bar; unsigned x; volatile LAS unsigned* st; };
__device__ __forceinline__ void xcd_barrier_complete(unsigned* bar, unsigned x, unsigned& nloc, unsigned& nx) {
    const unsigned G = gridDim.x * gridDim.y * gridDim.z;
    unsigned sum, cnt, mine, sp = 0u;
    for (;;) {
        sum = 0u; cnt = 0u; mine = 0u;
#pragma unroll
        for (unsigned j = 0; j < 16; ++j) { const unsigned c = xb_ld(&bar[XB_XCNT(j)]); sum += c; cnt += (c > 0u) ? 1u : 0u; mine = (j == x) ? c : mine; }
        if (sum == G) break;
        __builtin_amdgcn_s_sleep(1);
        if ((++sp & 255u) == 0u) { if (xb_ld(&bar[XB_TMO])) break; if (sp > XB_SPIN_CAP) { atomicAdd(&bar[XB_TMO], 1u); break; } }
    }
    nloc = mine > 0u ? mine : 1u; nx = cnt > 0u ? cnt : 1u;
}
__device__ __forceinline__ void xcd_barrier(unsigned* bar_, volatile LAS unsigned* st_) {
    XcdBarrier b; b.bar = bar_; b.st = st_; b.x = xb_xcc_id();
    asm volatile("s_waitcnt vmcnt(0)" ::: "memory");
    __syncthreads();
    if (threadIdx.x == 0) {
        unsigned* bar = b.bar;
        __builtin_amdgcn_s_waitcnt(0);
        unsigned nloc = b.st[0], nx = b.st[1];
        if (nloc == 0u) { xcd_barrier_complete(bar, b.x, nloc, nx); b.st[0] = nloc; b.st[1] = nx; }
        const unsigned old = xb_add(&bar[XB_XSUB(b.x)], 1u);
        const unsigned gen = old / nloc;
        if (old + 1u == (gen + 1u) * nloc) {
            __builtin_amdgcn_fence(__ATOMIC_RELEASE, "agent");
            asm volatile("s_waitcnt vmcnt(0)" ::: "memory");
            const unsigned og = xb_add(&bar[XB_TOP], 1u);
            const unsigned tg = og / nx;
            if (og + 1u == (tg + 1u) * nx) xb_add(&bar[XB_TOPGEN], 1u);
            else XB_SPIN(xb_ld(&bar[XB_TOPGEN]) == tg, bar);
            __builtin_amdgcn_fence(__ATOMIC_ACQUIRE, "agent");
            xb_add(&bar[XB_XGEN(b.x)], 1u);
            asm volatile("s_waitcnt vmcnt(0)" ::: "memory");
        } else {
            XB_SPIN(xb_ld(&bar[XB_XGEN(b.x)]) == gen, bar);
            __builtin_amdgcn_fence(__ATOMIC_ACQUIRE, "agent");
            asm volatile("s_waitcnt vmcnt(0)" ::: "memory");
        }
    }
    __syncthreads();
}

__device__ __forceinline__ void xcd_local_barrier(unsigned* bar, unsigned grp, unsigned nloc) {
    asm volatile("s_waitcnt vmcnt(0)" ::: "memory");
    __syncthreads();
    if (threadIdx.x == 0) {
        __builtin_amdgcn_s_waitcnt(0);
        const unsigned old = xb_add(&bar[XB_LSUB(grp)], 1u);
        const unsigned gen = old / nloc;
        if (old + 1u == (gen + 1u) * nloc) xb_add(&bar[XB_LGEN(grp)], 1u);
        else XB_SPIN(xb_ld(&bar[XB_LGEN(grp)]) == gen, bar);
        __builtin_amdgcn_fence(__ATOMIC_ACQUIRE, "agent");
        asm volatile("s_waitcnt vmcnt(0)" ::: "memory");
    }
    __syncthreads();
}

enum { K_PRO = 0, K_KV, K_G1, K_DW, K_G2, K_PL, K_GP, K_GQ, K_S, K_PV, K_WO, K_UP, K_DOWN, K_FINAL };
constexpr int N_PHASES = 2 + 2 * 17 + 1;
__host__ __device__ __forceinline__ void decode_phase(int ph, int& kind, int& layer) {
    if (ph == 0) { kind = K_PRO; layer = 0; return; }
    if (ph == 1) { kind = K_KV; layer = 0; return; }
    if (ph == N_PHASES - 1) { kind = K_FINAL; layer = 0; return; }
    const int q = ph - 2, pair = q / 17, r = q % 17;
    if (r < 9) { layer = 2 * pair; kind = (r < 3) ? (K_G1 + r) : (K_GQ + (r - 3)); }
    else { layer = 2 * pair + 1; const int s = r - 9; kind = (s < 2) ? (K_PL + s) : (K_GQ + (s - 2)); }
}

__global__ void __launch_bounds__(512, 2) fwd_megakernel(Args args) {
    extern __shared__ __attribute__((aligned(16))) unsigned char lds_raw[];
    LAS unsigned char* lds = (LAS unsigned char*)lds_raw;
    const int G0 = gridDim.x, bid0 = blockIdx.x, bid = bid0;
    const int wave_s = __builtin_amdgcn_readfirstlane(threadIdx.x >> 6);
    unsigned char* ws = args.ws;
    u64* SSQ = (u64*)(ws + WS_SSQ);
    float* X = args.out;
    bf16_t* XB = (bf16_t*)(ws + WS_XB);
    bf16_t* KALL = (bf16_t*)(ws + WS_KALL); bf16_t* VT = (bf16_t*)(ws + WS_VT);
    bf16_t* S0 = (bf16_t*)(ws + WS_S0); bf16_t* S1 = (bf16_t*)(ws + WS_S1); bf16_t* S2 = (bf16_t*)(ws + WS_S2); bf16_t* HM = (bf16_t*)(ws + WS_H);
    LAS float* exf = (LAS float*)(lds + EX_OFF);
    if (threadIdx.x < 4) ((volatile LAS unsigned*)(lds + BARST_OFF))[threadIdx.x] = 0u;
    if (threadIdx.x == 0) {
#pragma unroll
        for (int k = 0; k < 23; ++k) ((LAS unsigned long long*)(lds + PTAB_OFF))[k] = (unsigned long long)args.in[k];
    }
    __syncthreads();
    PtrTab tab = (PtrTab)(lds + PTAB_OFF);
    if (threadIdx.x == 0) {
        unsigned* bar0 = (unsigned*)(args.ws + WS_BAR); const unsigned x = xb_xcc_id();
        (void)xb_add(bar0 + XB_XCNT(x), 1u); (void)__hip_atomic_fetch_or(bar0 + XB_GMASK(bid & 7), 1u << x, __ATOMIC_RELAXED, __HIP_MEMORY_SCOPE_AGENT);
    }
    if (args.lo < 0) cg::this_grid().sync();

#pragma unroll 1
    for (int ph = args.lo; ph < args.hi; ++ph) {
        int lane; asm volatile("v_mbcnt_lo_u32_b32 %0, -1, 0\n\tv_mbcnt_hi_u32_b32 %0, -1, %0" : "=v"(lane));
        int G = G0, bid = bid0, wave = wave_s; asm volatile("" : "+s"(G), "+s"(bid), "+s"(wave));
        const int tid = wave * 64 + lane;
        const int gw = bid * 8 + wave, NGW = G * 8;
        LAS float* scr = (LAS float*)(lds + wave * 16384);
        int kind, i; decode_phase(ph, kind, i);
        if (ph >= LAST_PH && ph < N_PHASES - 1) kind = -1;
        const int j = i >> 1;
        unsigned char* lw = ws + WS_LW + (size_t)(i & 1) * LW_SET;
        switch (kind) {
        case K_PRO: {
            { unsigned z = 0u; asm volatile("" : "+v"(z));
              for (int u = bid * 512 + tid; u < 12 * M / 2; u += G * 512) ((u32x4*)(SSQ + M))[u] = (u32x4){z, z, z, z}; }
            convert_job(tab, ws, -1, scr, gw, NGW, lane);
            for (int m = gw; m < MEMR; m += NGW) {
                const f32x4* xr = (const f32x4*)(INP(1) + (size_t)m * D) + lane; f32x4 v[4]; float s = 0.f;
#pragma unroll
                for (int q = 0; q < 4; ++q) { v[q] = xr[64 * q]; s += (v[q].x * v[q].x + v[q].y * v[q].y) + (v[q].z * v[q].z + v[q].w * v[q].w); }
                const float rs = rsqrtf(wave_sum(s, lane) * (1.0f / D) + RMS_EPS);
                u32x2* o8 = (u32x2*)((bf16_t*)(ws + WS_MEMN) + (size_t)m * D) + lane;
#pragma unroll
                for (int q = 0; q < 4; ++q) { const f32x4 gq = ((const f32x4*)INP(2))[lane + 64 * q]; u32x2 w; w.x = cvt_pk_bf16(v[q].x * rs * gq.x, v[q].y * rs * gq.y); w.y = cvt_pk_bf16(v[q].z * rs * gq.z, v[q].w * rs * gq.w); o8[64 * q] = w; }
            }
            const int m0 = (G == 256) ? (bid & 7) * SEQ + (bid >> 3) * 8 + wave : gw, mstep = (G == 256) ? 256 : NGW, mend = (G == 256) ? ((bid & 7) + 1) * SEQ : M;
            for (int m = m0; m < mend; m += mstep) {
                const f32x4* xr = (const f32x4*)(INP(0) + (size_t)m * D) + lane; f32x4 v[4]; float s = 0.f;
                u32x2* o8 = (u32x2*)(XB + (size_t)m * D) + lane;
#pragma unroll
                for (int q = 0; q < 4; ++q) { v[q] = xr[64 * q]; u32x2 w; w.x = cvt_pk_bf16(v[q].x, v[q].y); w.y = cvt_pk_bf16(v[q].z, v[q].w); o8[64 * q] = w;
                    const float a = bf_lo(w.x), b = bf_hi(w.x), c = bf_lo(w.y), d = bf_hi(w.y); s += (a * a + b * b) + (c * c + d * d); }
                s = wave_sum(s, lane);
                if (lane == 0) SSQ[m] = (u64)(s * SSQ_SCALE);
            }
            convert_job(tab, ws, 0, scr, gw, NGW, lane);
        } break;
        case K_KV: {
            {
                pg8::Gemm g{(const bf16_t*)(ws + WS_MEMN), (const bf16_t*)(ws + WS_WKT), D, D, D, 256L * D, 0, 256L * D, 0};
                pg8::Order S; S.init(MEMR / 256, 4 * D / 256, G, bid);
                pg8::EpiBf E{KALL, 4 * D, nullptr, 1.0f, 0};
                pg8::gemm_phase<pg8::EpiBf, true>(lds, g, S, E, tid);
            }
            {
                pg8::Gemm g{(const bf16_t*)(ws + WS_WVT), (const bf16_t*)(ws + WS_MEMN), D, D, D, 256L * D, 0, 256L * D, 0};
                pg8::Order S; S.init(4 * D / 256, MEMR / 256, G, (bid + G / 2) % G);
                pg8::EpiBf E{VT, MEMR, nullptr, 1.0f, 0};
                pg8::gemm_phase<pg8::EpiBf, true>(lds, g, S, E, tid);
            }
        } break;
        case K_G1: {
            pg8::Gemm g{XB, (const bf16_t*)(lw + LW_WIN), D, D, D, 256L * D, 0, 256L * D, 0};
            pg8::Order S; S.init(M / 256, 2 * D / 256, G, bid);
            pg8::EpiGlu E{S0, INP(7) + j * 2 * D, SSQ + (size_t)(3 * i) * M};
            pg8::gemm_phase<pg8::EpiGlu, true>(lds, g, S, E, tid);
        } break;
        case K_DW: {
            dw_phase(S0, S1, INP(8) + (size_t)j * CW * D, INP(9) + j * D, INP(10) + j * D, INP(11) + j * D, exf, bid, G, tid);
        } break;
        case K_PL: {
            pl_phase(XB, SSQ + (size_t)(3 * i) * M, INP(3) + i * D, S0, bid, G, tid);
        } break;
        case K_G2: case K_GP: case K_WO: case K_DOWN: {
            pg8::Gemm g; pg8::EpiRes E; E.xb = XB; E.bias = nullptr;
            if (kind == K_G2) { g = pg8::Gemm{S1, (const bf16_t*)(lw + LW_WOUT), D, D, D, 256L * D, 0, 256L * D, 0}; E.bias = INP(13) + j * D; E.ssq_next = SSQ + (size_t)(3 * i + 1) * M; }
            else if (kind == K_GP) { g = pg8::Gemm{S0, (const bf16_t*)(lw + LW_WIN), D, 256, 256, 256L * D, 256, 65536, 0}; E.ssq_next = SSQ + (size_t)(3 * i + 1) * M; }
            else if (kind == K_WO) { g = pg8::Gemm{S2, (const bf16_t*)(lw + LW_WO), D, D, D, 256L * D, 0, 256L * D, 0}; E.ssq_next = SSQ + (size_t)(3 * i + 2) * M; }
            else { g = pg8::Gemm{HM, (const bf16_t*)(lw + LW_W2), FF, FF, FF, 256L * FF, 0, 256L * FF, 0}; E.ssq_next = SSQ + (size_t)(3 * i + 3) * M; }
            pg8::Order S; S.init(M / 256, D / 256, G, bid);
            pg8::gemm_phase<pg8::EpiRes, true>(lds, g, S, E, tid);
        } break;
        case K_GQ: case K_UP: case K_PV: {
            pg8::Gemm g; pg8::EpiBf E; int nN = D / 256;
            if (kind == K_GQ) { g = pg8::Gemm{XB, (const bf16_t*)(lw + LW_WQ), D, D, D, 256L * D, 0, 256L * D, 0}; E = pg8::EpiBf{S0, D, SSQ + (size_t)(3 * i + 1) * M, 0.0625f, 0}; }
            else if (kind == K_UP) { g = pg8::Gemm{XB, (const bf16_t*)(lw + LW_W1), D, D, D, 256L * D, 0, 256L * D, 0}; E = pg8::EpiBf{HM, FF, SSQ + (size_t)(3 * i + 2) * M, 1.0f, 1}; nN = FF / 256; }
            else { g = pg8::Gemm{S1, VT + (size_t)i * D * MEMR, D, MEMR, 256, 256L * D, 256, 256L * MEMR, 256}; E = pg8::EpiBf{S2, D, nullptr, 1.0f, 0}; }
            pg8::Order S; S.init(M / 256, nN, G, bid);
            pg8::gemm_phase<pg8::EpiBf, true>(lds, g, S, E, tid);
            if (kind == K_PV && i + 1 < 4) convert_job(tab, ws, i + 1, scr, gw, NGW, lane);
        } break;
        case K_S: {
            pg8::Gemm g{S0, KALL + (size_t)i * D, D, 4 * D, 256, 256L * D, 256, 256, 256L * 4 * D};
            pg8::Order S; S.init(M / 256, D / 256, G, bid);
            pg8::EpiSoftmax E{S1, (LAS f32x2*)exf};
            pg8::gemm_phase<pg8::EpiSoftmax, true>(lds, g, S, E, tid);
        } break;
        case K_FINAL: {
            const int m0 = (G == 256) ? (bid & 7) * SEQ + (bid >> 3) * 8 + wave : gw, mstep = (G == 256) ? 256 : NGW, mend = (G == 256) ? ((bid & 7) + 1) * SEQ : M;
            for (int m = m0; m < mend; m += mstep) {
                f32x4* xr = (f32x4*)(X + (size_t)m * D) + lane; const u32x2* xi = (const u32x2*)(XB + (size_t)m * D) + lane; f32x4 v[4]; float s = 0.f;
#pragma unroll
                for (int q = 0; q < 4; ++q) { const u32x2 w = xi[64 * q]; v[q] = (f32x4){bf_lo(w.x), bf_hi(w.x), bf_lo(w.y), bf_hi(w.y)}; s += (v[q].x * v[q].x + v[q].y * v[q].y) + (v[q].z * v[q].z + v[q].w * v[q].w); }
                const float rs = rsqrtf(wave_sum(s, lane) * (1.0f / D) + RMS_EPS);
#pragma unroll
                for (int q = 0; q < 4; ++q) { const f32x4 gq = ((const f32x4*)INP(22))[lane + 64 * q]; f32x4 o = v[q] * rs; o.x *= gq.x; o.y *= gq.y; o.z *= gq.z; o.w *= gq.w; xr[64 * q] = o; }
            }
        } break;
        }
        if (ph + 1 < args.hi) {
            unsigned* bar = (unsigned*)(args.ws + WS_BAR); volatile LAS unsigned* st = (volatile LAS unsigned*)(lds + BARST_OFF);
            if (kind == K_GQ || kind == K_S) {
                asm volatile("s_waitcnt vmcnt(0)" ::: "memory"); __syncthreads();
                if (threadIdx.x == 0) { __builtin_amdgcn_fence(__ATOMIC_ACQUIRE, "agent"); asm volatile("s_waitcnt vmcnt(0)" ::: "memory"); }
                __syncthreads();
            } else if (ph <= 1 || (kind == K_DOWN && i < 3) || st[2] != 1u) {
                xcd_barrier(bar, st);
                if (ph == 1) {
                    if (threadIdx.x == 0) { bool pure = (G == 256 && st[0] == 32u && st[1] == 8u);
#pragma unroll
                        for (int g8 = 0; g8 < 8; ++g8) pure = pure && (__builtin_popcount(xb_ld(bar + XB_GMASK(g8))) == 1);
                        st[2] = pure ? 1u : 2u; }
                    __syncthreads();
                }
            } else xcd_local_barrier(bar, (unsigned)(bid & 7), 32u);
        }
    }
}

extern "C" void kernel_launch(void* const* d_in, const int* in_sizes, int n_in, void* d_out, int out_size, void* d_ws, size_t ws_size, hipStream_t stream) {
    static int grid = 0;
    if (grid == 0) {
        if (n_in != 23 || out_size != M * D || ws_size < WS_END) { fprintf(stderr, "kernel_launch: unexpected problem (n_in %d out %d ws %zu)\n", n_in, out_size, ws_size); grid = -1; return; }
        int dev = 0, cus = 0, per_cu = 0;
        hipGetDevice(&dev); hipDeviceGetAttribute(&cus, hipDeviceAttributeMultiprocessorCount, dev);
        hipFuncSetAttribute((const void*)fwd_megakernel, hipFuncAttributeMaxDynamicSharedMemorySize, LDS_BYTES);
        if (hipOccupancyMaxActiveBlocksPerMultiprocessor(&per_cu, (const void*)fwd_megakernel, 512, LDS_BYTES) != hipSuccess || per_cu < 1) { fprintf(stderr, "kernel_launch: occupancy query gave %d\n", per_cu); per_cu = 1; }
        (void)hipGetLastError();
        grid = cus * per_cu;
    }
    if (grid < 0) return;
    (void)hipMemsetAsync((unsigned char*)d_ws + WS_BAR, 0, XCD_BAR_WORDS * 4, stream);
    Args a{};
    for (int i = 0; i < 23; ++i) a.in[i] = (const float*)d_in[i];
    a.out = (float*)d_out; a.ws = (unsigned char*)d_ws;
#if MK_PER_PHASE
    for (int ph = 0; ph < N_PHASES; ++ph) { a.lo = ph; a.hi = ph + 1; hipLaunchKernelGGL(fwd_megakernel, dim3(grid), dim3(512), LDS_BYTES, stream, a); }
#else
    a.lo = 0; a.hi = N_PHASES;
    void* kargs[] = {&a};
    hipError_t e = hipLaunchCooperativeKernel((const void*)fwd_megakernel, dim3(grid), dim3(512), kargs, LDS_BYTES, stream);
    if (e != hipSuccess) fprintf(stderr, "cooperative launch failed: %s (grid %d)\n", hipGetErrorString(e), grid);
#endif
}
```

```cpp
#include <hip/hip_runtime.h>
#include <hip/hip_cooperative_groups.h>
#include <cstdio>
#include <cstdint>
namespace cg = cooperative_groups;

#ifndef MK_PER_PHASE
#define MK_PER_PHASE 0
#endif

#ifndef LAST_PH
#define LAST_PH 99
#endif
#ifndef FORCE_FALLBACK
#define FORCE_FALLBACK 0
#endif
#define LAS __attribute__((address_space(3)))
typedef unsigned short bf16_t;
typedef short bf16x8 __attribute__((ext_vector_type(8)));
typedef float f32x4 __attribute__((ext_vector_type(4)));
typedef float f32x2 __attribute__((ext_vector_type(2)));
typedef unsigned u32x4 __attribute__((ext_vector_type(4)));
typedef unsigned u32x2 __attribute__((ext_vector_type(2)));

constexpr int D = 1024, NB = 8, SEQ = 2048, M = NB * SEQ, FF = 4096, MEML = 256, MEMR = NB * MEML, CW = 31;
constexpr float RMS_EPS = 1e-6f, LN_EPS = 1e-5f;
constexpr float LOG2E = 1.4426950408889634f;
typedef unsigned long long u64;
constexpr float SSQ_SCALE = 1048576.0f, SSQ_INV = 1.0f / (1048576.0f * 1024.0f);
__device__ __forceinline__ float rstd_of(u64 q) { return rsqrtf((float)q * SSQ_INV + 1e-6f); }

constexpr size_t MiB = 1u << 20;
constexpr size_t WS_SSQ = 0;
constexpr size_t WS_BAR = 2 * MiB - 32768;
constexpr size_t WS_LW = 2 * MiB;
constexpr size_t LW_SET = 26 * MiB;
constexpr size_t LW_WIN = 0, LW_WOUT = 4 * MiB, LW_WQ = 6 * MiB, LW_WO = 8 * MiB, LW_W1 = 10 * MiB, LW_W2 = 18 * MiB;
constexpr size_t WS_XB = WS_LW + 2 * LW_SET;
constexpr size_t WS_KALL = WS_XB + 32 * MiB;
constexpr size_t WS_VT = WS_KALL + 16 * MiB;
constexpr size_t WS_H = WS_VT + 16 * MiB;
constexpr size_t WS_S0 = WS_H, WS_S1 = WS_H + 32 * MiB, WS_S2 = WS_H + 64 * MiB, WS_S3 = WS_H + 96 * MiB;
constexpr size_t WS_WKT = WS_S3, WS_WVT = WS_S3 + 8 * MiB, WS_MEMN = WS_S3 + 16 * MiB;
constexpr size_t WS_END = WS_H + 128 * MiB;

constexpr int RING_BYTES = 131072, EX_OFF = RING_BYTES, BARST_OFF = RING_BYTES + 8192, PTAB_OFF = BARST_OFF + 64, LDS_BYTES = RING_BYTES + 8192 + 2048;

__device__ __forceinline__ unsigned cvt_pk_bf16(float lo, float hi) { unsigned r; asm volatile("v_cvt_pk_bf16_f32 %0, %1, %2" : "=v"(r) : "v"(lo), "v"(hi)); return r; }
__device__ __forceinline__ float shx(float v, int lane, int o) { return __int_as_float(__builtin_amdgcn_ds_bpermute((lane ^ o) << 2, __float_as_int(v))); }
__device__ __forceinline__ float wave_sum(float v, int lane) {
#pragma unroll
    for (int o = 1; o < 64; o <<= 1) v += shx(v, lane, o);
    return v;
}
__device__ __forceinline__ float bf_lo(unsigned u) { return __uint_as_float(u << 16); }
__device__ __forceinline__ float bf_hi(unsigned u) { return __uint_as_float(u & 0xffff0000u); }

namespace pg8 {
constexpr int BM = 256, BK = 64, HALF = 128, HTB = HALF * BK * 2, STAGE_BYTES = 8 * HTB, NXCD = 8, WGM = 8;
__host__ __device__ __forceinline__ int lds_byte(int r, int c) { const int st = (r >> 4) * 2 + (c >> 5), rr = r & 15, cc = c & 31, ob = rr * 64 + cc * 2; return st * 1024 + (ob ^ (((ob >> 9) & 1) << 5)); }
__host__ __device__ __forceinline__ void stage_rc(int b, int& R, int& C) { const int st = b / 1024, sb = b % 1024, swz = sb ^ (((sb >> 9) & 1) << 5); R = (st >> 1) * 16 + swz / 64; C = (st & 1) * 32 + (swz % 64) / 2; }
__host__ __device__ __forceinline__ int perm32(int rho) { const int n = rho >> 4, i = rho & 15; return 8 * (i >> 2) + 4 * n + (i & 3); }

struct Unit { int pm, pn; };
struct Gemm { const bf16_t* A; const bf16_t* Bt; int lda, ldb, K; long a_pm, a_pn, b_pn, b_b; };

struct Order {
    int nM, nN, nwg, G, c;
    __device__ __forceinline__ void init(int nM_, int nN_, int G_, int c_) { nM = nM_; nN = nN_; nwg = nM * nN; G = G_; c = c_; }
    __device__ __forceinline__ bool next(int i, Unit& u) const {
        const long L = (long)i * G + c; if (L >= nwg) return false;
        int wgid = (int)L; { const int q = nwg / NXCD, r = nwg % NXCD, xcd = wgid % NXCD, off = wgid / NXCD; wgid = (xcd < r ? xcd * (q + 1) : r * (q + 1) + (xcd - r) * q) + off; }
        const int nig = WGM * nN, gid = wgid / nig, fm = gid * WGM, gsz = (nM - fm) < WGM ? (nM - fm) : WGM;
        u.pm = fm + ((wgid % nig) % gsz); u.pn = (wgid % nig) / gsz; return true;
    }
};


struct EpiBf {
    bf16_t* O; int ldc; const u64* ssq; float cs; int act;
    __device__ __forceinline__ void operator()(f32x4 (&acc)[2][2][4][2], const Unit& u, int wid, int lane_) const {
        int lane = lane_; asm volatile("" : "+v"(lane));
        const int wr = wid >> 2, wc = wid & 3, fr = lane & 15, fq = lane >> 4;
        const int row0 = u.pm * BM + wr * 64 + fr, col0 = u.pn * BM + wc * 32 + 8 * fq;
#pragma unroll
        for (int ai = 0; ai < 2; ++ai)
#pragma unroll
            for (int m = 0; m < 4; ++m) {
                const int r = row0 + ai * HALF + m * 16;
                float rs = cs; if (ssq) rs *= rstd_of(ssq[r]);
                bf16_t* rowp = O + (size_t)r * ldc + col0;
#pragma unroll
                for (int bj = 0; bj < 2; ++bj) {
                    f32x4 v0 = acc[ai][bj][m][0] * rs, v1 = acc[ai][bj][m][1] * rs;
                    if (act) {
#pragma unroll
                        for (int j = 0; j < 4; ++j) { const float a = fmaxf(v0[j], 0.f), b = fmaxf(v1[j], 0.f); v0[j] = a * a; v1[j] = b * b; }
                    }
                    u32x4 w; w.x = cvt_pk_bf16(v0[0], v0[1]); w.y = cvt_pk_bf16(v0[2], v0[3]); w.z = cvt_pk_bf16(v1[0], v1[1]); w.w = cvt_pk_bf16(v1[2], v1[3]);
                    *(u32x4*)(rowp + bj * HALF) = w;
                }
            }
    }
};
struct EpiGlu {
    bf16_t* O; const float* bias; const u64* ssq;
    __device__ __forceinline__ void operator()(f32x4 (&acc)[2][2][4][2], const Unit& u, int wid, int lane_) const {
        int lane = lane_; asm volatile("" : "+v"(lane));
        const int wr = wid >> 2, wc = wid & 3, fr = lane & 15, fq = lane >> 4;
        const int row0 = u.pm * BM + wr * 64 + fr, ch0 = u.pn * HALF + wc * 32 + 8 * fq;
        f32x4 ba[2], bg[2];
#pragma unroll
        for (int n = 0; n < 2; ++n) { ba[n] = *(const f32x4*)(bias + ch0 + 4 * n); bg[n] = *(const f32x4*)(bias + D + ch0 + 4 * n); }
#pragma unroll
        for (int ai = 0; ai < 2; ++ai)
#pragma unroll
            for (int m = 0; m < 4; ++m) {
                const int r = row0 + ai * HALF + m * 16;
                const float rs = rstd_of(ssq[r]);
                f32x4 o[2];
#pragma unroll
                for (int n = 0; n < 2; ++n) {
                    const f32x4 a = acc[ai][0][m][n] * rs + ba[n], g = acc[ai][1][m][n] * rs + bg[n];
#pragma unroll
                    for (int j = 0; j < 4; ++j) o[n][j] = a[j] * __builtin_amdgcn_rcpf(1.0f + __builtin_amdgcn_exp2f(-g[j] * LOG2E));
                }
                u32x4 w; w.x = cvt_pk_bf16(o[0][0], o[0][1]); w.y = cvt_pk_bf16(o[0][2], o[0][3]); w.z = cvt_pk_bf16(o[1][0], o[1][1]); w.w = cvt_pk_bf16(o[1][2], o[1][3]);
                *(u32x4*)(O + (size_t)r * D + ch0) = w;
            }
    }
};
struct EpiRes {
    bf16_t* xb; const float* bias; u64* ssq_next;
    __device__ __forceinline__ void operator()(f32x4 (&acc)[2][2][4][2], const Unit& u, int wid, int lane_) const {
        int lane = lane_; asm volatile("" : "+v"(lane));
        const int wr = wid >> 2, wc = wid & 3, fr = lane & 15, fq = lane >> 4;
        const int row0 = u.pm * BM + wr * 64 + fr, col0 = u.pn * BM + wc * 32 + 8 * fq;
        f32x4 bv[2][2];
#pragma unroll
        for (int bj = 0; bj < 2; ++bj)
#pragma unroll
            for (int n = 0; n < 2; ++n) bv[bj][n] = bias ? *(const f32x4*)(bias + col0 + bj * HALF + 4 * n) : (f32x4){0.f, 0.f, 0.f, 0.f};
#pragma unroll
        for (int ai = 0; ai < 2; ++ai)
#pragma unroll
            for (int m = 0; m < 4; ++m) {
                const int r = row0 + ai * HALF + m * 16; const size_t off = (size_t)r * D + col0;
                float ss = 0.f;
#pragma unroll
                for (int bj = 0; bj < 2; ++bj) {
                    const u32x4 xo = *(const u32x4*)(xb + off + bj * HALF);
                    f32x4 x0 = (f32x4){bf_lo(xo.x), bf_hi(xo.x), bf_lo(xo.y), bf_hi(xo.y)}, x1 = (f32x4){bf_lo(xo.z), bf_hi(xo.z), bf_lo(xo.w), bf_hi(xo.w)};
                    x0 += acc[ai][bj][m][0] + bv[bj][0]; x1 += acc[ai][bj][m][1] + bv[bj][1];
                    u32x4 w; w.x = cvt_pk_bf16(x0[0], x0[1]); w.y = cvt_pk_bf16(x0[2], x0[3]); w.z = cvt_pk_bf16(x1[0], x1[1]); w.w = cvt_pk_bf16(x1[2], x1[3]);
                    *(u32x4*)(xb + off + bj * HALF) = w;
                    x0 = (f32x4){bf_lo(w.x), bf_hi(w.x), bf_lo(w.y), bf_hi(w.y)}; x1 = (f32x4){bf_lo(w.z), bf_hi(w.z), bf_lo(w.w), bf_hi(w.w)};
                    ss += (x0[0] * x0[0] + x0[1] * x0[1]) + (x0[2] * x0[2] + x0[3] * x0[3]) + (x1[0] * x1[0] + x1[1] * x1[1]) + (x1[2] * x1[2] + x1[3] * x1[3]);
                }
                ss += shx(ss, lane, 16); ss += shx(ss, lane, 32);
                if (fq == 0) __hip_atomic_fetch_add(ssq_next + r, (u64)(ss * SSQ_SCALE), __ATOMIC_RELAXED, __HIP_MEMORY_SCOPE_AGENT);
            }
    }
};
struct EpiSoftmax {
    bf16_t* P; LAS f32x2* ex;
    __device__ __forceinline__ void operator()(f32x4 (&acc)[2][2][4][2], const Unit& u, int wid, int lane_) const {
        int lane = lane_; asm volatile("" : "+v"(lane));
        const int wr = wid >> 2, wc = wid & 3, fr = lane & 15, fq = lane >> 4;
        const int row0 = u.pm * BM + wr * 64 + fr, col0 = u.pn * BM + wc * 32 + 8 * fq;
        float mxs[2][4];
#pragma unroll
        for (int ai = 0; ai < 2; ++ai)
#pragma unroll
            for (int m = 0; m < 4; ++m) {
                float mx = -3.0e38f;
#pragma unroll
                for (int bj = 0; bj < 2; ++bj)
#pragma unroll
                    for (int n = 0; n < 2; ++n) { const f32x4 v = acc[ai][bj][m][n]; mx = fmaxf(mx, fmaxf(fmaxf(v[0], v[1]), fmaxf(v[2], v[3]))); }
                mx = fmaxf(mx, shx(mx, lane, 16)); mx = fmaxf(mx, shx(mx, lane, 32));
                float l = 0.f;
#pragma unroll
                for (int bj = 0; bj < 2; ++bj)
#pragma unroll
                    for (int n = 0; n < 2; ++n) { f32x4 v = acc[ai][bj][m][n];
#pragma unroll
                        for (int j = 0; j < 4; ++j) { v[j] = __builtin_amdgcn_exp2f((v[j] - mx) * LOG2E); l += v[j]; }
                        acc[ai][bj][m][n] = v; }
                l += shx(l, lane, 16); l += shx(l, lane, 32);
                mxs[ai][m] = mx;
                if (fq == 0) ex[(ai * HALF + wr * 64 + m * 16 + fr) * 4 + wc] = (f32x2){mx, l};
            }
        asm volatile("s_waitcnt lgkmcnt(0)" ::: "memory"); __builtin_amdgcn_s_barrier(); asm volatile("" ::: "memory");
#pragma unroll
        for (int ai = 0; ai < 2; ++ai)
#pragma unroll
            for (int m = 0; m < 4; ++m) {
                const int lr = ai * HALF + wr * 64 + m * 16 + fr;
                const f32x2 a = ex[lr * 4 + 0], b = ex[lr * 4 + 1], c = ex[lr * 4 + 2], d = ex[lr * 4 + 3];
                const float MX = fmaxf(fmaxf(a.x, b.x), fmaxf(c.x, d.x));
                const float L = a.y * __builtin_amdgcn_exp2f((a.x - MX) * LOG2E) + b.y * __builtin_amdgcn_exp2f((b.x - MX) * LOG2E)
                              + c.y * __builtin_amdgcn_exp2f((c.x - MX) * LOG2E) + d.y * __builtin_amdgcn_exp2f((d.x - MX) * LOG2E);
                const float f = __builtin_amdgcn_exp2f((mxs[ai][m] - MX) * LOG2E) / L;
                bf16_t* rowp = P + (size_t)(row0 + ai * HALF + m * 16) * D + col0;
#pragma unroll
                for (int bj = 0; bj < 2; ++bj) {
                    const f32x4 v0 = acc[ai][bj][m][0] * f, v1 = acc[ai][bj][m][1] * f;
                    u32x4 w; w.x = cvt_pk_bf16(v0[0], v0[1]); w.y = cvt_pk_bf16(v0[2], v0[3]); w.z = cvt_pk_bf16(v1[0], v1[1]); w.w = cvt_pk_bf16(v1[2], v1[3]);
                    *(u32x4*)(rowp + bj * HALF) = w;
                }
            }
        asm volatile("s_waitcnt lgkmcnt(0)" ::: "memory"); __builtin_amdgcn_s_barrier(); asm volatile("" ::: "memory");
    }
};

template <int LDSIMM, int GOFF>
__device__ __forceinline__ void glds_s(const char* sbase, unsigned voff, unsigned ldsbase) {
    asm volatile("s_add_u32 m0, %2, %3\n\ts_nop 0\n\tglobal_load_lds_dwordx4 %0, %1 offset:%4" :: "v"(voff), "s"(sbase), "s"(ldsbase), "i"(LDSIMM), "i"(GOFF) : "memory", "m0", "scc");
}
template <class Epi, bool ALIGN_EPI>
__device__ __forceinline__ void gemm_phase(LAS unsigned char* lds, const Gemm g, const Order& S, const Epi& E, const int tid) {
    const int wid = __builtin_amdgcn_readfirstlane(tid >> 6), lane = tid & 63, wr = wid >> 2, wc = wid & 3, fr = lane & 15, fq = lane >> 4;
    const int nt = g.K / BK;
    unsigned voffA[2], voffB[2];
#pragma unroll
    for (int i = 0; i < 2; ++i) { int R, C; stage_rc(tid * 16 + i * 8192, R, C); const int Rb = (R & ~31) + perm32(R & 31);
        voffA[i] = (unsigned)(R * g.lda + C) * 2u; voffB[i] = (unsigned)(Rb * g.ldb + C) * 2u; }
    const size_t kstep = (size_t)(BK * 2);
    const size_t hstepA = (size_t)HALF * g.lda * 2, hstepB = (size_t)HALF * g.ldb * 2;
    const unsigned ldsbase = (unsigned)(size_t)lds + (unsigned)wid * 1024u;
    const int aoff = lds_byte(wr * 64 + fr, fq * 8), boff = lds_byte(wc * 32 + fr, fq * 8);
#define PG8_SA(b, h) (((b) * 2 + (h)) * HTB)
#define PG8_SB(b, h) ((4 + (b) * 2 + (h)) * HTB)
#define PG8_STAGE(bufoff, gbase, voff) do { glds_s<(bufoff), 0>((const char*)(gbase), (voff)[0], ldsbase); glds_s<(bufoff) + 8192, 0>((const char*)(gbase), (voff)[1], ldsbase); } while (0)
#define PG8_LDA(dst, b, h) do { _Pragma("unroll") for (int m = 0; m < 4; ++m) _Pragma("unroll") for (int k = 0; k < 2; ++k) dst[m][k] = *(const LAS bf16x8*)(lds + PG8_SA(b, h) + aoff + m * 2048 + k * 1024); } while (0)
#define PG8_LDB(dst, b, h) do { _Pragma("unroll") for (int n = 0; n < 2; ++n) _Pragma("unroll") for (int k = 0; k < 2; ++k) dst[n][k] = *(const LAS bf16x8*)(lds + PG8_SB(b, h) + boff + n * 2048 + k * 1024); } while (0)
#define PG8_MMA(ai, bj, At, Bt) do { __builtin_amdgcn_s_setprio(1); _Pragma("unroll") for (int m = 0; m < 4; ++m) _Pragma("unroll") for (int n = 0; n < 2; ++n) _Pragma("unroll") for (int k = 0; k < 2; ++k) \
        acc[ai][bj][m][n] = __builtin_amdgcn_mfma_f32_16x16x32_bf16(Bt[n][k], At[m][k], acc[ai][bj][m][n], 0, 0, 0); __builtin_amdgcn_s_setprio(0); } while (0)
#define PG8_WAIT_V(n) asm volatile("s_waitcnt vmcnt(" #n ")" ::: "memory")
#define PG8_WAIT_L(n) asm volatile("s_waitcnt lgkmcnt(" #n ")" ::: "memory")
#define PG8_BAR __builtin_amdgcn_s_barrier()
#define PG8_SCHED __builtin_amdgcn_sched_barrier(0)
#define PG8_ABASE(u) ((const char*)(g.A + (size_t)(u).pm * g.a_pm + (size_t)(u).pn * g.a_pn))
#define PG8_BBASE(u) ((const char*)(g.Bt + (size_t)(u).pn * g.b_pn + (size_t)((u).pm >> 3) * g.b_b))
    Unit cur, nxt; int ui = 0;
    if (!S.next(0, cur)) return;
    f32x4 acc[2][2][4][2];
#pragma unroll
    for (int a = 0; a < 2; ++a)
#pragma unroll
        for (int b = 0; b < 2; ++b)
#pragma unroll
            for (int m = 0; m < 4; ++m)
#pragma unroll
                for (int n = 0; n < 2; ++n) acc[a][b][m][n] = (f32x4){0.f, 0.f, 0.f, 0.f};
    bf16x8 At[4][2], B0[2][2], B1[2][2];
    const char* cA = PG8_ABASE(cur); const char* cB = PG8_BBASE(cur);
    PG8_STAGE(PG8_SB(0, 0), cB, voffB); PG8_STAGE(PG8_SB(0, 1), cB + hstepB, voffB); PG8_STAGE(PG8_SA(0, 0), cA, voffA); PG8_STAGE(PG8_SA(0, 1), cA + hstepA, voffA);
    if (wr == 1) PG8_BAR;
    PG8_WAIT_V(2); PG8_BAR;
    PG8_STAGE(PG8_SB(1, 0), cB + kstep, voffB); PG8_STAGE(PG8_SA(1, 0), cA + kstep, voffA); PG8_STAGE(PG8_SB(1, 1), cB + hstepB + kstep, voffB);
    PG8_WAIT_V(6); PG8_BAR;
    for (;;) {
        const bool has_next = S.next(ui + 1, nxt);
        const char* nA = has_next ? PG8_ABASE(nxt) : cA; const char* nB = has_next ? PG8_BBASE(nxt) : cB;
        for (int t = 0; t < nt; t += 2) {
            const bool last = (t == nt - 2);
            const char* a1 = cA + (size_t)(t + 1) * kstep;
            const char* a2 = last ? nA : cA + (size_t)(t + 2) * kstep; const char* b2 = last ? nB : cB + (size_t)(t + 2) * kstep;
            const char* a3 = a2 + kstep; const char* b3 = b2 + kstep;
            PG8_LDB(B0, 0, 0); PG8_LDB(B1, 0, 1); PG8_SCHED; PG8_LDA(At, 0, 0); PG8_STAGE(PG8_SA(1, 1), a1 + hstepA, voffA);
            PG8_WAIT_V(8); PG8_WAIT_L(0); PG8_BAR; PG8_MMA(0, 0, At, B0); PG8_MMA(0, 1, At, B1); PG8_BAR; PG8_SCHED;
            PG8_LDA(At, 0, 1); PG8_STAGE(PG8_SB(0, 0), b2, voffB); PG8_STAGE(PG8_SB(0, 1), b2 + hstepB, voffB); PG8_STAGE(PG8_SA(0, 0), a2, voffA);
            PG8_WAIT_V(8); PG8_WAIT_L(0); PG8_BAR; PG8_MMA(1, 0, At, B0); PG8_MMA(1, 1, At, B1); PG8_BAR; PG8_SCHED;
            PG8_LDB(B0, 1, 0); PG8_LDB(B1, 1, 1); PG8_SCHED; PG8_LDA(At, 1, 0); PG8_STAGE(PG8_SA(0, 1), a2 + hstepA, voffA);
            PG8_WAIT_V(8); PG8_WAIT_L(0); PG8_BAR; PG8_MMA(0, 0, At, B0); PG8_MMA(0, 1, At, B1); PG8_BAR; PG8_SCHED;
            PG8_LDA(At, 1, 1); PG8_STAGE(PG8_SB(1, 0), b3, voffB); PG8_STAGE(PG8_SB(1, 1), b3 + hstepB, voffB); PG8_STAGE(PG8_SA(1, 0), a3, voffA);
            PG8_WAIT_V(8); PG8_WAIT_L(0); PG8_BAR; PG8_MMA(1, 0, At, B0); PG8_MMA(1, 1, At, B1); PG8_BAR; PG8_SCHED;
        }
        if constexpr (ALIGN_EPI) { if (wr == 0) PG8_BAR; }
        E(acc, cur, wid, lane);
        if (!has_next) break;
#pragma unroll
        for (int a = 0; a < 2; ++a)
#pragma unroll
            for (int b = 0; b < 2; ++b)
#pragma unroll
                for (int m = 0; m < 4; ++m)
#pragma unroll
                    for (int n = 0; n < 2; ++n) acc[a][b][m][n] = (f32x4){0.f, 0.f, 0.f, 0.f};
        cur = nxt; cA = nA; cB = nB; ++ui;
        if constexpr (ALIGN_EPI) { if (wr == 1) PG8_BAR; }
    }
    PG8_WAIT_V(0);
    if constexpr (!ALIGN_EPI) { if (wr == 0) PG8_BAR; }
    PG8_BAR;
#undef PG8_SA
#undef PG8_SB
#undef PG8_STAGE
#undef PG8_LDA
#undef PG8_LDB
#undef PG8_MMA
#undef PG8_WAIT_V
#undef PG8_WAIT_L
#undef PG8_BAR
#undef PG8_SCHED
#undef PG8_ABASE
#undef PG8_BBASE
}
}

struct TrItem { const float* W; int ldw, src_n0, k0; bf16_t* WT; int ldt, dst_n0; const float* rs; const float* cs; };
__device__ __forceinline__ void tr_load(const TrItem& d, float (&v)[32], int lane) {
    const float* wp = d.W + (size_t)(d.k0 + (lane >> 5)) * d.ldw + d.src_n0 + (lane & 31);
#pragma unroll
    for (int i = 0; i < 32; ++i) v[i] = wp[(size_t)(2 * i) * d.ldw];
}
__device__ __forceinline__ void tr_finish(const TrItem& d, const float (&v)[32], LAS float* scr, int lane) {
    const float csv = d.cs ? d.cs[d.src_n0 + (lane & 31)] : 1.0f;
#pragma unroll
    for (int i = 0; i < 32; ++i) { const int kk = 2 * i + (lane >> 5); float t = v[i]; if (d.rs) t *= d.rs[d.k0 + kk]; scr[kk * 33 + (lane & 31)] = t * csv; }
    asm volatile("s_waitcnt lgkmcnt(0)" ::: "memory");
    const int c = lane & 7;
#pragma unroll
    for (int j = 0; j < 4; ++j) { const int n = (lane >> 3) + 8 * j; const LAS float* s = scr + (8 * c) * 33 + n;
        u32x4 o; o.x = cvt_pk_bf16(s[0 * 33], s[1 * 33]); o.y = cvt_pk_bf16(s[2 * 33], s[3 * 33]); o.z = cvt_pk_bf16(s[4 * 33], s[5 * 33]); o.w = cvt_pk_bf16(s[6 * 33], s[7 * 33]);
        *(u32x4*)(d.WT + (size_t)(d.dst_n0 + n) * d.ldt + d.k0 + 8 * c) = o; }
    asm volatile("s_waitcnt lgkmcnt(0)" ::: "memory");
}
__device__ __forceinline__ bool conv_mat(int& r, const float* W, int K, int N, bf16_t* WT, const float* rs, const float* cs, bool glu, TrItem& d) {
    const int nblk = N / 32, items = (K / 64) * nblk;
    if (r >= items) { r -= items; return false; }
    const int kb = r / nblk, nb = r % nblk, n0 = nb * 32;
    d.W = W; d.ldw = N; d.src_n0 = glu ? ((n0 >> 8) * 128 + (n0 & 127) + ((n0 >> 7) & 1) * D) : n0; d.k0 = kb * 64; d.WT = WT; d.ldt = K; d.dst_n0 = n0; d.rs = rs; d.cs = cs;
    return true;
}

struct Args { const float* in[23]; float* out; unsigned char* ws; int lo, hi; };
typedef LAS const unsigned long long* PtrTab;
__device__ __forceinline__ const float* inptr(PtrTab tab, int k) {
    const unsigned long long v = tab[k];
    return (const float*)(((unsigned long long)(unsigned)__builtin_amdgcn_readfirstlane((int)(v >> 32)) << 32) | (unsigned long long)(unsigned)__builtin_amdgcn_readfirstlane((int)v));
}
#define INP(k) inptr(tab, (k))

__device__ __forceinline__ void decode_item(PtrTab tab, unsigned char* ws_, int i, int it, TrItem& d) {
    int r = it;
    if (i < 0) { constexpr int I1 = (D / 64) * (D / 32); const int mtx = it / I1, l = mtx & 3; r = it % I1;
        conv_mat(r, (mtx < 4 ? INP(17) : INP(18)) + (size_t)l * D * D, D, D, (bf16_t*)(ws_ + (mtx < 4 ? WS_WKT : WS_WVT)) + (size_t)l * D * D, nullptr, nullptr, false, d); return; }
    unsigned char* lw = ws_ + WS_LW + (size_t)(i & 1) * LW_SET; const int j = i >> 1;
    if (!(i & 1)) {
        if (conv_mat(r, INP(6) + (size_t)j * D * 2 * D, D, 2 * D, (bf16_t*)(lw + LW_WIN), INP(3) + i * D, nullptr, true, d)) return;
        if (conv_mat(r, INP(12) + (size_t)j * D * D, D, D, (bf16_t*)(lw + LW_WOUT), nullptr, nullptr, false, d)) return;
    } else {
        const int g = r >> 5;
        if (g < 4) { r &= 31; conv_mat(r, INP(14) + ((size_t)j * 4 + g) * 65536, 256, 256, (bf16_t*)(lw + LW_WIN) + (size_t)g * 65536, nullptr, INP(15) + j * D + g * 256, false, d); return; }
        r -= 128;
    }
    if (conv_mat(r, INP(16) + (size_t)i * D * D, D, D, (bf16_t*)(lw + LW_WQ), INP(4) + i * D, nullptr, false, d)) return;
    if (conv_mat(r, INP(19) + (size_t)i * D * D, D, D, (bf16_t*)(lw + LW_WO), nullptr, nullptr, false, d)) return;
    if (conv_mat(r, INP(20) + (size_t)i * D * FF, D, FF, (bf16_t*)(lw + LW_W1), INP(5) + i * D, nullptr, false, d)) return;
    conv_mat(r, INP(21) + (size_t)i * FF * D, FF, D, (bf16_t*)(lw + LW_W2), nullptr, nullptr, false, d);
}
__device__ __forceinline__ void convert_job(PtrTab tab, unsigned char* ws_, int i, LAS float* scr, int gw, int NGW, int lane) {
    const int I_MIX = !(i & 1) ? (D / 64) * (2 * D / 32) + (D / 64) * (D / 32) : 4 * (256 / 64) * (256 / 32);
    const int NITEMS = (i < 0) ? 8 * (D / 64) * (D / 32) : I_MIX + 2 * (D / 64) * (D / 32) + 2 * (D / 64) * (FF / 32);
    int it = gw; if (it >= NITEMS) return;
    TrItem d0; float v0[32];
    decode_item(tab, ws_, i, it, d0); tr_load(d0, v0, lane);
    for (;;) {
        const int it2 = it + NGW; const bool has = it2 < NITEMS;
        TrItem d1; float v1[32];
        if (has) { decode_item(tab, ws_, i, it2, d1); tr_load(d1, v1, lane); }
        tr_finish(d0, v0, scr, lane);
        if (!has) break;
        d0 = d1; it = it2;
#pragma unroll
        for (int q = 0; q < 32; ++q) v0[q] = v1[q];
    }
}

__device__ __forceinline__ void dw_phase(const bf16_t* GLU, bf16_t* V, const float* wdw, const float* bdw, const float* lng, const float* lnb, LAS float* red, int bid, int G, int tid) {
    const int lane = tid & 63, wave = tid >> 6;
    f32x2 wk[CW];
#pragma unroll
    for (int k = 0; k < CW; ++k) wk[k] = *(const f32x2*)(wdw + k * D + 2 * tid);
    const f32x2 bd = *(const f32x2*)(bdw + 2 * tid), lg = *(const f32x2*)(lng + 2 * tid), lb = *(const f32x2*)(lnb + 2 * tid);
    const unsigned* G32 = (const unsigned*)GLU; unsigned* V32 = (unsigned*)V;
    LAS f32x2* part = (LAS f32x2*)red;
    LAS f32x2* stat = (LAS f32x2*)(red + 256);
    const int ustart = (G == 256) ? (bid & 7) * 128 + (bid >> 3) * 4 : bid, ustep = (G == 256) ? 1 : G, uend = (G == 256) ? ustart + 4 : M / 16;
    unsigned raw[46];
    if (ustart < uend) { const int t0 = (ustart & 127) * 16; int vb = (ustart * 16 - 30) * 512 + tid; asm volatile("" : "+v"(vb));
#pragma unroll
        for (int r = 0; r < 46; ++r) raw[r] = (t0 - 30 + r >= 0) ? G32[vb + r * 512] : 0u; }
    for (int unit = ustart; unit < uend; unit += ustep) {
        const int t0 = (unit & 127) * 16, rowbase = unit * 16;
        f32x2 win[46];
#pragma unroll
        for (int r = 0; r < 46; ++r) win[r] = (f32x2){bf_lo(raw[r]), bf_hi(raw[r])};
        f32x2 o[16];
#pragma unroll
        for (int t = 0; t < 16; ++t) { f32x2 a = bd;
#pragma unroll
            for (int k = 0; k < CW; ++k) a = __builtin_elementwise_fma(wk[k], win[t + k], a);
            o[t] = a; }
        if (unit + ustep < uend) { const int nu = unit + ustep, nt0 = (nu & 127) * 16; int vb = (nu * 16 - 30) * 512 + tid; asm volatile("" : "+v"(vb));
#pragma unroll
            for (int r = 0; r < 46; ++r) raw[r] = (nt0 - 30 + r >= 0) ? G32[vb + r * 512] : 0u; }
#pragma unroll
        for (int t = 0; t < 16; ++t) {
            const float s1 = wave_sum(o[t].x + o[t].y, lane), s2 = wave_sum(o[t].x * o[t].x + o[t].y * o[t].y, lane);
            if (lane == 0) part[wave * 16 + t] = (f32x2){s1, s2};
        }
        asm volatile("s_waitcnt lgkmcnt(0)" ::: "memory"); __builtin_amdgcn_s_barrier(); asm volatile("" ::: "memory");
        if (tid < 16) { float s1 = 0.f, s2 = 0.f;
#pragma unroll
            for (int w = 0; w < 8; ++w) { const f32x2 p = part[w * 16 + tid]; s1 += p.x; s2 += p.y; }
            const float mean = s1 * (1.0f / D), var = fmaxf(s2 * (1.0f / D) - mean * mean, 0.f);
            stat[tid] = (f32x2){mean, rsqrtf(var + LN_EPS)}; }
        asm volatile("s_waitcnt lgkmcnt(0)" ::: "memory"); __builtin_amdgcn_s_barrier(); asm volatile("" ::: "memory");
#pragma unroll
        for (int t = 0; t < 16; ++t) {
            const f32x2 st = stat[t];
            float y0 = (o[t].x - st.x) * st.y * lg.x + lb.x, y1 = (o[t].y - st.x) * st.y * lg.y + lb.y;
            y0 = y0 * __builtin_amdgcn_rcpf(1.0f + __builtin_amdgcn_exp2f(-y0 * LOG2E)); y1 = y1 * __builtin_amdgcn_rcpf(1.0f + __builtin_amdgcn_exp2f(-y1 * LOG2E));
            V32[(size_t)(rowbase + t) * 512 + tid] = cvt_pk_bf16(y0, y1);
        }
        asm volatile("s_waitcnt lgkmcnt(0)" ::: "memory"); __builtin_amdgcn_s_barrier(); asm volatile("" ::: "memory");
    }
}

__device__ __forceinline__ float bcast_lane(float v, int k) { return __int_as_float(__builtin_amdgcn_readlane(__float_as_int(v), k)); }
template <int W>
__device__ __forceinline__ void pl_span(const bf16_t* XBs, const u64* ssq, bf16_t* PP, int unit0, int nsub, int tid, int lane, f32x2 g) {
    const unsigned* X32 = (const unsigned*)XBs; unsigned* P32 = (unsigned*)PP;
    const int t0 = (unit0 & 127) * 16, rowbase = unit0 * 16;
    const bool first = (t0 == 0);
    int vb = rowbase * 512 + tid; asm volatile("" : "+v"(vb));
    unsigned xh[W - 1], xc[16];
#pragma unroll
    for (int j = 0; j < W - 1; ++j) xh[j] = X32[vb + (first ? 0 : (j - (W - 1))) * 512];
    const int l5 = lane & 31;
    u64 q = ssq[rowbase + (l5 < 16 ? l5 : (first ? 0 : l5 - 32))];
#pragma unroll
    for (int j = 0; j < 16; ++j) xc[j] = X32[vb + j * 512];
    float rsl = rstd_of(q);
    f32x2 hist[W - 1]; f32x2 S = (f32x2){0.f, 0.f};
#pragma unroll
    for (int j = 0; j < W - 1; ++j) { const float r0 = bcast_lane(rsl, 32 - (W - 1) + j), rs = first ? 0.f : r0; hist[j] = (f32x2){bf_lo(xh[j]) * rs, bf_hi(xh[j]) * rs}; S += hist[j]; }
    constexpr float INVW = 1.0f / (float)W;
    for (int c = 0; c < nsub; ++c) {
        const bool more = (c + 1 < nsub);
        f32x2 ext[W - 1 + 16];
#pragma unroll
        for (int j = 0; j < W - 1; ++j) ext[j] = hist[j];
#pragma unroll
        for (int j = 0; j < 16; ++j) { const float rs = bcast_lane(rsl, j); ext[W - 1 + j] = (f32x2){bf_lo(xc[j]) * rs, bf_hi(xc[j]) * rs}; }
        const bool head = first && c == 0;
#pragma unroll
        for (int j = 0; j < 16; ++j) {
            S += ext[W - 1 + j];
            const float inv = head ? (1.0f / (float)((j + 1 < W) ? j + 1 : W)) : INVW;
            const f32x2 p = (S * inv - ext[W - 1 + j]) * g;
            P32[vb + (16 * c + j) * 512] = cvt_pk_bf16(p.x, p.y);
            S -= ext[j];
        }
#pragma unroll
        for (int j = 0; j < W - 1; ++j) hist[j] = ext[16 + j];
        if (more) {
#pragma unroll
            for (int j = 0; j < 16; ++j) xc[j] = X32[vb + (16 * (c + 1) + j) * 512];
            rsl = rstd_of(ssq[rowbase + 16 * (c + 1) + (lane & 15)]);
        }
    }
}
__device__ __forceinline__ void pl_phase(const bf16_t* X, const u64* ssq, const float* gain, bf16_t* PP, int bid, int G, int tid) {
    const f32x2 g = *(const f32x2*)(gain + 2 * tid); const int grp = __builtin_amdgcn_readfirstlane(tid >> 7), lane = tid & 63;
    const int ustart = (G == 256) ? (bid & 7) * 128 + (bid >> 3) * 4 : bid, ustep = (G == 256) ? 4 : G, uend = (G == 256) ? ustart + 4 : M / 16, nsub = (G == 256) ? 4 : 1;
    for (int unit = ustart; unit < uend; unit += ustep) {
        if (grp == 0) pl_span<2>(X, ssq, PP, unit, nsub, tid, lane, g);
        else if (grp == 1) pl_span<4>(X, ssq, PP, unit, nsub, tid, lane, g);
        else if (grp == 2) pl_span<8>(X, ssq, PP, unit, nsub, tid, lane, g);
        else pl_span<16>(X, ssq, PP, unit, nsub, tid, lane, g);
    }
}

#define XB_TMO      128
#define XB_XCNT(j)  (256  + 64 * (j))
#define XB_XSUB(j)  (1280 + 64 * (j))
#define XB_XGEN(j)  (2304 + 64 * (j))
#define XB_TOP      3328
#define XB_TOPGEN   3392
#define XB_LSUB(j)  (3456 + 64 * (j))
#define XB_LGEN(j)  (4480 + 64 * (j))
#define XB_GMASK(j) (5504 + (j))
#define XCD_BAR_WORDS 5632
#define XB_SPIN_CAP (1u << 18)
__device__ __forceinline__ unsigned xb_ld(unsigned* p)              { return __hip_atomic_load(p, __ATOMIC_RELAXED, __HIP_MEMORY_SCOPE_AGENT); }
__device__ __forceinline__ unsigned xb_add(unsigned* p, unsigned v) { return __hip_atomic_fetch_add(p, v, __ATOMIC_RELAXED, __HIP_MEMORY_SCOPE_AGENT); }
__device__ __forceinline__ unsigned xb_xcc_id() { return (unsigned)__builtin_amdgcn_s_getreg((3 << 11) | 20) & 0xFu; }
#define XB_SPIN(cond, bar) do { unsigned _sp = 0; while (cond) { __builtin_amdgcn_s_sleep(1); \
    if ((++_sp & 255u) == 0u) { if (xb_ld(&(bar)[XB_TMO])) break; if (_sp > XB_SPIN_CAP) { atomicAdd(&(bar)[XB_TMO], 1u); break; } } } } while (0)
struct XcdBarrier { unsigned* bar; unsigned x; volatile LAS unsigned* st; };
__device__ __forceinline__ void xcd_barrier_complete(unsigned* bar, unsigned x, unsigned& nloc, unsigned& nx) {
    const unsigned G = gridDim.x * gridDim.y * gridDim.z;
    unsigned sum, cnt, mine, sp = 0u;
    for (;;) {
        sum = 0u; cnt = 0u; mine = 0u;
#pragma unroll
        for (unsigned j = 0; j < 16; ++j) { const unsigned c = xb_ld(&bar[XB_XCNT(j)]); sum += c; cnt += (c > 0u) ? 1u : 0u; mine = (j == x) ? c : mine; }
        if (sum == G) break;
        __builtin_amdgcn_s_sleep(1);
        if ((++sp & 255u) == 0u) { if (xb_ld(&bar[XB_TMO])) break; if (sp > XB_SPIN_CAP) { atomicAdd(&bar[XB_TMO], 1u); break; } }
    }
    nloc = mine > 0u ? mine : 1u; nx = cnt > 0u ? cnt : 1u;
}
__device__ __forceinline__ void xcd_barrier(unsigned* bar_, volatile LAS unsigned* st_) {
    XcdBarrier b; b.bar = bar_; b.st = st_; b.x = xb_xcc_id();
    asm volatile("s_waitcnt vmcnt(0)" ::: "memory");
    __syncthreads();
    if (threadIdx.x == 0) {
        unsigned* bar = b.bar;
        __builtin_amdgcn_s_waitcnt(0);
        unsigned nloc = b.st[0], nx = b.st[1];
        if (nloc == 0u) { xcd_barrier_complete(bar, b.x, nloc, nx); b.st[0] = nloc; b.st[1] = nx; }
        const unsigned old = xb_add(&bar[XB_XSUB(b.x)], 1u);
        const unsigned gen = old / nloc;
        if (old + 1u == (gen + 1u) * nloc) {
            __builtin_amdgcn_fence(__ATOMIC_RELEASE, "agent");
            asm volatile("s_waitcnt vmcnt(0)" ::: "memory");
            const unsigned og = xb_add(&bar[XB_TOP], 1u);
            const unsigned tg = og / nx;
            if (og + 1u == (tg + 1u) * nx) xb_add(&bar[XB_TOPGEN], 1u);
            else XB_SPIN(xb_ld(&bar[XB_TOPGEN]) == tg, bar);
            __builtin_amdgcn_fence(__ATOMIC_ACQUIRE, "agent");
            xb_add(&bar[XB_XGEN(b.x)], 1u);
            asm volatile("s_waitcnt vmcnt(0)" ::: "memory");
        } else {
            XB_SPIN(xb_ld(&bar[XB_XGEN(b.x)]) == gen, bar);
            __builtin_amdgcn_fence(__ATOMIC_ACQUIRE, "agent");
            asm volatile("s_waitcnt vmcnt(0)" ::: "memory");
        }
    }
    __syncthreads();
}

__device__ __forceinline__ void xcd_local_barrier(unsigned* bar, unsigned grp, unsigned nloc) {
    asm volatile("s_waitcnt vmcnt(0)" ::: "memory");
    __syncthreads();
    if (threadIdx.x == 0) {
        __builtin_amdgcn_s_waitcnt(0);
        const unsigned old = xb_add(&bar[XB_LSUB(grp)], 1u);
        const unsigned gen = old / nloc;
        if (old + 1u == (gen + 1u) * nloc) xb_add(&bar[XB_LGEN(grp)], 1u);
        else XB_SPIN(xb_ld(&bar[XB_LGEN(grp)]) == gen, bar);
        __builtin_amdgcn_fence(__ATOMIC_ACQUIRE, "agent");
        asm volatile("s_waitcnt vmcnt(0)" ::: "memory");
    }
    __syncthreads();
}

enum { K_PRO = 0, K_KV, K_G1, K_DW, K_G2, K_PL, K_GP, K_GQ, K_S, K_PV, K_WO, K_UP, K_DOWN, K_FINAL };
constexpr int N_PHASES = 2 + 2 * 17 + 1;
__host__ __device__ __forceinline__ void decode_phase(int ph, int& kind, int& layer) {
    if (ph == 0) { kind = K_PRO; layer = 0; return; }
    if (ph == 1) { kind = K_KV; layer = 0; return; }
    if (ph == N_PHASES - 1) { kind = K_FINAL; layer = 0; return; }
    const int q = ph - 2, pair = q / 17, r = q % 17;
    if (r < 9) { layer = 2 * pair; kind = (r < 3) ? (K_G1 + r) : (K_GQ + (r - 3)); }
    else { layer = 2 * pair + 1; const int s = r - 9; kind = (s < 2) ? (K_PL + s) : (K_GQ + (s - 2)); }
}

__global__ void __launch_bounds__(512, 2) fwd_megakernel(Args args) {
    extern __shared__ __attribute__((aligned(16))) unsigned char lds_raw[];
    LAS unsigned char* lds = (LAS unsigned char*)lds_raw;
    const int G0 = gridDim.x, bid0 = blockIdx.x, bid = bid0;
    const int wave_s = __builtin_amdgcn_readfirstlane(threadIdx.x >> 6);
    unsigned char* ws = args.ws;
    u64* SSQ = (u64*)(ws + WS_SSQ);
    float* X = args.out;
    bf16_t* XB = (bf16_t*)(ws + WS_XB);
    bf16_t* KALL = (bf16_t*)(ws + WS_KALL); bf16_t* VT = (bf16_t*)(ws + WS_VT);
    bf16_t* S0 = (bf16_t*)(ws + WS_S0); bf16_t* S1 = (bf16_t*)(ws + WS_S1); bf16_t* S2 = (bf16_t*)(ws + WS_S2); bf16_t* HM = (bf16_t*)(ws + WS_H);
    LAS float* exf = (LAS float*)(lds + EX_OFF);
    if (threadIdx.x < 4) ((volatile LAS unsigned*)(lds + BARST_OFF))[threadIdx.x] = 0u;
    if (threadIdx.x == 0) {
#pragma unroll
        for (int k = 0; k < 23; ++k) ((LAS unsigned long long*)(lds + PTAB_OFF))[k] = (unsigned long long)args.in[k];
    }
    __syncthreads();
    PtrTab tab = (PtrTab)(lds + PTAB_OFF);
    if (threadIdx.x == 0) {
        unsigned* bar0 = (unsigned*)(args.ws + WS_BAR); const unsigned x = xb_xcc_id();
        (void)xb_add(bar0 + XB_XCNT(x), 1u); (void)__hip_atomic_fetch_or(bar0 + XB_GMASK(bid & 7), 1u << x, __ATOMIC_RELAXED, __HIP_MEMORY_SCOPE_AGENT);
    }
    if (args.lo < 0) cg::this_grid().sync();

#pragma unroll 1
    for (int ph = args.lo; ph < args.hi; ++ph) {
        int lane; asm volatile("v_mbcnt_lo_u32_b32 %0, -1, 0\n\tv_mbcnt_hi_u32_b32 %0, -1, %0" : "=v"(lane));
        int G = G0, bid = bid0, wave = wave_s; asm volatile("" : "+s"(G), "+s"(bid), "+s"(wave));
        const int tid = wave * 64 + lane;
        const int gw = bid * 8 + wave, NGW = G * 8;
        LAS float* scr = (LAS float*)(lds + wave * 16384);
        int kind, i; decode_phase(ph, kind, i);
        if (ph >= LAST_PH && ph < N_PHASES - 1) kind = -1;
        const int j = i >> 1;
        unsigned char* lw = ws + WS_LW + (size_t)(i & 1) * LW_SET;
        switch (kind) {
        case K_PRO: {
            { unsigned z = 0u; asm volatile("" : "+v"(z));
              for (int u = bid * 512 + tid; u < 12 * M / 2; u += G * 512) ((u32x4*)(SSQ + M))[u] = (u32x4){z, z, z, z}; }
            convert_job(tab, ws, -1, scr, gw, NGW, lane);
            for (int m = gw; m < MEMR; m += NGW) {
                const f32x4* xr = (const f32x4*)(INP(1) + (size_t)m * D) + lane; f32x4 v[4]; float s = 0.f;
#pragma unroll
                for (int q = 0; q < 4; ++q) { v[q] = xr[64 * q]; s += (v[q].x * v[q].x + v[q].y * v[q].y) + (v[q].z * v[q].z + v[q].w * v[q].w); }
                const float rs = rsqrtf(wave_sum(s, lane) * (1.0f / D) + RMS_EPS);
                u32x2* o8 = (u32x2*)((bf16_t*)(ws + WS_MEMN) + (size_t)m * D) + lane;
#pragma unroll
                for (int q = 0; q < 4; ++q) { const f32x4 gq = ((const f32x4*)INP(2))[lane + 64 * q]; u32x2 w; w.x = cvt_pk_bf16(v[q].x * rs * gq.x, v[q].y * rs * gq.y); w.y = cvt_pk_bf16(v[q].z * rs * gq.z, v[q].w * rs * gq.w); o8[64 * q] = w; }
            }
            const int m0 = (G == 256) ? (bid & 7) * SEQ + (bid >> 3) * 8 + wave : gw, mstep = (G == 256) ? 256 : NGW, mend = (G == 256) ? ((bid & 7) + 1) * SEQ : M;
            for (int m = m0; m < mend; m += mstep) {
                const f32x4* xr = (const f32x4*)(INP(0) + (size_t)m * D) + lane; f32x4 v[4]; float s = 0.f;
                u32x2* o8 = (u32x2*)(XB + (size_t)m * D) + lane;
#pragma unroll
                for (int q = 0; q < 4; ++q) { v[q] = xr[64 * q]; u32x2 w; w.x = cvt_pk_bf16(v[q].x, v[q].y); w.y = cvt_pk_bf16(v[q].z, v[q].w); o8[64 * q] = w;
                    const float a = bf_lo(w.x), b = bf_hi(w.x), c = bf_lo(w.y), d = bf_hi(w.y); s += (a * a + b * b) + (c * c + d * d); }
                s = wave_sum(s, lane);
                if (lane == 0) SSQ[m] = (u64)(s * SSQ_SCALE);
            }
            convert_job(tab, ws, 0, scr, gw, NGW, lane);
        } break;
        case K_KV: {
            {
                pg8::Gemm g{(const bf16_t*)(ws + WS_MEMN), (const bf16_t*)(ws + WS_WKT), D, D, D, 256L * D, 0, 256L * D, 0};
                pg8::Order S; S.init(MEMR / 256, 4 * D / 256, G, bid);
                pg8::EpiBf E{KALL, 4 * D, nullptr, 1.0f, 0};
                pg8::gemm_phase<pg8::EpiBf, true>(lds, g, S, E, tid);
            }
            {
                pg8::Gemm g{(const bf16_t*)(ws + WS_WVT), (const bf16_t*)(ws + WS_MEMN), D, D, D, 256L * D, 0, 256L * D, 0};
                pg8::Order S; S.init(4 * D / 256, MEMR / 256, G, (bid + G / 2) % G);
                pg8::EpiBf E{VT, MEMR, nullptr, 1.0f, 0};
                pg8::gemm_phase<pg8::EpiBf, true>(lds, g, S, E, tid);
            }
        } break;
        case K_G1: {
            pg8::Gemm g{XB, (const bf16_t*)(lw + LW_WIN), D, D, D, 256L * D, 0, 256L * D, 0};
            pg8::Order S; S.init(M / 256, 2 * D / 256, G, bid);
            pg8::EpiGlu E{S0, INP(7) + j * 2 * D, SSQ + (size_t)(3 * i) * M};
            pg8::gemm_phase<pg8::EpiGlu, true>(lds, g, S, E, tid);
        } break;
        case K_DW: {
            dw_phase(S0, S1, INP(8) + (size_t)j * CW * D, INP(9) + j * D, INP(10) + j * D, INP(11) + j * D, exf, bid, G, tid);
        } break;
        case K_PL: {
            pl_phase(XB, SSQ + (size_t)(3 * i) * M, INP(3) + i * D, S0, bid, G, tid);
        } break;
        case K_G2: case K_GP: case K_WO: case K_DOWN: {
            pg8::Gemm g; pg8::EpiRes E; E.xb = XB; E.bias = nullptr;
            if (kind == K_G2) { g = pg8::Gemm{S1, (const bf16_t*)(lw + LW_WOUT), D, D, D, 256L * D, 0, 256L * D, 0}; E.bias = INP(13) + j * D; E.ssq_next = SSQ + (size_t)(3 * i + 1) * M; }
            else if (kind == K_GP) { g = pg8::Gemm{S0, (const bf16_t*)(lw + LW_WIN), D, 256, 256, 256L * D, 256, 65536, 0}; E.ssq_next = SSQ + (size_t)(3 * i + 1) * M; }
            else if (kind == K_WO) { g = pg8::Gemm{S2, (const bf16_t*)(lw + LW_WO), D, D, D, 256L * D, 0, 256L * D, 0}; E.ssq_next = SSQ + (size_t)(3 * i + 2) * M; }
            else { g = pg8::Gemm{HM, (const bf16_t*)(lw + LW_W2), FF, FF, FF, 256L * FF, 0, 256L * FF, 0}; E.ssq_next = SSQ + (size_t)(3 * i + 3) * M; }
            pg8::Order S; S.init(M / 256, D / 256, G, bid);
            pg8::gemm_phase<pg8::EpiRes, true>(lds, g, S, E, tid);
        } break;
        case K_GQ: case K_UP: case K_PV: {
            pg8::Gemm g; pg8::EpiBf E; int nN = D / 256;
            if (kind == K_GQ) { g = pg8::Gemm{XB, (const bf16_t*)(lw + LW_WQ), D, D, D, 256L * D, 0, 256L * D, 0}; E = pg8::EpiBf{S0, D, SSQ + (size_t)(3 * i + 1) * M, 0.0625f, 0}; }
            else if (kind == K_UP) { g = pg8::Gemm{XB, (const bf16_t*)(lw + LW_W1), D, D, D, 256L * D, 0, 256L * D, 0}; E = pg8::EpiBf{HM, FF, SSQ + (size_t)(3 * i + 2) * M, 1.0f, 1}; nN = FF / 256; }
            else { g = pg8::Gemm{S1, VT + (size_t)i * D * MEMR, D, MEMR, 256, 256L * D, 256, 256L * MEMR, 256}; E = pg8::EpiBf{S2, D, nullptr, 1.0f, 0}; }
            pg8::Order S; S.init(M / 256, nN, G, bid);
            pg8::gemm_phase<pg8::EpiBf, true>(lds, g, S, E, tid);
            if (kind == K_PV && i + 1 < 4) convert_job(tab, ws, i + 1, scr, gw, NGW, lane);
        } break;
        case K_S: {
            pg8::Gemm g{S0, KALL + (size_t)i * D, D, 4 * D, 256, 256L * D, 256, 256, 256L * 4 * D};
            pg8::Order S; S.init(M / 256, D / 256, G, bid);
            pg8::EpiSoftmax E{S1, (LAS f32x2*)exf};
            pg8::gemm_phase<pg8::EpiSoftmax, true>(lds, g, S, E, tid);
        } break;
        case K_FINAL: {
            const int m0 = (G == 256) ? (bid & 7) * SEQ + (bid >> 3) * 8 + wave : gw, mstep = (G == 256) ? 256 : NGW, mend = (G == 256) ? ((bid & 7) + 1) * SEQ : M;
            for (int m = m0; m < mend; m += mstep) {
                f32x4* xr = (f32x4*)(X + (size_t)m * D) + lane; const u32x2* xi = (const u32x2*)(XB + (size_t)m * D) + lane; f32x4 v[4]; float s = 0.f;
#pragma unroll
                for (int q = 0; q < 4; ++q) { const u32x2 w = xi[64 * q]; v[q] = (f32x4){bf_lo(w.x), bf_hi(w.x), bf_lo(w.y), bf_hi(w.y)}; s += (v[q].x * v[q].x + v[q].y * v[q].y) + (v[q].z * v[q].z + v[q].w * v[q].w); }
                const float rs = rsqrtf(wave_sum(s, lane) * (1.0f / D) + RMS_EPS);
#pragma unroll
                for (int q = 0; q < 4; ++q) { const f32x4 gq = ((const f32x4*)INP(22))[lane + 64 * q]; f32x4 o = v[q] * rs; o.x *= gq.x; o.y *= gq.y; o.z *= gq.z; o.w *= gq.w; xr[64 * q] = o; }
            }
        } break;
        }
        if (ph + 1 < args.hi) {
            unsigned* bar = (unsigned*)(args.ws + WS_BAR); volatile LAS unsigned* st = (volatile LAS unsigned*)(lds + BARST_OFF);
            if (kind == K_GQ || kind == K_S) {
                asm volatile("s_waitcnt vmcnt(0)" ::: "memory"); __syncthreads();
                if (threadIdx.x == 0) { __builtin_amdgcn_fence(__ATOMIC_ACQUIRE, "agent"); asm volatile("s_waitcnt vmcnt(0)" ::: "memory"); }
                __syncthreads();
            } else if (ph <= 1 || (kind == K_DOWN && i < 3) || st[2] != 1u) {
                xcd_barrier(bar, st);
                if (ph == 1) {
                    if (threadIdx.x == 0) { bool pure = (G == 256 && st[0] == 32u && st[1] == 8u);
#pragma unroll
                        for (int g8 = 0; g8 < 8; ++g8) pure = pure && (__builtin_popcount(xb_ld(bar + XB_GMASK(g8))) == 1);
                        st[2] = (pure && !FORCE_FALLBACK) ? 1u : 2u; }
                    __syncthreads();
                }
            } else xcd_local_barrier(bar, (unsigned)(bid & 7), 32u);
        }
    }
}

extern "C" void kernel_launch(void* const* d_in, const int* in_sizes, int n_in, void* d_out, int out_size, void* d_ws, size_t ws_size, hipStream_t stream) {
    static int grid = 0;
    if (grid == 0) {
        if (n_in != 23 || out_size != M * D || ws_size < WS_END) { fprintf(stderr, "kernel_launch: unexpected problem (n_in %d out %d ws %zu)\n", n_in, out_size, ws_size); grid = -1; return; }
        int dev = 0, cus = 0, per_cu = 0;
        hipGetDevice(&dev); hipDeviceGetAttribute(&cus, hipDeviceAttributeMultiprocessorCount, dev);
        hipFuncSetAttribute((const void*)fwd_megakernel, hipFuncAttributeMaxDynamicSharedMemorySize, LDS_BYTES);
        if (hipOccupancyMaxActiveBlocksPerMultiprocessor(&per_cu, (const void*)fwd_megakernel, 512, LDS_BYTES) != hipSuccess || per_cu < 1) { fprintf(stderr, "kernel_launch: occupancy query gave %d\n", per_cu); per_cu = 1; }
        (void)hipGetLastError();
        grid = cus * per_cu;
    }
    if (grid < 0) return;
    (void)hipMemsetAsync((unsigned char*)d_ws + WS_BAR, 0, XCD_BAR_WORDS * 4, stream);
    Args a{};
    for (int i = 0; i < 23; ++i) a.in[i] = (const float*)d_in[i];
    a.out = (float*)d_out; a.ws = (unsigned char*)d_ws;
#if MK_PER_PHASE
    for (int ph = 0; ph < N_PHASES; ++ph) { a.lo = ph; a.hi = ph + 1; hipLaunchKernelGGL(fwd_megakernel, dim3(grid), dim3(512), LDS_BYTES, stream, a); }
#else
    a.lo = 0; a.hi = N_PHASES;
    void* kargs[] = {&a};
    hipError_t e = hipLaunchCooperativeKernel((const void*)fwd_megakernel, dim3(grid), dim3(512), kargs, LDS_BYTES, stream);
    if (e != hipSuccess) fprintf(stderr, "cooperative launch failed: %s (grid %d)\n", hipGetErrorString(e), grid);
#endif
}
```

```cpp
#include <hip/hip_runtime.h>
#include <hip/hip_cooperative_groups.h>
#include <cstdio>
#include <cstdint>
namespace cg = cooperative_groups;

#ifndef MK_PER_PHASE
#define MK_PER_PHASE 0
#endif

#ifndef LAST_PH
#define LAST_PH 99
#endif
#ifndef FORCE_FALLBACK
#define FORCE_FALLBACK 0
#endif
#define LAS __attribute__((address_space(3)))
typedef unsigned short bf16_t;
typedef short bf16x8 __attribute__((ext_vector_type(8)));
typedef float f32x4 __attribute__((ext_vector_type(4)));
typedef float f32x2 __attribute__((ext_vector_type(2)));
typedef unsigned u32x4 __attribute__((ext_vector_type(4)));
typedef unsigned u32x2 __attribute__((ext_vector_type(2)));

constexpr int D = 1024, NB = 8, SEQ = 2048, M = NB * SEQ, FF = 4096, MEML = 256, MEMR = NB * MEML, CW = 31;
constexpr float RMS_EPS = 1e-6f, LN_EPS = 1e-5f;
constexpr float LOG2E = 1.4426950408889634f;
typedef unsigned long long u64;
constexpr float SSQ_SCALE = 1048576.0f, SSQ_INV = 1.0f / (1048576.0f * 1024.0f);
__device__ __forceinline__ float rstd_of(u64 q) { return rsqrtf((float)q * SSQ_INV + 1e-6f); }

constexpr size_t MiB = 1u << 20;
constexpr size_t WS_SSQ = 0;
constexpr size_t WS_BAR = 2 * MiB - 32768;
constexpr size_t WS_LW = 2 * MiB;
constexpr size_t LW_SET = 26 * MiB;
constexpr size_t LW_WIN = 0, LW_WOUT = 4 * MiB, LW_WQ = 6 * MiB, LW_WO = 8 * MiB, LW_W1 = 10 * MiB, LW_W2 = 18 * MiB;
constexpr size_t WS_XB = WS_LW + 2 * LW_SET;
constexpr size_t WS_KALL = WS_XB + 32 * MiB;
constexpr size_t WS_VT = WS_KALL + 16 * MiB;
constexpr size_t WS_H = WS_VT + 16 * MiB;
constexpr size_t WS_S0 = WS_H, WS_S1 = WS_H + 32 * MiB, WS_S2 = WS_H + 64 * MiB, WS_S3 = WS_H + 96 * MiB;
constexpr size_t WS_WKT = WS_S3, WS_WVT = WS_S3 + 8 * MiB, WS_MEMN = WS_S3 + 16 * MiB;
constexpr size_t WS_END = WS_H + 128 * MiB;

constexpr int RING_BYTES = 131072, EX_OFF = RING_BYTES, BARST_OFF = RING_BYTES + 8192, PTAB_OFF = BARST_OFF + 64, LDS_BYTES = RING_BYTES + 8192 + 2048;

__device__ __forceinline__ unsigned cvt_pk_bf16(float lo, float hi) { unsigned r; asm volatile("v_cvt_pk_bf16_f32 %0, %1, %2" : "=v"(r) : "v"(lo), "v"(hi)); return r; }
__device__ __forceinline__ float shx(float v, int lane, int o) { return __int_as_float(__builtin_amdgcn_ds_bpermute((lane ^ o) << 2, __float_as_int(v))); }
__device__ __forceinline__ float wave_sum(float v, int lane) {
#pragma unroll
    for (int o = 1; o < 64; o <<= 1) v += shx(v, lane, o);
    return v;
}
__device__ __forceinline__ float bf_lo(unsigned u) { return __uint_as_float(u << 16); }
__device__ __forceinline__ float bf_hi(unsigned u) { return __uint_as_float(u & 0xffff0000u); }

namespace pg8 {
constexpr int BM = 256, BK = 64, HALF = 128, HTB = HALF * BK * 2, STAGE_BYTES = 8 * HTB, NXCD = 8, WGM = 8;
__host__ __device__ __forceinline__ int lds_byte(int r, int c) { const int st = (r >> 4) * 2 + (c >> 5), rr = r & 15, cc = c & 31, ob = rr * 64 + cc * 2; return st * 1024 + (ob ^ (((ob >> 9) & 1) << 5)); }
__host__ __device__ __forceinline__ void stage_rc(int b, int& R, int& C) { const int st = b / 1024, sb = b % 1024, swz = sb ^ (((sb >> 9) & 1) << 5); R = (st >> 1) * 16 + swz / 64; C = (st & 1) * 32 + (swz % 64) / 2; }
__host__ __device__ __forceinline__ int perm32(int rho) { const int n = rho >> 4, i = rho & 15; return 8 * (i >> 2) + 4 * n + (i & 3); }

struct Unit { int pm, pn; };
struct Gemm { const bf16_t* A; const bf16_t* Bt; int lda, ldb, K; long a_pm, a_pn, b_pn, b_b; };

struct Order {
    int nM, nN, nwg, G, c;
    __device__ __forceinline__ void init(int nM_, int nN_, int G_, int c_) { nM = nM_; nN = nN_; nwg = nM * nN; G = G_; c = c_; }
    __device__ __forceinline__ bool next(int i, Unit& u) const {
        const long L = (long)i * G + c; if (L >= nwg) return false;
        int wgid = (int)L; { const int q = nwg / NXCD, r = nwg % NXCD, xcd = wgid % NXCD, off = wgid / NXCD; wgid = (xcd < r ? xcd * (q + 1) : r * (q + 1) + (xcd - r) * q) + off; }
        const int nig = WGM * nN, gid = wgid / nig, fm = gid * WGM, gsz = (nM - fm) < WGM ? (nM - fm) : WGM;
        u.pm = fm + ((wgid % nig) % gsz); u.pn = (wgid % nig) / gsz; return true;
    }
};


struct EpiBf {
    bf16_t* O; int ldc; const u64* ssq; float cs; int act;
    __device__ __forceinline__ void operator()(f32x4 (&acc)[2][2][4][2], const Unit& u, int wid, int lane_) const {
        int lane = lane_; asm volatile("" : "+v"(lane));
        const int wr = wid >> 2, wc = wid & 3, fr = lane & 15, fq = lane >> 4;
        const int row0 = u.pm * BM + wr * 64 + fr, col0 = u.pn * BM + wc * 32 + 8 * fq;
#pragma unroll
        for (int ai = 0; ai < 2; ++ai)
#pragma unroll
            for (int m = 0; m < 4; ++m) {
                const int r = row0 + ai * HALF + m * 16;
                float rs = cs; if (ssq) rs *= rstd_of(ssq[r]);
                bf16_t* rowp = O + (size_t)r * ldc + col0;
#pragma unroll
                for (int bj = 0; bj < 2; ++bj) {
                    f32x4 v0 = acc[ai][bj][m][0] * rs, v1 = acc[ai][bj][m][1] * rs;
                    if (act) {
#pragma unroll
                        for (int j = 0; j < 4; ++j) { const float a = fmaxf(v0[j], 0.f), b = fmaxf(v1[j], 0.f); v0[j] = a * a; v1[j] = b * b; }
                    }
                    u32x4 w; w.x = cvt_pk_bf16(v0[0], v0[1]); w.y = cvt_pk_bf16(v0[2], v0[3]); w.z = cvt_pk_bf16(v1[0], v1[1]); w.w = cvt_pk_bf16(v1[2], v1[3]);
                    *(u32x4*)(rowp + bj * HALF) = w;
                }
            }
    }
};
struct EpiGlu {
    bf16_t* O; const float* bias; const u64* ssq;
    __device__ __forceinline__ void operator()(f32x4 (&acc)[2][2][4][2], const Unit& u, int wid, int lane_) const {
        int lane = lane_; asm volatile("" : "+v"(lane));
        const int wr = wid >> 2, wc = wid & 3, fr = lane & 15, fq = lane >> 4;
        const int row0 = u.pm * BM + wr * 64 + fr, ch0 = u.pn * HALF + wc * 32 + 8 * fq;
        f32x4 ba[2], bg[2];
#pragma unroll
        for (int n = 0; n < 2; ++n) { ba[n] = *(const f32x4*)(bias + ch0 + 4 * n); bg[n] = *(const f32x4*)(bias + D + ch0 + 4 * n); }
#pragma unroll
        for (int ai = 0; ai < 2; ++ai)
#pragma unroll
            for (int m = 0; m < 4; ++m) {
                const int r = row0 + ai * HALF + m * 16;
                const float rs = rstd_of(ssq[r]);
                f32x4 o[2];
#pragma unroll
                for (int n = 0; n < 2; ++n) {
                    const f32x4 a = acc[ai][0][m][n] * rs + ba[n], g = acc[ai][1][m][n] * rs + bg[n];
#pragma unroll
                    for (int j = 0; j < 4; ++j) o[n][j] = a[j] * __builtin_amdgcn_rcpf(1.0f + __builtin_amdgcn_exp2f(-g[j] * LOG2E));
                }
                u32x4 w; w.x = cvt_pk_bf16(o[0][0], o[0][1]); w.y = cvt_pk_bf16(o[0][2], o[0][3]); w.z = cvt_pk_bf16(o[1][0], o[1][1]); w.w = cvt_pk_bf16(o[1][2], o[1][3]);
                *(u32x4*)(O + (size_t)r * D + ch0) = w;
            }
    }
};
struct EpiRes {
    bf16_t* xb; const float* bias; u64* ssq_next;
    __device__ __forceinline__ void operator()(f32x4 (&acc)[2][2][4][2], const Unit& u, int wid, int lane_) const {
        int lane = lane_; asm volatile("" : "+v"(lane));
        const int wr = wid >> 2, wc = wid & 3, fr = lane & 15, fq = lane >> 4;
        const int row0 = u.pm * BM + wr * 64 + fr, col0 = u.pn * BM + wc * 32 + 8 * fq;
        f32x4 bv[2][2];
#pragma unroll
        for (int bj = 0; bj < 2; ++bj)
#pragma unroll
            for (int n = 0; n < 2; ++n) bv[bj][n] = bias ? *(const f32x4*)(bias + col0 + bj * HALF + 4 * n) : (f32x4){0.f, 0.f, 0.f, 0.f};
#pragma unroll
        for (int ai = 0; ai < 2; ++ai)
#pragma unroll
            for (int m = 0; m < 4; ++m) {
                const int r = row0 + ai * HALF + m * 16; const size_t off = (size_t)r * D + col0;
                float ss = 0.f;
#pragma unroll
                for (int bj = 0; bj < 2; ++bj) {
                    const u32x4 xo = *(const u32x4*)(xb + off + bj * HALF);
                    f32x4 x0 = (f32x4){bf_lo(xo.x), bf_hi(xo.x), bf_lo(xo.y), bf_hi(xo.y)}, x1 = (f32x4){bf_lo(xo.z), bf_hi(xo.z), bf_lo(xo.w), bf_hi(xo.w)};
                    x0 += acc[ai][bj][m][0] + bv[bj][0]; x1 += acc[ai][bj][m][1] + bv[bj][1];
                    u32x4 w; w.x = cvt_pk_bf16(x0[0], x0[1]); w.y = cvt_pk_bf16(x0[2], x0[3]); w.z = cvt_pk_bf16(x1[0], x1[1]); w.w = cvt_pk_bf16(x1[2], x1[3]);
                    *(u32x4*)(xb + off + bj * HALF) = w;
                    x0 = (f32x4){bf_lo(w.x), bf_hi(w.x), bf_lo(w.y), bf_hi(w.y)}; x1 = (f32x4){bf_lo(w.z), bf_hi(w.z), bf_lo(w.w), bf_hi(w.w)};
                    ss += (x0[0] * x0[0] + x0[1] * x0[1]) + (x0[2] * x0[2] + x0[3] * x0[3]) + (x1[0] * x1[0] + x1[1] * x1[1]) + (x1[2] * x1[2] + x1[3] * x1[3]);
                }
                ss += shx(ss, lane, 16); ss += shx(ss, lane, 32);
                if (fq == 0) __hip_atomic_fetch_add(ssq_next + r, (u64)(ss * SSQ_SCALE), __ATOMIC_RELAXED, __HIP_MEMORY_SCOPE_AGENT);
            }
    }
};
struct EpiSoftmax {
    bf16_t* P; LAS f32x2* ex;
    __device__ __forceinline__ void operator()(f32x4 (&acc)[2][2][4][2], const Unit& u, int wid, int lane_) const {
        int lane = lane_; asm volatile("" : "+v"(lane));
        const int wr = wid >> 2, wc = wid & 3, fr = lane & 15, fq = lane >> 4;
        const int row0 = u.pm * BM + wr * 64 + fr, col0 = u.pn * BM + wc * 32 + 8 * fq;
        float mxs[2][4];
#pragma unroll
        for (int ai = 0; ai < 2; ++ai)
#pragma unroll
            for (int m = 0; m < 4; ++m) {
                float mx = -3.0e38f;
#pragma unroll
                for (int bj = 0; bj < 2; ++bj)
#pragma unroll
                    for (int n = 0; n < 2; ++n) { const f32x4 v = acc[ai][bj][m][n]; mx = fmaxf(mx, fmaxf(fmaxf(v[0], v[1]), fmaxf(v[2], v[3]))); }
                mx = fmaxf(mx, shx(mx, lane, 16)); mx = fmaxf(mx, shx(mx, lane, 32));
                float l = 0.f;
#pragma unroll
                for (int bj = 0; bj < 2; ++bj)
#pragma unroll
                    for (int n = 0; n < 2; ++n) { f32x4 v = acc[ai][bj][m][n];
#pragma unroll
                        for (int j = 0; j < 4; ++j) { v[j] = __builtin_amdgcn_exp2f((v[j] - mx) * LOG2E); l += v[j]; }
                        acc[ai][bj][m][n] = v; }
                l += shx(l, lane, 16); l += shx(l, lane, 32);
                mxs[ai][m] = mx;
                if (fq == 0) ex[(ai * HALF + wr * 64 + m * 16 + fr) * 4 + wc] = (f32x2){mx, l};
            }
        asm volatile("s_waitcnt lgkmcnt(0)" ::: "memory"); __builtin_amdgcn_s_barrier(); asm volatile("" ::: "memory");
#pragma unroll
        for (int ai = 0; ai < 2; ++ai)
#pragma unroll
            for (int m = 0; m < 4; ++m) {
                const int lr = ai * HALF + wr * 64 + m * 16 + fr;
                const f32x2 a = ex[lr * 4 + 0], b = ex[lr * 4 + 1], c = ex[lr * 4 + 2], d = ex[lr * 4 + 3];
                const float MX = fmaxf(fmaxf(a.x, b.x), fmaxf(c.x, d.x));
                const float L = a.y * __builtin_amdgcn_exp2f((a.x - MX) * LOG2E) + b.y * __builtin_amdgcn_exp2f((b.x - MX) * LOG2E)
                              + c.y * __builtin_amdgcn_exp2f((c.x - MX) * LOG2E) + d.y * __builtin_amdgcn_exp2f((d.x - MX) * LOG2E);
                const float f = __builtin_amdgcn_exp2f((mxs[ai][m] - MX) * LOG2E) / L;
                bf16_t* rowp = P + (size_t)(row0 + ai * HALF + m * 16) * D + col0;
#pragma unroll
                for (int bj = 0; bj < 2; ++bj) {
                    const f32x4 v0 = acc[ai][bj][m][0] * f, v1 = acc[ai][bj][m][1] * f;
                    u32x4 w; w.x = cvt_pk_bf16(v0[0], v0[1]); w.y = cvt_pk_bf16(v0[2], v0[3]); w.z = cvt_pk_bf16(v1[0], v1[1]); w.w = cvt_pk_bf16(v1[2], v1[3]);
                    *(u32x4*)(rowp + bj * HALF) = w;
                }
            }
        asm volatile("s_waitcnt lgkmcnt(0)" ::: "memory"); __builtin_amdgcn_s_barrier(); asm volatile("" ::: "memory");
    }
};

template <int LDSIMM, int GOFF>
__device__ __forceinline__ void glds_s(const char* sbase, unsigned voff, unsigned ldsbase) {
    asm volatile("s_add_u32 m0, %2, %3\n\ts_nop 0\n\tglobal_load_lds_dwordx4 %0, %1 offset:%4" :: "v"(voff), "s"(sbase), "s"(ldsbase), "i"(LDSIMM), "i"(GOFF) : "memory", "m0", "scc");
}
template <class Epi, bool ALIGN_EPI>
__device__ __forceinline__ void gemm_phase(LAS unsigned char* lds, const Gemm g, const Order& S, const Epi& E, const int tid) {
    const int wid = __builtin_amdgcn_readfirstlane(tid >> 6), lane = tid & 63, wr = wid >> 2, wc = wid & 3, fr = lane & 15, fq = lane >> 4;
    const int nt = g.K / BK;
    unsigned voffA[2], voffB[2];
#pragma unroll
    for (int i = 0; i < 2; ++i) { int R, C; stage_rc(tid * 16 + i * 8192, R, C); const int Rb = (R & ~31) + perm32(R & 31);
        voffA[i] = (unsigned)(R * g.lda + C) * 2u; voffB[i] = (unsigned)(Rb * g.ldb + C) * 2u; }
    const size_t kstep = (size_t)(BK * 2);
    const size_t hstepA = (size_t)HALF * g.lda * 2, hstepB = (size_t)HALF * g.ldb * 2;
    const unsigned ldsbase = (unsigned)(size_t)lds + (unsigned)wid * 1024u;
    const int aoff = lds_byte(wr * 64 + fr, fq * 8), boff = lds_byte(wc * 32 + fr, fq * 8);
#define PG8_SA(b, h) (((b) * 2 + (h)) * HTB)
#define PG8_SB(b, h) ((4 + (b) * 2 + (h)) * HTB)
#define PG8_STAGE(bufoff, gbase, voff) do { glds_s<(bufoff), 0>((const char*)(gbase), (voff)[0], ldsbase); glds_s<(bufoff) + 8192, 0>((const char*)(gbase), (voff)[1], ldsbase); } while (0)
#define PG8_LDA(dst, b, h) do { _Pragma("unroll") for (int m = 0; m < 4; ++m) _Pragma("unroll") for (int k = 0; k < 2; ++k) dst[m][k] = *(const LAS bf16x8*)(lds + PG8_SA(b, h) + aoff + m * 2048 + k * 1024); } while (0)
#define PG8_LDB(dst, b, h) do { _Pragma("unroll") for (int n = 0; n < 2; ++n) _Pragma("unroll") for (int k = 0; k < 2; ++k) dst[n][k] = *(const LAS bf16x8*)(lds + PG8_SB(b, h) + boff + n * 2048 + k * 1024); } while (0)
#define PG8_MMA(ai, bj, At, Bt) do { __builtin_amdgcn_s_setprio(1); _Pragma("unroll") for (int m = 0; m < 4; ++m) _Pragma("unroll") for (int n = 0; n < 2; ++n) _Pragma("unroll") for (int k = 0; k < 2; ++k) \
        acc[ai][bj][m][n] = __builtin_amdgcn_mfma_f32_16x16x32_bf16(Bt[n][k], At[m][k], acc[ai][bj][m][n], 0, 0, 0); __builtin_amdgcn_s_setprio(0); } while (0)
#define PG8_WAIT_V(n) asm volatile("s_waitcnt vmcnt(" #n ")" ::: "memory")
#define PG8_WAIT_L(n) asm volatile("s_waitcnt lgkmcnt(" #n ")" ::: "memory")
#define PG8_BAR __builtin_amdgcn_s_barrier()
#define PG8_SCHED __builtin_amdgcn_sched_barrier(0)
#define PG8_ABASE(u) ((const char*)(g.A + (size_t)(u).pm * g.a_pm + (size_t)(u).pn * g.a_pn))
#define PG8_BBASE(u) ((const char*)(g.Bt + (size_t)(u).pn * g.b_pn + (size_t)((u).pm >> 3) * g.b_b))
    Unit cur, nxt; int ui = 0;
    if (!S.next(0, cur)) return;
    f32x4 acc[2][2][4][2];
#pragma unroll
    for (int a = 0; a < 2; ++a)
#pragma unroll
        for (int b = 0; b < 2; ++b)
#pragma unroll
            for (int m = 0; m < 4; ++m)
#pragma unroll
                for (int n = 0; n < 2; ++n) acc[a][b][m][n] = (f32x4){0.f, 0.f, 0.f, 0.f};
    bf16x8 At[4][2], B0[2][2], B1[2][2];
    const char* cA = PG8_ABASE(cur); const char* cB = PG8_BBASE(cur);
    PG8_STAGE(PG8_SB(0, 0), cB, voffB); PG8_STAGE(PG8_SB(0, 1), cB + hstepB, voffB); PG8_STAGE(PG8_SA(0, 0), cA, voffA); PG8_STAGE(PG8_SA(0, 1), cA + hstepA, voffA);
    if (wr == 1) PG8_BAR;
    PG8_WAIT_V(2); PG8_BAR;
    PG8_STAGE(PG8_SB(1, 0), cB + kstep, voffB); PG8_STAGE(PG8_SA(1, 0), cA + kstep, voffA); PG8_STAGE(PG8_SB(1, 1), cB + hstepB + kstep, voffB);
    PG8_WAIT_V(6); PG8_BAR;
    for (;;) {
        const bool has_next = S.next(ui + 1, nxt);
        const char* nA = has_next ? PG8_ABASE(nxt) : cA; const char* nB = has_next ? PG8_BBASE(nxt) : cB;
        for (int t = 0; t < nt; t += 2) {
            const bool last = (t == nt - 2);
            const char* a1 = cA + (size_t)(t + 1) * kstep;
            const char* a2 = last ? nA : cA + (size_t)(t + 2) * kstep; const char* b2 = last ? nB : cB + (size_t)(t + 2) * kstep;
            const char* a3 = a2 + kstep; const char* b3 = b2 + kstep;
            PG8_LDB(B0, 0, 0); PG8_LDB(B1, 0, 1); PG8_SCHED; PG8_LDA(At, 0, 0); PG8_STAGE(PG8_SA(1, 1), a1 + hstepA, voffA);
            PG8_WAIT_V(8); PG8_WAIT_L(0); PG8_BAR; PG8_MMA(0, 0, At, B0); PG8_MMA(0, 1, At, B1); PG8_BAR; PG8_SCHED;
            PG8_LDA(At, 0, 1); PG8_STAGE(PG8_SB(0, 0), b2, voffB); PG8_STAGE(PG8_SB(0, 1), b2 + hstepB, voffB); PG8_STAGE(PG8_SA(0, 0), a2, voffA);
            PG8_WAIT_V(8); PG8_WAIT_L(0); PG8_BAR; PG8_MMA(1, 0, At, B0); PG8_MMA(1, 1, At, B1); PG8_BAR; PG8_SCHED;
            PG8_LDB(B0, 1, 0); PG8_LDB(B1, 1, 1); PG8_SCHED; PG8_LDA(At, 1, 0); PG8_STAGE(PG8_SA(0, 1), a2 + hstepA, voffA);
            PG8_WAIT_V(8); PG8_WAIT_L(0); PG8_BAR; PG8_MMA(0, 0, At, B0); PG8_MMA(0, 1, At, B1); PG8_BAR; PG8_SCHED;
            PG8_LDA(At, 1, 1); PG8_STAGE(PG8_SB(1, 0), b3, voffB); PG8_STAGE(PG8_SB(1, 1), b3 + hstepB, voffB); PG8_STAGE(PG8_SA(1, 0), a3, voffA);
            PG8_WAIT_V(8); PG8_WAIT_L(0); PG8_BAR; PG8_MMA(1, 0, At, B0); PG8_MMA(1, 1, At, B1); PG8_BAR; PG8_SCHED;
        }
        if constexpr (ALIGN_EPI) { if (wr == 0) PG8_BAR; }
        E(acc, cur, wid, lane);
        if (!has_next) break;
#pragma unroll
        for (int a = 0; a < 2; ++a)
#pragma unroll
            for (int b = 0; b < 2; ++b)
#pragma unroll
                for (int m = 0; m < 4; ++m)
#pragma unroll
                    for (int n = 0; n < 2; ++n) acc[a][b][m][n] = (f32x4){0.f, 0.f, 0.f, 0.f};
        cur = nxt; cA = nA; cB = nB; ++ui;
        if constexpr (ALIGN_EPI) { if (wr == 1) PG8_BAR; }
    }
    PG8_WAIT_V(0);
    if constexpr (!ALIGN_EPI) { if (wr == 0) PG8_BAR; }
    PG8_BAR;
#undef PG8_SA
#undef PG8_SB
#undef PG8_STAGE
#undef PG8_LDA
#undef PG8_LDB
#undef PG8_MMA
#undef PG8_WAIT_V
#undef PG8_WAIT_L
#undef PG8_BAR
#undef PG8_SCHED
#undef PG8_ABASE
#undef PG8_BBASE
}
}

struct TrItem { const float* W; int ldw, src_n0, k0; bf16_t* WT; int ldt, dst_n0; const float* rs; const float* cs; };
__device__ __forceinline__ void tr_load(const TrItem& d, float (&v)[32], int lane) {
    const float* wp = d.W + (size_t)(d.k0 + (lane >> 5)) * d.ldw + d.src_n0 + (lane & 31);
#pragma unroll
    for (int i = 0; i < 32; ++i) v[i] = wp[(size_t)(2 * i) * d.ldw];
}
__device__ __forceinline__ void tr_finish(const TrItem& d, const float (&v)[32], LAS float* scr, int lane) {
    const float csv = d.cs ? d.cs[d.src_n0 + (lane & 31)] : 1.0f;
#pragma unroll
    for (int i = 0; i < 32; ++i) { const int kk = 2 * i + (lane >> 5); float t = v[i]; if (d.rs) t *= d.rs[d.k0 + kk]; scr[kk * 33 + (lane & 31)] = t * csv; }
    asm volatile("s_waitcnt lgkmcnt(0)" ::: "memory");
    const int c = lane & 7;
#pragma unroll
    for (int j = 0; j < 4; ++j) { const int n = (lane >> 3) + 8 * j; const LAS float* s = scr + (8 * c) * 33 + n;
        u32x4 o; o.x = cvt_pk_bf16(s[0 * 33], s[1 * 33]); o.y = cvt_pk_bf16(s[2 * 33], s[3 * 33]); o.z = cvt_pk_bf16(s[4 * 33], s[5 * 33]); o.w = cvt_pk_bf16(s[6 * 33], s[7 * 33]);
        *(u32x4*)(d.WT + (size_t)(d.dst_n0 + n) * d.ldt + d.k0 + 8 * c) = o; }
    asm volatile("s_waitcnt lgkmcnt(0)" ::: "memory");
}
__device__ __forceinline__ bool conv_mat(int& r, const float* W, int K, int N, bf16_t* WT, const float* rs, const float* cs, bool glu, TrItem& d) {
    const int nblk = N / 32, items = (K / 64) * nblk;
    if (r >= items) { r -= items; return false; }
    const int kb = r / nblk, nb = r % nblk, n0 = nb * 32;
    d.W = W; d.ldw = N; d.src_n0 = glu ? ((n0 >> 8) * 128 + (n0 & 127) + ((n0 >> 7) & 1) * D) : n0; d.k0 = kb * 64; d.WT = WT; d.ldt = K; d.dst_n0 = n0; d.rs = rs; d.cs = cs;
    return true;
}

struct Args { const float* in[23]; float* out; unsigned char* ws; int lo, hi; };
typedef LAS const unsigned long long* PtrTab;
__device__ __forceinline__ const float* inptr(PtrTab tab, int k) {
    const unsigned long long v = tab[k];
    typedef const float __attribute__((address_space(1)))* GPF;
    return (const float*)(GPF)(((unsigned long long)(unsigned)__builtin_amdgcn_readfirstlane((int)(v >> 32)) << 32) | (unsigned long long)(unsigned)__builtin_amdgcn_readfirstlane((int)v));
}
#define INP(k) inptr(tab, (k))

__device__ __forceinline__ void decode_item(PtrTab tab, unsigned char* ws_, int i, int it, TrItem& d) {
    int r = it;
    if (i < 0) { constexpr int I1 = (D / 64) * (D / 32); const int mtx = it / I1, l = mtx & 3; r = it % I1;
        conv_mat(r, (mtx < 4 ? INP(17) : INP(18)) + (size_t)l * D * D, D, D, (bf16_t*)(ws_ + (mtx < 4 ? WS_WKT : WS_WVT)) + (size_t)l * D * D, nullptr, nullptr, false, d); return; }
    unsigned char* lw = ws_ + WS_LW + (size_t)(i & 1) * LW_SET; const int j = i >> 1;
    if (!(i & 1)) {
        if (conv_mat(r, INP(6) + (size_t)j * D * 2 * D, D, 2 * D, (bf16_t*)(lw + LW_WIN), INP(3) + i * D, nullptr, true, d)) return;
        if (conv_mat(r, INP(12) + (size_t)j * D * D, D, D, (bf16_t*)(lw + LW_WOUT), nullptr, nullptr, false, d)) return;
    } else {
        const int g = r >> 5;
        if (g < 4) { r &= 31; conv_mat(r, INP(14) + ((size_t)j * 4 + g) * 65536, 256, 256, (bf16_t*)(lw + LW_WIN) + (size_t)g * 65536, nullptr, INP(15) + j * D + g * 256, false, d); return; }
        r -= 128;
    }
    if (conv_mat(r, INP(16) + (size_t)i * D * D, D, D, (bf16_t*)(lw + LW_WQ), INP(4) + i * D, nullptr, false, d)) return;
    if (conv_mat(r, INP(19) + (size_t)i * D * D, D, D, (bf16_t*)(lw + LW_WO), nullptr, nullptr, false, d)) return;
    if (conv_mat(r, INP(20) + (size_t)i * D * FF, D, FF, (bf16_t*)(lw + LW_W1), INP(5) + i * D, nullptr, false, d)) return;
    conv_mat(r, INP(21) + (size_t)i * FF * D, FF, D, (bf16_t*)(lw + LW_W2), nullptr, nullptr, false, d);
}
__device__ __forceinline__ void convert_job(PtrTab tab, unsigned char* ws_, int i, LAS float* scr, int gw, int NGW, int lane) {
    const int I_MIX = !(i & 1) ? (D / 64) * (2 * D / 32) + (D / 64) * (D / 32) : 4 * (256 / 64) * (256 / 32);
    const int NITEMS = (i < 0) ? 8 * (D / 64) * (D / 32) : I_MIX + 2 * (D / 64) * (D / 32) + 2 * (D / 64) * (FF / 32);
    int it = gw; if (it >= NITEMS) return;
    TrItem d0; float v0[32];
    decode_item(tab, ws_, i, it, d0); tr_load(d0, v0, lane);
    for (;;) {
        const int it2 = it + NGW; const bool has = it2 < NITEMS;
        TrItem d1; float v1[32];
        if (has) { decode_item(tab, ws_, i, it2, d1); tr_load(d1, v1, lane); }
        tr_finish(d0, v0, scr, lane);
        if (!has) break;
        d0 = d1; it = it2;
#pragma unroll
        for (int q = 0; q < 32; ++q) v0[q] = v1[q];
    }
}

__device__ __forceinline__ void dw_phase(const bf16_t* GLU, bf16_t* V, const float* wdw, const float* bdw, const float* lng, const float* lnb, LAS float* red, int bid, int G, int tid) {
    const int lane = tid & 63, wave = tid >> 6;
    f32x2 wk[CW];
#pragma unroll
    for (int k = 0; k < CW; ++k) wk[k] = *(const f32x2*)(wdw + k * D + 2 * tid);
    const f32x2 bd = *(const f32x2*)(bdw + 2 * tid), lg = *(const f32x2*)(lng + 2 * tid), lb = *(const f32x2*)(lnb + 2 * tid);
    const unsigned* G32 = (const unsigned*)GLU; unsigned* V32 = (unsigned*)V;
    LAS f32x2* part = (LAS f32x2*)red;
    LAS f32x2* stat = (LAS f32x2*)(red + 256);
    const int ustart = (G == 256) ? (bid & 7) * 128 + (bid >> 3) * 4 : bid, ustep = (G == 256) ? 1 : G, uend = (G == 256) ? ustart + 4 : M / 16;
    unsigned raw[46];
    if (ustart < uend) { const int t0 = (ustart & 127) * 16; int vb = (ustart * 16 - 30) * 512 + tid; asm volatile("" : "+v"(vb));
#pragma unroll
        for (int r = 0; r < 46; ++r) raw[r] = (t0 - 30 + r >= 0) ? G32[vb + r * 512] : 0u; }
    for (int unit = ustart; unit < uend; unit += ustep) {
        const int t0 = (unit & 127) * 16, rowbase = unit * 16;
        f32x2 win[46];
#pragma unroll
        for (int r = 0; r < 46; ++r) win[r] = (f32x2){bf_lo(raw[r]), bf_hi(raw[r])};
        f32x2 o[16];
#pragma unroll
        for (int t = 0; t < 16; ++t) { f32x2 a = bd;
#pragma unroll
            for (int k = 0; k < CW; ++k) a = __builtin_elementwise_fma(wk[k], win[t + k], a);
            o[t] = a; }
        if (unit + ustep < uend) { const int nu = unit + ustep, nt0 = (nu & 127) * 16; int vb = (nu * 16 - 30) * 512 + tid; asm volatile("" : "+v"(vb));
#pragma unroll
            for (int r = 0; r < 46; ++r) raw[r] = (nt0 - 30 + r >= 0) ? G32[vb + r * 512] : 0u; }
#pragma unroll
        for (int t = 0; t < 16; ++t) {
            const float s1 = wave_sum(o[t].x + o[t].y, lane), s2 = wave_sum(o[t].x * o[t].x + o[t].y * o[t].y, lane);
            if (lane == 0) part[wave * 16 + t] = (f32x2){s1, s2};
        }
        asm volatile("s_waitcnt lgkmcnt(0)" ::: "memory"); __builtin_amdgcn_s_barrier(); asm volatile("" ::: "memory");
        if (tid < 16) { float s1 = 0.f, s2 = 0.f;
#pragma unroll
            for (int w = 0; w < 8; ++w) { const f32x2 p = part[w * 16 + tid]; s1 += p.x; s2 += p.y; }
            const float mean = s1 * (1.0f / D), var = fmaxf(s2 * (1.0f / D) - mean * mean, 0.f);
            stat[tid] = (f32x2){mean, rsqrtf(var + LN_EPS)}; }
        asm volatile("s_waitcnt lgkmcnt(0)" ::: "memory"); __builtin_amdgcn_s_barrier(); asm volatile("" ::: "memory");
#pragma unroll
        for (int t = 0; t < 16; ++t) {
            const f32x2 st = stat[t];
            float y0 = (o[t].x - st.x) * st.y * lg.x + lb.x, y1 = (o[t].y - st.x) * st.y * lg.y + lb.y;
            y0 = y0 * __builtin_amdgcn_rcpf(1.0f + __builtin_amdgcn_exp2f(-y0 * LOG2E)); y1 = y1 * __builtin_amdgcn_rcpf(1.0f + __builtin_amdgcn_exp2f(-y1 * LOG2E));
            V32[(size_t)(rowbase + t) * 512 + tid] = cvt_pk_bf16(y0, y1);
        }
        asm volatile("s_waitcnt lgkmcnt(0)" ::: "memory"); __builtin_amdgcn_s_barrier(); asm volatile("" ::: "memory");
    }
}

__device__ __forceinline__ float bcast_lane(float v, int k) { return __int_as_float(__builtin_amdgcn_readlane(__float_as_int(v), k)); }
template <int W>
__device__ __forceinline__ void pl_span(const bf16_t* XBs, const u64* ssq, bf16_t* PP, int unit0, int nsub, int tid, int lane, f32x2 g) {
    const unsigned* X32 = (const unsigned*)XBs; unsigned* P32 = (unsigned*)PP;
    const int t0 = (unit0 & 127) * 16, rowbase = unit0 * 16;
    const bool first = (t0 == 0);
    int vb = rowbase * 512 + tid; asm volatile("" : "+v"(vb));
    unsigned xh[W - 1], xc[16];
#pragma unroll
    for (int j = 0; j < W - 1; ++j) xh[j] = X32[vb + (first ? 0 : (j - (W - 1))) * 512];
    const int l5 = lane & 31;
    u64 q = ssq[rowbase + (l5 < 16 ? l5 : (first ? 0 : l5 - 32))];
#pragma unroll
    for (int j = 0; j < 16; ++j) xc[j] = X32[vb + j * 512];
    float rsl = rstd_of(q);
    f32x2 hist[W - 1]; f32x2 S = (f32x2){0.f, 0.f};
#pragma unroll
    for (int j = 0; j < W - 1; ++j) { const float r0 = bcast_lane(rsl, 32 - (W - 1) + j), rs = first ? 0.f : r0; hist[j] = (f32x2){bf_lo(xh[j]) * rs, bf_hi(xh[j]) * rs}; S += hist[j]; }
    constexpr float INVW = 1.0f / (float)W;
    for (int c = 0; c < nsub; ++c) {
        const bool more = (c + 1 < nsub);
        f32x2 ext[W - 1 + 16];
#pragma unroll
        for (int j = 0; j < W - 1; ++j) ext[j] = hist[j];
#pragma unroll
        for (int j = 0; j < 16; ++j) { const float rs = bcast_lane(rsl, j); ext[W - 1 + j] = (f32x2){bf_lo(xc[j]) * rs, bf_hi(xc[j]) * rs}; }
        const bool head = first && c == 0;
#pragma unroll
        for (int j = 0; j < 16; ++j) {
            S += ext[W - 1 + j];
            const float inv = head ? (1.0f / (float)((j + 1 < W) ? j + 1 : W)) : INVW;
            const f32x2 p = (S * inv - ext[W - 1 + j]) * g;
            P32[vb + (16 * c + j) * 512] = cvt_pk_bf16(p.x, p.y);
            S -= ext[j];
        }
#pragma unroll
        for (int j = 0; j < W - 1; ++j) hist[j] = ext[16 + j];
        if (more) {
#pragma unroll
            for (int j = 0; j < 16; ++j) xc[j] = X32[vb + (16 * (c + 1) + j) * 512];
            rsl = rstd_of(ssq[rowbase + 16 * (c + 1) + (lane & 15)]);
        }
    }
}
__device__ __forceinline__ void pl_phase(const bf16_t* X, const u64* ssq, const float* gain, bf16_t* PP, int bid, int G, int tid) {
    const f32x2 g = *(const f32x2*)(gain + 2 * tid); const int grp = __builtin_amdgcn_readfirstlane(tid >> 7), lane = tid & 63;
    const int ustart = (G == 256) ? (bid & 7) * 128 + (bid >> 3) * 4 : bid, ustep = (G == 256) ? 4 : G, uend = (G == 256) ? ustart + 4 : M / 16, nsub = (G == 256) ? 4 : 1;
    for (int unit = ustart; unit < uend; unit += ustep) {
        if (grp == 0) pl_span<2>(X, ssq, PP, unit, nsub, tid, lane, g);
        else if (grp == 1) pl_span<4>(X, ssq, PP, unit, nsub, tid, lane, g);
        else if (grp == 2) pl_span<8>(X, ssq, PP, unit, nsub, tid, lane, g);
        else pl_span<16>(X, ssq, PP, unit, nsub, tid, lane, g);
    }
}

#define XB_TMO      128
#define XB_XCNT(j)  (256  + 64 * (j))
#define XB_XSUB(j)  (1280 + 64 * (j))
#define XB_XGEN(j)  (2304 + 64 * (j))
#define XB_TOP      3328
#define XB_TOPGEN   3392
#define XB_LSUB(j)  (3456 + 64 * (j))
#define XB_LGEN(j)  (4480 + 64 * (j))
#define XB_GMASK(j) (5504 + (j))
#define XCD_BAR_WORDS 5632
#define XB_SPIN_CAP (1u << 18)
__device__ __forceinline__ unsigned xb_ld(unsigned* p)              { return __hip_atomic_load(p, __ATOMIC_RELAXED, __HIP_MEMORY_SCOPE_AGENT); }
__device__ __forceinline__ unsigned xb_add(unsigned* p, unsigned v) { return __hip_atomic_fetch_add(p, v, __ATOMIC_RELAXED, __HIP_MEMORY_SCOPE_AGENT); }
__device__ __forceinline__ unsigned xb_xcc_id() { return (unsigned)__builtin_amdgcn_s_getreg((3 << 11) | 20) & 0xFu; }
#define XB_SPIN(cond, bar) do { unsigned _sp = 0; while (cond) { __builtin_amdgcn_s_sleep(1); \
    if ((++_sp & 255u) == 0u) { if (xb_ld(&(bar)[XB_TMO])) break; if (_sp > XB_SPIN_CAP) { atomicAdd(&(bar)[XB_TMO], 1u); break; } } } } while (0)
struct XcdBarrier { unsigned* bar; unsigned x; volatile LAS unsigned* st; };
__device__ __forceinline__ void xcd_barrier_complete(unsigned* bar, unsigned x, unsigned& nloc, unsigned& nx) {
    const unsigned G = gridDim.x * gridDim.y * gridDim.z;
    unsigned sum, cnt, mine, sp = 0u;
    for (;;) {
        sum = 0u; cnt = 0u; mine = 0u;
#pragma unroll
        for (unsigned j = 0; j < 16; ++j) { const unsigned c = xb_ld(&bar[XB_XCNT(j)]); sum += c; cnt += (c > 0u) ? 1u : 0u; mine = (j == x) ? c : mine; }
        if (sum == G) break;
        __builtin_amdgcn_s_sleep(1);
        if ((++sp & 255u) == 0u) { if (xb_ld(&bar[XB_TMO])) break; if (sp > XB_SPIN_CAP) { atomicAdd(&bar[XB_TMO], 1u); break; } }
    }
    nloc = mine > 0u ? mine : 1u; nx = cnt > 0u ? cnt : 1u;
}
__device__ __forceinline__ void xcd_barrier(unsigned* bar_, volatile LAS unsigned* st_) {
    XcdBarrier b; b.bar = bar_; b.st = st_; b.x = xb_xcc_id();
    asm volatile("s_waitcnt vmcnt(0)" ::: "memory");
    __syncthreads();
    if (threadIdx.x == 0) {
        unsigned* bar = b.bar;
        __builtin_amdgcn_s_waitcnt(0);
        unsigned nloc = b.st[0], nx = b.st[1];
        if (nloc == 0u) { xcd_barrier_complete(bar, b.x, nloc, nx); b.st[0] = nloc; b.st[1] = nx; }
        const unsigned old = xb_add(&bar[XB_XSUB(b.x)], 1u);
        const unsigned gen = old / nloc;
        if (old + 1u == (gen + 1u) * nloc) {
            __builtin_amdgcn_fence(__ATOMIC_RELEASE, "agent");
            asm volatile("s_waitcnt vmcnt(0)" ::: "memory");
            const unsigned og = xb_add(&bar[XB_TOP], 1u);
            const unsigned tg = og / nx;
            if (og + 1u == (tg + 1u) * nx) xb_add(&bar[XB_TOPGEN], 1u);
            else XB_SPIN(xb_ld(&bar[XB_TOPGEN]) == tg, bar);
            __builtin_amdgcn_fence(__ATOMIC_ACQUIRE, "agent");
            xb_add(&bar[XB_XGEN(b.x)], 1u);
            asm volatile("s_waitcnt vmcnt(0)" ::: "memory");
        } else {
            XB_SPIN(xb_ld(&bar[XB_XGEN(b.x)]) == gen, bar);
            __builtin_amdgcn_fence(__ATOMIC_ACQUIRE, "agent");
            asm volatile("s_waitcnt vmcnt(0)" ::: "memory");
        }
    }
    __syncthreads();
}

__device__ __forceinline__ void xcd_local_barrier(unsigned* bar, unsigned grp, unsigned nloc) {
    asm volatile("s_waitcnt vmcnt(0)" ::: "memory");
    __syncthreads();
    if (threadIdx.x == 0) {
        __builtin_amdgcn_s_waitcnt(0);
        const unsigned old = xb_add(&bar[XB_LSUB(grp)], 1u);
        const unsigned gen = old / nloc;
        if (old + 1u == (gen + 1u) * nloc) xb_add(&bar[XB_LGEN(grp)], 1u);
        else XB_SPIN(xb_ld(&bar[XB_LGEN(grp)]) == gen, bar);
        __builtin_amdgcn_fence(__ATOMIC_ACQUIRE, "agent");
        asm volatile("s_waitcnt vmcnt(0)" ::: "memory");
    }
    __syncthreads();
}

enum { K_PRO = 0, K_KV, K_G1, K_DW, K_G2, K_PL, K_GP, K_GQ, K_S, K_PV, K_WO, K_UP, K_DOWN, K_FINAL };
constexpr int N_PHASES = 2 + 2 * 17 + 1;
__host__ __device__ __forceinline__ void decode_phase(int ph, int& kind, int& layer) {
    if (ph == 0) { kind = K_PRO; layer = 0; return; }
    if (ph == 1) { kind = K_KV; layer = 0; return; }
    if (ph == N_PHASES - 1) { kind = K_FINAL; layer = 0; return; }
    const int q = ph - 2, pair = q / 17, r = q % 17;
    if (r < 9) { layer = 2 * pair; kind = (r < 3) ? (K_G1 + r) : (K_GQ + (r - 3)); }
    else { layer = 2 * pair + 1; const int s = r - 9; kind = (s < 2) ? (K_PL + s) : (K_GQ + (s - 2)); }
}

__global__ void __launch_bounds__(512, 2) fwd_megakernel(Args args) {
    extern __shared__ __attribute__((aligned(16))) unsigned char lds_raw[];
    LAS unsigned char* lds = (LAS unsigned char*)lds_raw;
    const int G0 = gridDim.x, bid0 = blockIdx.x, bid = bid0;
    const int wave_s = __builtin_amdgcn_readfirstlane(threadIdx.x >> 6);
    unsigned char* ws = args.ws;
    u64* SSQ = (u64*)(ws + WS_SSQ);
    float* X = args.out;
    bf16_t* XB = (bf16_t*)(ws + WS_XB);
    bf16_t* KALL = (bf16_t*)(ws + WS_KALL); bf16_t* VT = (bf16_t*)(ws + WS_VT);
    bf16_t* S0 = (bf16_t*)(ws + WS_S0); bf16_t* S1 = (bf16_t*)(ws + WS_S1); bf16_t* S2 = (bf16_t*)(ws + WS_S2); bf16_t* HM = (bf16_t*)(ws + WS_H);
    LAS float* exf = (LAS float*)(lds + EX_OFF);
    if (threadIdx.x < 4) ((volatile LAS unsigned*)(lds + BARST_OFF))[threadIdx.x] = 0u;
    if (threadIdx.x == 0) {
#pragma unroll
        for (int k = 0; k < 23; ++k) ((LAS unsigned long long*)(lds + PTAB_OFF))[k] = (unsigned long long)args.in[k];
    }
    __syncthreads();
    PtrTab tab = (PtrTab)(lds + PTAB_OFF);
    if (threadIdx.x == 0) {
        unsigned* bar0 = (unsigned*)(args.ws + WS_BAR); const unsigned x = xb_xcc_id();
        (void)xb_add(bar0 + XB_XCNT(x), 1u); (void)__hip_atomic_fetch_or(bar0 + XB_GMASK(bid & 7), 1u << x, __ATOMIC_RELAXED, __HIP_MEMORY_SCOPE_AGENT);
    }
    if (args.lo < 0) cg::this_grid().sync();

#pragma unroll 1
    for (int ph = args.lo; ph < args.hi; ++ph) {
        int lane; asm volatile("v_mbcnt_lo_u32_b32 %0, -1, 0\n\tv_mbcnt_hi_u32_b32 %0, -1, %0" : "=v"(lane));
        int G = G0, bid = bid0, wave = wave_s; asm volatile("" : "+s"(G), "+s"(bid), "+s"(wave));
        const int tid = wave * 64 + lane;
        const int gw = bid * 8 + wave, NGW = G * 8;
        LAS float* scr = (LAS float*)(lds + wave * 16384);
        int kind, i; decode_phase(ph, kind, i);
        if (ph >= LAST_PH && ph < N_PHASES - 1) kind = -1;
        const int j = i >> 1;
        unsigned char* lw = ws + WS_LW + (size_t)(i & 1) * LW_SET;
        switch (kind) {
        case K_PRO: {
            { unsigned z = 0u; asm volatile("" : "+v"(z));
              for (int u = bid * 512 + tid; u < 12 * M / 2; u += G * 512) ((u32x4*)(SSQ + M))[u] = (u32x4){z, z, z, z}; }
            convert_job(tab, ws, -1, scr, gw, NGW, lane);
            for (int m = gw; m < MEMR; m += NGW) {
                const f32x4* xr = (const f32x4*)(INP(1) + (size_t)m * D) + lane; f32x4 v[4]; float s = 0.f;
#pragma unroll
                for (int q = 0; q < 4; ++q) { v[q] = xr[64 * q]; s += (v[q].x * v[q].x + v[q].y * v[q].y) + (v[q].z * v[q].z + v[q].w * v[q].w); }
                const float rs = rsqrtf(wave_sum(s, lane) * (1.0f / D) + RMS_EPS);
                u32x2* o8 = (u32x2*)((bf16_t*)(ws + WS_MEMN) + (size_t)m * D) + lane;
#pragma unroll
                for (int q = 0; q < 4; ++q) { const f32x4 gq = ((const f32x4*)INP(2))[lane + 64 * q]; u32x2 w; w.x = cvt_pk_bf16(v[q].x * rs * gq.x, v[q].y * rs * gq.y); w.y = cvt_pk_bf16(v[q].z * rs * gq.z, v[q].w * rs * gq.w); o8[64 * q] = w; }
            }
            const int m0 = (G == 256) ? (bid & 7) * SEQ + (bid >> 3) * 8 + wave : gw, mstep = (G == 256) ? 256 : NGW, mend = (G == 256) ? ((bid & 7) + 1) * SEQ : M;
            for (int m = m0; m < mend; m += mstep) {
                const f32x4* xr = (const f32x4*)(INP(0) + (size_t)m * D) + lane; f32x4 v[4]; float s = 0.f;
                u32x2* o8 = (u32x2*)(XB + (size_t)m * D) + lane;
#pragma unroll
                for (int q = 0; q < 4; ++q) { v[q] = xr[64 * q]; u32x2 w; w.x = cvt_pk_bf16(v[q].x, v[q].y); w.y = cvt_pk_bf16(v[q].z, v[q].w); o8[64 * q] = w;
                    const float a = bf_lo(w.x), b = bf_hi(w.x), c = bf_lo(w.y), d = bf_hi(w.y); s += (a * a + b * b) + (c * c + d * d); }
                s = wave_sum(s, lane);
                if (lane == 0) SSQ[m] = (u64)(s * SSQ_SCALE);
            }
            convert_job(tab, ws, 0, scr, gw, NGW, lane);
        } break;
        case K_KV: {
            {
                pg8::Gemm g{(const bf16_t*)(ws + WS_MEMN), (const bf16_t*)(ws + WS_WKT), D, D, D, 256L * D, 0, 256L * D, 0};
                pg8::Order S; S.init(MEMR / 256, 4 * D / 256, G, bid);
                pg8::EpiBf E{KALL, 4 * D, nullptr, 1.0f, 0};
                pg8::gemm_phase<pg8::EpiBf, true>(lds, g, S, E, tid);
            }
            {
                pg8::Gemm g{(const bf16_t*)(ws + WS_WVT), (const bf16_t*)(ws + WS_MEMN), D, D, D, 256L * D, 0, 256L * D, 0};
                pg8::Order S; S.init(4 * D / 256, MEMR / 256, G, (bid + G / 2) % G);
                pg8::EpiBf E{VT, MEMR, nullptr, 1.0f, 0};
                pg8::gemm_phase<pg8::EpiBf, true>(lds, g, S, E, tid);
            }
        } break;
        case K_G1: {
            pg8::Gemm g{XB, (const bf16_t*)(lw + LW_WIN), D, D, D, 256L * D, 0, 256L * D, 0};
            pg8::Order S; S.init(M / 256, 2 * D / 256, G, bid);
            pg8::EpiGlu E{S0, INP(7) + j * 2 * D, SSQ + (size_t)(3 * i) * M};
            pg8::gemm_phase<pg8::EpiGlu, true>(lds, g, S, E, tid);
        } break;
        case K_DW: {
            dw_phase(S0, S1, INP(8) + (size_t)j * CW * D, INP(9) + j * D, INP(10) + j * D, INP(11) + j * D, exf, bid, G, tid);
        } break;
        case K_PL: {
            pl_phase(XB, SSQ + (size_t)(3 * i) * M, INP(3) + i * D, S0, bid, G, tid);
        } break;
        case K_G2: case K_GP: case K_WO: case K_DOWN: {
            pg8::Gemm g; pg8::EpiRes E; E.xb = XB; E.bias = nullptr;
            if (kind == K_G2) { g = pg8::Gemm{S1, (const bf16_t*)(lw + LW_WOUT), D, D, D, 256L * D, 0, 256L * D, 0}; E.bias = INP(13) + j * D; E.ssq_next = SSQ + (size_t)(3 * i + 1) * M; }
            else if (kind == K_GP) { g = pg8::Gemm{S0, (const bf16_t*)(lw + LW_WIN), D, 256, 256, 256L * D, 256, 65536, 0}; E.ssq_next = SSQ + (size_t)(3 * i + 1) * M; }
            else if (kind == K_WO) { g = pg8::Gemm{S2, (const bf16_t*)(lw + LW_WO), D, D, D, 256L * D, 0, 256L * D, 0}; E.ssq_next = SSQ + (size_t)(3 * i + 2) * M; }
            else { g = pg8::Gemm{HM, (const bf16_t*)(lw + LW_W2), FF, FF, FF, 256L * FF, 0, 256L * FF, 0}; E.ssq_next = SSQ + (size_t)(3 * i + 3) * M; }
            pg8::Order S; S.init(M / 256, D / 256, G, bid);
            pg8::gemm_phase<pg8::EpiRes, true>(lds, g, S, E, tid);
        } break;
        case K_GQ: case K_UP: case K_PV: {
            pg8::Gemm g; pg8::EpiBf E; int nN = D / 256;
            if (kind == K_GQ) { g = pg8::Gemm{XB, (const bf16_t*)(lw + LW_WQ), D, D, D, 256L * D, 0, 256L * D, 0}; E = pg8::EpiBf{S0, D, SSQ + (size_t)(3 * i + 1) * M, 0.0625f, 0}; }
            else if (kind == K_UP) { g = pg8::Gemm{XB, (const bf16_t*)(lw + LW_W1), D, D, D, 256L * D, 0, 256L * D, 0}; E = pg8::EpiBf{HM, FF, SSQ + (size_t)(3 * i + 2) * M, 1.0f, 1}; nN = FF / 256; }
            else { g = pg8::Gemm{S1, VT + (size_t)i * D * MEMR, D, MEMR, 256, 256L * D, 256, 256L * MEMR, 256}; E = pg8::EpiBf{S2, D, nullptr, 1.0f, 0}; }
            pg8::Order S; S.init(M / 256, nN, G, bid);
            pg8::gemm_phase<pg8::EpiBf, true>(lds, g, S, E, tid);
            if (kind == K_PV && i + 1 < 4) convert_job(tab, ws, i + 1, scr, gw, NGW, lane);
        } break;
        case K_S: {
            pg8::Gemm g{S0, KALL + (size_t)i * D, D, 4 * D, 256, 256L * D, 256, 256, 256L * 4 * D};
            pg8::Order S; S.init(M / 256, D / 256, G, bid);
            pg8::EpiSoftmax E{S1, (LAS f32x2*)exf};
            pg8::gemm_phase<pg8::EpiSoftmax, true>(lds, g, S, E, tid);
        } break;
        case K_FINAL: {
            const int m0 = (G == 256) ? (bid & 7) * SEQ + (bid >> 3) * 8 + wave : gw, mstep = (G == 256) ? 256 : NGW, mend = (G == 256) ? ((bid & 7) + 1) * SEQ : M;
            for (int m = m0; m < mend; m += mstep) {
                f32x4* xr = (f32x4*)(X + (size_t)m * D) + lane; const u32x2* xi = (const u32x2*)(XB + (size_t)m * D) + lane; f32x4 v[4]; float s = 0.f;
#pragma unroll
                for (int q = 0; q < 4; ++q) { const u32x2 w = xi[64 * q]; v[q] = (f32x4){bf_lo(w.x), bf_hi(w.x), bf_lo(w.y), bf_hi(w.y)}; s += (v[q].x * v[q].x + v[q].y * v[q].y) + (v[q].z * v[q].z + v[q].w * v[q].w); }
                const float rs = rsqrtf(wave_sum(s, lane) * (1.0f / D) + RMS_EPS);
#pragma unroll
                for (int q = 0; q < 4; ++q) { const f32x4 gq = ((const f32x4*)INP(22))[lane + 64 * q]; f32x4 o = v[q] * rs; o.x *= gq.x; o.y *= gq.y; o.z *= gq.z; o.w *= gq.w; xr[64 * q] = o; }
            }
        } break;
        }
        if (ph + 1 < args.hi) {
            unsigned* bar = (unsigned*)(args.ws + WS_BAR); volatile LAS unsigned* st = (volatile LAS unsigned*)(lds + BARST_OFF);
            if (kind == K_GQ || kind == K_S) {
                asm volatile("s_waitcnt vmcnt(0)" ::: "memory"); __syncthreads();
                if (threadIdx.x == 0) { __builtin_amdgcn_fence(__ATOMIC_ACQUIRE, "agent"); asm volatile("s_waitcnt vmcnt(0)" ::: "memory"); }
                __syncthreads();
            } else if (ph <= 1 || (kind == K_DOWN && i < 3) || st[2] != 1u) {
                xcd_barrier(bar, st);
                if (ph == 1) {
                    if (threadIdx.x == 0) { bool pure = (G == 256 && st[0] == 32u && st[1] == 8u);
#pragma unroll
                        for (int g8 = 0; g8 < 8; ++g8) pure = pure && (__builtin_popcount(xb_ld(bar + XB_GMASK(g8))) == 1);
                        st[2] = (pure && !FORCE_FALLBACK) ? 1u : 2u; }
                    __syncthreads();
                }
            } else xcd_local_barrier(bar, (unsigned)(bid & 7), 32u);
        }
    }
}

extern "C" void kernel_launch(void* const* d_in, const int* in_sizes, int n_in, void* d_out, int out_size, void* d_ws, size_t ws_size, hipStream_t stream) {
    static int grid = 0;
    if (grid == 0) {
        if (n_in != 23 || out_size != M * D || ws_size < WS_END) { fprintf(stderr, "kernel_launch: unexpected problem (n_in %d out %d ws %zu)\n", n_in, out_size, ws_size); grid = -1; return; }
        int dev = 0, cus = 0, per_cu = 0;
        hipGetDevice(&dev); hipDeviceGetAttribute(&cus, hipDeviceAttributeMultiprocessorCount, dev);
        hipFuncSetAttribute((const void*)fwd_megakernel, hipFuncAttributeMaxDynamicSharedMemorySize, LDS_BYTES);
        if (hipOccupancyMaxActiveBlocksPerMultiprocessor(&per_cu, (const void*)fwd_megakernel, 512, LDS_BYTES) != hipSuccess || per_cu < 1) { fprintf(stderr, "kernel_launch: occupancy query gave %d\n", per_cu); per_cu = 1; }
        (void)hipGetLastError();
        grid = cus * per_cu;
    }
    if (grid < 0) return;
    (void)hipMemsetAsync((unsigned char*)d_ws + WS_BAR, 0, XCD_BAR_WORDS * 4, stream);
    Args a{};
    for (int i = 0; i < 23; ++i) a.in[i] = (const float*)d_in[i];
    a.out = (float*)d_out; a.ws = (unsigned char*)d_ws;
#if MK_PER_PHASE
    for (int ph = 0; ph < N_PHASES; ++ph) { a.lo = ph; a.hi = ph + 1; hipLaunchKernelGGL(fwd_megakernel, dim3(grid), dim3(512), LDS_BYTES, stream, a); }
#else
    a.lo = 0; a.hi = N_PHASES;
    void* kargs[] = {&a};
    hipError_t e = hipLaunchCooperativeKernel((const void*)fwd_megakernel, dim3(grid), dim3(512), kargs, LDS_BYTES, stream);
    if (e != hipSuccess) fprintf(stderr, "cooperative launch failed: %s (grid %d)\n", hipGetErrorString(e), grid);
#endif
}
```

```cpp
#include <hip/hip_runtime.h>
#include <hip/hip_cooperative_groups.h>
#include <cstdio>
#include <cstdint>
namespace cg = cooperative_groups;

#ifndef MK_PER_PHASE
#define MK_PER_PHASE 0
#endif

#ifndef LAST_PH
#define LAST_PH 99
#endif
#ifndef FORCE_FALLBACK
#define FORCE_FALLBACK 0
#endif
#define LAS __attribute__((address_space(3)))
typedef unsigned short bf16_t;
typedef short bf16x8 __attribute__((ext_vector_type(8)));
typedef float f32x4 __attribute__((ext_vector_type(4)));
typedef float f32x2 __attribute__((ext_vector_type(2)));
typedef unsigned u32x4 __attribute__((ext_vector_type(4)));
typedef unsigned u32x2 __attribute__((ext_vector_type(2)));

constexpr int D = 1024, NB = 8, SEQ = 2048, M = NB * SEQ, FF = 4096, MEML = 256, MEMR = NB * MEML, CW = 31;
constexpr float RMS_EPS = 1e-6f, LN_EPS = 1e-5f;
constexpr float LOG2E = 1.4426950408889634f;
typedef unsigned long long u64;
constexpr float SSQ_SCALE = 1048576.0f, SSQ_INV = 1.0f / (1048576.0f * 1024.0f);
__device__ __forceinline__ float rstd_of(u64 q) { return rsqrtf((float)q * SSQ_INV + 1e-6f); }

constexpr size_t MiB = 1u << 20;
constexpr size_t WS_SSQ = 0;
constexpr size_t WS_BAR = 2 * MiB - 32768;
constexpr size_t WS_LW = 2 * MiB;
constexpr size_t LW_SET = 26 * MiB;
constexpr size_t LW_WIN = 0, LW_WOUT = 4 * MiB, LW_WQ = 6 * MiB, LW_WO = 8 * MiB, LW_W1 = 10 * MiB, LW_W2 = 18 * MiB;
constexpr size_t WS_XB = WS_LW + 2 * LW_SET;
constexpr size_t WS_KALL = WS_XB + 32 * MiB;
constexpr size_t WS_VT = WS_KALL + 16 * MiB;
constexpr size_t WS_H = WS_VT + 16 * MiB;
constexpr size_t WS_S0 = WS_H, WS_S1 = WS_H + 32 * MiB, WS_S2 = WS_H + 64 * MiB, WS_S3 = WS_H + 96 * MiB;
constexpr size_t WS_WKT = WS_S3, WS_WVT = WS_S3 + 8 * MiB, WS_MEMN = WS_S3 + 16 * MiB;
constexpr size_t WS_END = WS_H + 128 * MiB;

constexpr int RING_BYTES = 131072, EX_OFF = RING_BYTES, BARST_OFF = RING_BYTES + 8192, PTAB_OFF = BARST_OFF + 64, LDS_BYTES = RING_BYTES + 8192 + 2048;

__device__ __forceinline__ unsigned cvt_pk_bf16(float lo, float hi) { unsigned r; asm volatile("v_cvt_pk_bf16_f32 %0, %1, %2" : "=v"(r) : "v"(lo), "v"(hi)); return r; }
__device__ __forceinline__ float shx(float v, int lane, int o) { return __int_as_float(__builtin_amdgcn_ds_bpermute((lane ^ o) << 2, __float_as_int(v))); }
__device__ __forceinline__ float wave_sum(float v, int lane) {
#pragma unroll
    for (int o = 1; o < 64; o <<= 1) v += shx(v, lane, o);
    return v;
}
template <int CTRL> __device__ __forceinline__ float dpp_mov(float v) { return __int_as_float(__builtin_amdgcn_update_dpp(0, __float_as_int(v), CTRL, 0xf, 0xf, false)); }
__device__ __forceinline__ float wave_sum_dpp(float v) {
    v += dpp_mov<0xB1>(v);
    v += dpp_mov<0x4E>(v);
    v += dpp_mov<0x141>(v);
    v += dpp_mov<0x140>(v);
    const int b = __float_as_int(v);
    return (__int_as_float(__builtin_amdgcn_readlane(b, 0)) + __int_as_float(__builtin_amdgcn_readlane(b, 16))) + (__int_as_float(__builtin_amdgcn_readlane(b, 32)) + __int_as_float(__builtin_amdgcn_readlane(b, 48)));
}
__device__ __forceinline__ float bf_lo(unsigned u) { return __uint_as_float(u << 16); }
__device__ __forceinline__ float bf_hi(unsigned u) { return __uint_as_float(u & 0xffff0000u); }

namespace pg8 {
constexpr int BM = 256, BK = 64, HALF = 128, HTB = HALF * BK * 2, STAGE_BYTES = 8 * HTB, NXCD = 8, WGM = 8;
__host__ __device__ __forceinline__ int lds_byte(int r, int c) { const int st = (r >> 4) * 2 + (c >> 5), rr = r & 15, cc = c & 31, ob = rr * 64 + cc * 2; return st * 1024 + (ob ^ (((ob >> 9) & 1) << 5)); }
__host__ __device__ __forceinline__ void stage_rc(int b, int& R, int& C) { const int st = b / 1024, sb = b % 1024, swz = sb ^ (((sb >> 9) & 1) << 5); R = (st >> 1) * 16 + swz / 64; C = (st & 1) * 32 + (swz % 64) / 2; }
__host__ __device__ __forceinline__ int perm32(int rho) { const int n = rho >> 4, i = rho & 15; return 8 * (i >> 2) + 4 * n + (i & 3); }

struct Unit { int pm, pn; };
struct Gemm { const bf16_t* A; const bf16_t* Bt; int lda, ldb, K; long a_pm, a_pn, b_pn, b_b; };

struct Order {
    int nM, nN, nwg, G, c;
    __device__ __forceinline__ void init(int nM_, int nN_, int G_, int c_) { nM = nM_; nN = nN_; nwg = nM * nN; G = G_; c = c_; }
    __device__ __forceinline__ bool next(int i, Unit& u) const {
        const long L = (long)i * G + c; if (L >= nwg) return false;
        int wgid = (int)L; { const int q = nwg / NXCD, r = nwg % NXCD, xcd = wgid % NXCD, off = wgid / NXCD; wgid = (xcd < r ? xcd * (q + 1) : r * (q + 1) + (xcd - r) * q) + off; }
        const int nig = WGM * nN, gid = wgid / nig, fm = gid * WGM, gsz = (nM - fm) < WGM ? (nM - fm) : WGM;
        u.pm = fm + ((wgid % nig) % gsz); u.pn = (wgid % nig) / gsz; return true;
    }
};


struct EpiBf {
    bf16_t* O; int ldc; const u64* ssq; float cs; int act;
    __device__ __forceinline__ void operator()(f32x4 (&acc)[2][2][4][2], const Unit& u, int wid, int lane_) const {
        int lane; asm volatile("v_mbcnt_lo_u32_b32 %0, -1, 0\n\tv_mbcnt_hi_u32_b32 %0, -1, %0" : "=v"(lane));
        (void)lane_;
        const int wr = wid >> 2, wc = wid & 3, fr = lane & 15, fq = lane >> 4;
        const int row0 = u.pm * BM + wr * 64 + fr, col0 = u.pn * BM + wc * 32 + 8 * fq;
#pragma unroll
        for (int ai = 0; ai < 2; ++ai)
#pragma unroll
            for (int m = 0; m < 4; ++m) {
                const int r = row0 + ai * HALF + m * 16;
                float rs = cs; if (ssq) rs *= rstd_of(ssq[r]);
                bf16_t* rowp = O + (size_t)r * ldc + col0;
#pragma unroll
                for (int bj = 0; bj < 2; ++bj) {
                    f32x4 v0 = acc[ai][bj][m][0] * rs, v1 = acc[ai][bj][m][1] * rs;
                    if (act) {
#pragma unroll
                        for (int j = 0; j < 4; ++j) { const float a = fmaxf(v0[j], 0.f), b = fmaxf(v1[j], 0.f); v0[j] = a * a; v1[j] = b * b; }
                    }
                    u32x4 w; w.x = cvt_pk_bf16(v0[0], v0[1]); w.y = cvt_pk_bf16(v0[2], v0[3]); w.z = cvt_pk_bf16(v1[0], v1[1]); w.w = cvt_pk_bf16(v1[2], v1[3]);
                    *(u32x4*)(rowp + bj * HALF) = w;
                }
            }
    }
};
struct EpiGlu {
    bf16_t* O; const float* bias; const u64* ssq;
    __device__ __forceinline__ void operator()(f32x4 (&acc)[2][2][4][2], const Unit& u, int wid, int lane_) const {
        int lane; asm volatile("v_mbcnt_lo_u32_b32 %0, -1, 0\n\tv_mbcnt_hi_u32_b32 %0, -1, %0" : "=v"(lane));
        (void)lane_;
        const int wr = wid >> 2, wc = wid & 3, fr = lane & 15, fq = lane >> 4;
        const int row0 = u.pm * BM + wr * 64 + fr, ch0 = u.pn * HALF + wc * 32 + 8 * fq;
        f32x4 ba[2], bg[2];
#pragma unroll
        for (int n = 0; n < 2; ++n) { ba[n] = *(const f32x4*)(bias + ch0 + 4 * n); bg[n] = *(const f32x4*)(bias + D + ch0 + 4 * n); }
#pragma unroll
        for (int ai = 0; ai < 2; ++ai)
#pragma unroll
            for (int m = 0; m < 4; ++m) {
                const int r = row0 + ai * HALF + m * 16;
                const float rs = rstd_of(ssq[r]);
                f32x4 o[2];
#pragma unroll
                for (int n = 0; n < 2; ++n) {
                    const f32x4 a = acc[ai][0][m][n] * rs + ba[n], g = acc[ai][1][m][n] * rs + bg[n];
#pragma unroll
                    for (int j = 0; j < 4; ++j) o[n][j] = a[j] * __builtin_amdgcn_rcpf(1.0f + __builtin_amdgcn_exp2f(-g[j] * LOG2E));
                }
                u32x4 w; w.x = cvt_pk_bf16(o[0][0], o[0][1]); w.y = cvt_pk_bf16(o[0][2], o[0][3]); w.z = cvt_pk_bf16(o[1][0], o[1][1]); w.w = cvt_pk_bf16(o[1][2], o[1][3]);
                *(u32x4*)(O + (size_t)r * D + ch0) = w;
            }
    }
};
struct EpiRes {
    bf16_t* xb; const float* bias; u64* ssq_next;
    __device__ __forceinline__ void operator()(f32x4 (&acc)[2][2][4][2], const Unit& u, int wid, int lane_) const {
        int lane; asm volatile("v_mbcnt_lo_u32_b32 %0, -1, 0\n\tv_mbcnt_hi_u32_b32 %0, -1, %0" : "=v"(lane));
        (void)lane_;
        const int wr = wid >> 2, wc = wid & 3, fr = lane & 15, fq = lane >> 4;
        const int row0 = u.pm * BM + wr * 64 + fr, col0 = u.pn * BM + wc * 32 + 8 * fq;
        f32x4 bv[2][2];
#pragma unroll
        for (int bj = 0; bj < 2; ++bj)
#pragma unroll
            for (int n = 0; n < 2; ++n) bv[bj][n] = bias ? *(const f32x4*)(bias + col0 + bj * HALF + 4 * n) : (f32x4){0.f, 0.f, 0.f, 0.f};
#pragma unroll
        for (int ai = 0; ai < 2; ++ai)
#pragma unroll
            for (int m = 0; m < 4; ++m) {
                const int r = row0 + ai * HALF + m * 16; const size_t off = (size_t)r * D + col0;
                float ss = 0.f;
#pragma unroll
                for (int bj = 0; bj < 2; ++bj) {
                    const u32x4 xo = *(const u32x4*)(xb + off + bj * HALF);
                    f32x4 x0 = (f32x4){bf_lo(xo.x), bf_hi(xo.x), bf_lo(xo.y), bf_hi(xo.y)}, x1 = (f32x4){bf_lo(xo.z), bf_hi(xo.z), bf_lo(xo.w), bf_hi(xo.w)};
                    x0 += acc[ai][bj][m][0] + bv[bj][0]; x1 += acc[ai][bj][m][1] + bv[bj][1];
                    u32x4 w; w.x = cvt_pk_bf16(x0[0], x0[1]); w.y = cvt_pk_bf16(x0[2], x0[3]); w.z = cvt_pk_bf16(x1[0], x1[1]); w.w = cvt_pk_bf16(x1[2], x1[3]);
                    *(u32x4*)(xb + off + bj * HALF) = w;
                    x0 = (f32x4){bf_lo(w.x), bf_hi(w.x), bf_lo(w.y), bf_hi(w.y)}; x1 = (f32x4){bf_lo(w.z), bf_hi(w.z), bf_lo(w.w), bf_hi(w.w)};
                    ss += (x0[0] * x0[0] + x0[1] * x0[1]) + (x0[2] * x0[2] + x0[3] * x0[3]) + (x1[0] * x1[0] + x1[1] * x1[1]) + (x1[2] * x1[2] + x1[3] * x1[3]);
                }
                ss += shx(ss, lane, 16); ss += shx(ss, lane, 32);
                if (fq == 0) __hip_atomic_fetch_add(ssq_next + r, (u64)(ss * SSQ_SCALE), __ATOMIC_RELAXED, __HIP_MEMORY_SCOPE_AGENT);
            }
    }
};
struct EpiSoftmax {
    bf16_t* P; LAS f32x2* ex;
    __device__ __forceinline__ void operator()(f32x4 (&acc)[2][2][4][2], const Unit& u, int wid, int lane_) const {
        int lane; asm volatile("v_mbcnt_lo_u32_b32 %0, -1, 0\n\tv_mbcnt_hi_u32_b32 %0, -1, %0" : "=v"(lane));
        (void)lane_;
        const int wr = wid >> 2, wc = wid & 3, fr = lane & 15, fq = lane >> 4;
        const int row0 = u.pm * BM + wr * 64 + fr, col0 = u.pn * BM + wc * 32 + 8 * fq;
        float mxs[2][4];
#pragma unroll
        for (int ai = 0; ai < 2; ++ai)
#pragma unroll
            for (int m = 0; m < 4; ++m) {
                float mx = -3.0e38f;
#pragma unroll
                for (int bj = 0; bj < 2; ++bj)
#pragma unroll
                    for (int n = 0; n < 2; ++n) { const f32x4 v = acc[ai][bj][m][n]; mx = fmaxf(mx, fmaxf(fmaxf(v[0], v[1]), fmaxf(v[2], v[3]))); }
                mx = fmaxf(mx, shx(mx, lane, 16)); mx = fmaxf(mx, shx(mx, lane, 32));
                float l = 0.f;
#pragma unroll
                for (int bj = 0; bj < 2; ++bj)
#pragma unroll
                    for (int n = 0; n < 2; ++n) { f32x4 v = acc[ai][bj][m][n];
#pragma unroll
                        for (int j = 0; j < 4; ++j) { v[j] = __builtin_amdgcn_exp2f((v[j] - mx) * LOG2E); l += v[j]; }
                        acc[ai][bj][m][n] = v; }
                l += shx(l, lane, 16); l += shx(l, lane, 32);
                mxs[ai][m] = mx;
                if (fq == 0) ex[(ai * HALF + wr * 64 + m * 16 + fr) * 4 + wc] = (f32x2){mx, l};
            }
        asm volatile("s_waitcnt lgkmcnt(0)" ::: "memory"); __builtin_amdgcn_s_barrier(); asm volatile("" ::: "memory");
#pragma unroll
        for (int ai = 0; ai < 2; ++ai)
#pragma unroll
            for (int m = 0; m < 4; ++m) {
                const int lr = ai * HALF + wr * 64 + m * 16 + fr;
                const f32x2 a = ex[lr * 4 + 0], b = ex[lr * 4 + 1], c = ex[lr * 4 + 2], d = ex[lr * 4 + 3];
                const float MX = fmaxf(fmaxf(a.x, b.x), fmaxf(c.x, d.x));
                const float L = a.y * __builtin_amdgcn_exp2f((a.x - MX) * LOG2E) + b.y * __builtin_amdgcn_exp2f((b.x - MX) * LOG2E)
                              + c.y * __builtin_amdgcn_exp2f((c.x - MX) * LOG2E) + d.y * __builtin_amdgcn_exp2f((d.x - MX) * LOG2E);
                const float f = __builtin_amdgcn_exp2f((mxs[ai][m] - MX) * LOG2E) / L;
                bf16_t* rowp = P + (size_t)(row0 + ai * HALF + m * 16) * D + col0;
#pragma unroll
                for (int bj = 0; bj < 2; ++bj) {
                    const f32x4 v0 = acc[ai][bj][m][0] * f, v1 = acc[ai][bj][m][1] * f;
                    u32x4 w; w.x = cvt_pk_bf16(v0[0], v0[1]); w.y = cvt_pk_bf16(v0[2], v0[3]); w.z = cvt_pk_bf16(v1[0], v1[1]); w.w = cvt_pk_bf16(v1[2], v1[3]);
                    *(u32x4*)(rowp + bj * HALF) = w;
                }
            }
        asm volatile("s_waitcnt lgkmcnt(0)" ::: "memory"); __builtin_amdgcn_s_barrier(); asm volatile("" ::: "memory");
    }
};

template <int LDSIMM, int GOFF>
__device__ __forceinline__ void glds_s(const char* sbase, unsigned voff, unsigned ldsbase) {
    asm volatile("s_add_u32 m0, %2, %3\n\ts_nop 0\n\tglobal_load_lds_dwordx4 %0, %1 offset:%4" :: "v"(voff), "s"(sbase), "s"(ldsbase), "i"(LDSIMM), "i"(GOFF) : "memory", "m0", "scc");
}
template <class Epi, bool ALIGN_EPI>
__device__ __forceinline__ void gemm_phase(LAS unsigned char* lds, const Gemm g, const Order& S, const Epi& E, const int wid) {
    int lane; asm volatile("v_mbcnt_lo_u32_b32 %0, -1, 0\n\tv_mbcnt_hi_u32_b32 %0, -1, %0" : "=v"(lane));
    const int tid = wid * 64 + lane, wr = wid >> 2, wc = wid & 3, fr = lane & 15, fq = lane >> 4;
    const int nt = g.K / BK;
    unsigned voffA[2], voffB[2];
#pragma unroll
    for (int i = 0; i < 2; ++i) { int R, C; stage_rc(tid * 16 + i * 8192, R, C); const int Rb = (R & ~31) + perm32(R & 31);
        voffA[i] = (unsigned)(R * g.lda + C) * 2u; voffB[i] = (unsigned)(Rb * g.ldb + C) * 2u; }
    const size_t kstep = (size_t)(BK * 2);
    const size_t hstepA = (size_t)HALF * g.lda * 2, hstepB = (size_t)HALF * g.ldb * 2;
    const unsigned ldsbase = (unsigned)(size_t)lds + (unsigned)wid * 1024u;
    const int aoff = lds_byte(wr * 64 + fr, fq * 8), boff = lds_byte(wc * 32 + fr, fq * 8);
#define PG8_SA(b, h) (((b) * 2 + (h)) * HTB)
#define PG8_SB(b, h) ((4 + (b) * 2 + (h)) * HTB)
#define PG8_STAGE(bufoff, gbase, voff) do { glds_s<(bufoff), 0>((const char*)(gbase), (voff)[0], ldsbase); glds_s<(bufoff) + 8192, 0>((const char*)(gbase), (voff)[1], ldsbase); } while (0)
#define PG8_LDA(dst, b, h) do { _Pragma("unroll") for (int m = 0; m < 4; ++m) _Pragma("unroll") for (int k = 0; k < 2; ++k) dst[m][k] = *(const LAS bf16x8*)(lds + PG8_SA(b, h) + aoff + m * 2048 + k * 1024); } while (0)
#define PG8_LDB(dst, b, h) do { _Pragma("unroll") for (int n = 0; n < 2; ++n) _Pragma("unroll") for (int k = 0; k < 2; ++k) dst[n][k] = *(const LAS bf16x8*)(lds + PG8_SB(b, h) + boff + n * 2048 + k * 1024); } while (0)
#define PG8_MMA(ai, bj, At, Bt) do { __builtin_amdgcn_s_setprio(1); _Pragma("unroll") for (int m = 0; m < 4; ++m) _Pragma("unroll") for (int n = 0; n < 2; ++n) _Pragma("unroll") for (int k = 0; k < 2; ++k) \
        acc[ai][bj][m][n] = __builtin_amdgcn_mfma_f32_16x16x32_bf16(Bt[n][k], At[m][k], acc[ai][bj][m][n], 0, 0, 0); __builtin_amdgcn_s_setprio(0); } while (0)
#define PG8_WAIT_V(n) asm volatile("s_waitcnt vmcnt(" #n ")" ::: "memory")
#define PG8_WAIT_L(n) asm volatile("s_waitcnt lgkmcnt(" #n ")" ::: "memory")
#define PG8_BAR __builtin_amdgcn_s_barrier()
#define PG8_SCHED __builtin_amdgcn_sched_barrier(0)
#define PG8_ABASE(u) ((const char*)(g.A + (size_t)(u).pm * g.a_pm + (size_t)(u).pn * g.a_pn))
#define PG8_BBASE(u) ((const char*)(g.Bt + (size_t)(u).pn * g.b_pn + (size_t)((u).pm >> 3) * g.b_b))
    Unit cur, nxt; int ui = 0;
    if (!S.next(0, cur)) return;
    f32x4 acc[2][2][4][2];
#pragma unroll
    for (int a = 0; a < 2; ++a)
#pragma unroll
        for (int b = 0; b < 2; ++b)
#pragma unroll
            for (int m = 0; m < 4; ++m)
#pragma unroll
                for (int n = 0; n < 2; ++n) acc[a][b][m][n] = (f32x4){0.f, 0.f, 0.f, 0.f};
    bf16x8 At[4][2], B0[2][2], B1[2][2];
    const char* cA = PG8_ABASE(cur); const char* cB = PG8_BBASE(cur);
    PG8_STAGE(PG8_SB(0, 0), cB, voffB); PG8_STAGE(PG8_SB(0, 1), cB + hstepB, voffB); PG8_STAGE(PG8_SA(0, 0), cA, voffA); PG8_STAGE(PG8_SA(0, 1), cA + hstepA, voffA);
    if (wr == 1) PG8_BAR;
    PG8_WAIT_V(2); PG8_BAR;
    PG8_STAGE(PG8_SB(1, 0), cB + kstep, voffB); PG8_STAGE(PG8_SA(1, 0), cA + kstep, voffA); PG8_STAGE(PG8_SB(1, 1), cB + hstepB + kstep, voffB);
    PG8_WAIT_V(6); PG8_BAR;
    for (;;) {
        const bool has_next = S.next(ui + 1, nxt);
        const char* nA = has_next ? PG8_ABASE(nxt) : cA; const char* nB = has_next ? PG8_BBASE(nxt) : cB;
        for (int t = 0; t < nt; t += 2) {
            const bool last = (t == nt - 2);
            const char* a1 = cA + (size_t)(t + 1) * kstep;
            const char* a2 = last ? nA : cA + (size_t)(t + 2) * kstep; const char* b2 = last ? nB : cB + (size_t)(t + 2) * kstep;
            const char* a3 = a2 + kstep; const char* b3 = b2 + kstep;
            PG8_LDB(B0, 0, 0); PG8_LDB(B1, 0, 1); PG8_SCHED; PG8_LDA(At, 0, 0); PG8_STAGE(PG8_SA(1, 1), a1 + hstepA, voffA);
            PG8_WAIT_V(8); PG8_WAIT_L(0); PG8_BAR; PG8_MMA(0, 0, At, B0); PG8_MMA(0, 1, At, B1); PG8_BAR; PG8_SCHED;
            PG8_LDA(At, 0, 1); PG8_STAGE(PG8_SB(0, 0), b2, voffB); PG8_STAGE(PG8_SB(0, 1), b2 + hstepB, voffB); PG8_STAGE(PG8_SA(0, 0), a2, voffA);
            PG8_WAIT_V(8); PG8_WAIT_L(0); PG8_BAR; PG8_MMA(1, 0, At, B0); PG8_MMA(1, 1, At, B1); PG8_BAR; PG8_SCHED;
            PG8_LDB(B0, 1, 0); PG8_LDB(B1, 1, 1); PG8_SCHED; PG8_LDA(At, 1, 0); PG8_STAGE(PG8_SA(0, 1), a2 + hstepA, voffA);
            PG8_WAIT_V(8); PG8_WAIT_L(0); PG8_BAR; PG8_MMA(0, 0, At, B0); PG8_MMA(0, 1, At, B1); PG8_BAR; PG8_SCHED;
            PG8_LDA(At, 1, 1); PG8_STAGE(PG8_SB(1, 0), b3, voffB); PG8_STAGE(PG8_SB(1, 1), b3 + hstepB, voffB); PG8_STAGE(PG8_SA(1, 0), a3, voffA);
            PG8_WAIT_V(8); PG8_WAIT_L(0); PG8_BAR; PG8_MMA(1, 0, At, B0); PG8_MMA(1, 1, At, B1); PG8_BAR; PG8_SCHED;
        }
        if constexpr (ALIGN_EPI) { if (wr == 0) PG8_BAR; }
        E(acc, cur, wid, lane);
        if (!has_next) break;
#pragma unroll
        for (int a = 0; a < 2; ++a)
#pragma unroll
            for (int b = 0; b < 2; ++b)
#pragma unroll
                for (int m = 0; m < 4; ++m)
#pragma unroll
                    for (int n = 0; n < 2; ++n) acc[a][b][m][n] = (f32x4){0.f, 0.f, 0.f, 0.f};
        cur = nxt; cA = nA; cB = nB; ++ui;
        if constexpr (ALIGN_EPI) { if (wr == 1) PG8_BAR; }
    }
    PG8_WAIT_V(0);
    if constexpr (!ALIGN_EPI) { if (wr == 0) PG8_BAR; }
    PG8_BAR;
#undef PG8_SA
#undef PG8_SB
#undef PG8_STAGE
#undef PG8_LDA
#undef PG8_LDB
#undef PG8_MMA
#undef PG8_WAIT_V
#undef PG8_WAIT_L
#undef PG8_BAR
#undef PG8_SCHED
#undef PG8_ABASE
#undef PG8_BBASE
}
}

struct TrItem { const float* W; int ldw, src_n0, k0; bf16_t* WT; int ldt, dst_n0; const float* rs; const float* cs; };
__device__ __forceinline__ void tr_load(const TrItem& d, float (&v)[32], int lane) {
    const float* wp = d.W + (size_t)(d.k0 + (lane >> 5)) * d.ldw + d.src_n0 + (lane & 31);
#pragma unroll
    for (int i = 0; i < 32; ++i) v[i] = wp[(size_t)(2 * i) * d.ldw];
}
__device__ __forceinline__ void tr_finish(const TrItem& d, const float (&v)[32], LAS float* scr, int lane) {
    const float csv = d.cs ? d.cs[d.src_n0 + (lane & 31)] : 1.0f;
#pragma unroll
    for (int i = 0; i < 32; ++i) { const int kk = 2 * i + (lane >> 5); float t = v[i]; if (d.rs) t *= d.rs[d.k0 + kk]; scr[kk * 33 + (lane & 31)] = t * csv; }
    asm volatile("s_waitcnt lgkmcnt(0)" ::: "memory");
    const int c = lane & 7;
#pragma unroll
    for (int j = 0; j < 4; ++j) { const int n = (lane >> 3) + 8 * j; const LAS float* s = scr + (8 * c) * 33 + n;
        u32x4 o; o.x = cvt_pk_bf16(s[0 * 33], s[1 * 33]); o.y = cvt_pk_bf16(s[2 * 33], s[3 * 33]); o.z = cvt_pk_bf16(s[4 * 33], s[5 * 33]); o.w = cvt_pk_bf16(s[6 * 33], s[7 * 33]);
        *(u32x4*)(d.WT + (size_t)(d.dst_n0 + n) * d.ldt + d.k0 + 8 * c) = o; }
    asm volatile("s_waitcnt lgkmcnt(0)" ::: "memory");
}
__device__ __forceinline__ bool conv_mat(int& r, const float* W, int K, int N, bf16_t* WT, const float* rs, const float* cs, bool glu, TrItem& d) {
    const int nblk = N / 32, items = (K / 64) * nblk;
    if (r >= items) { r -= items; return false; }
    const int kb = r / nblk, nb = r % nblk, n0 = nb * 32;
    d.W = W; d.ldw = N; d.src_n0 = glu ? ((n0 >> 8) * 128 + (n0 & 127) + ((n0 >> 7) & 1) * D) : n0; d.k0 = kb * 64; d.WT = WT; d.ldt = K; d.dst_n0 = n0; d.rs = rs; d.cs = cs;
    return true;
}

struct Args { const float* in[23]; float* out; unsigned char* ws; int lo, hi; };
typedef LAS const unsigned long long* PtrTab;
__device__ __forceinline__ const float* inptr(PtrTab tab, int k) {
    const unsigned long long v = tab[k];
    typedef const float __attribute__((address_space(1)))* GPF;
    return (const float*)(GPF)(((unsigned long long)(unsigned)__builtin_amdgcn_readfirstlane((int)(v >> 32)) << 32) | (unsigned long long)(unsigned)__builtin_amdgcn_readfirstlane((int)v));
}
#define INP(k) inptr(tab, (k))

__device__ __forceinline__ void decode_item(PtrTab tab, unsigned char* ws_, int i, int it, TrItem& d) {
    int r = it;
    if (i < 0) { constexpr int I1 = (D / 64) * (D / 32); const int mtx = it / I1, l = mtx & 3; r = it % I1;
        conv_mat(r, (mtx < 4 ? INP(17) : INP(18)) + (size_t)l * D * D, D, D, (bf16_t*)(ws_ + (mtx < 4 ? WS_WKT : WS_WVT)) + (size_t)l * D * D, nullptr, nullptr, false, d); return; }
    unsigned char* lw = ws_ + WS_LW + (size_t)(i & 1) * LW_SET; const int j = i >> 1;
    if (!(i & 1)) {
        if (conv_mat(r, INP(6) + (size_t)j * D * 2 * D, D, 2 * D, (bf16_t*)(lw + LW_WIN), INP(3) + i * D, nullptr, true, d)) return;
        if (conv_mat(r, INP(12) + (size_t)j * D * D, D, D, (bf16_t*)(lw + LW_WOUT), nullptr, nullptr, false, d)) return;
    } else {
        const int g = r >> 5;
        if (g < 4) { r &= 31; conv_mat(r, INP(14) + ((size_t)j * 4 + g) * 65536, 256, 256, (bf16_t*)(lw + LW_WIN) + (size_t)g * 65536, nullptr, INP(15) + j * D + g * 256, false, d); return; }
        r -= 128;
    }
    if (conv_mat(r, INP(16) + (size_t)i * D * D, D, D, (bf16_t*)(lw + LW_WQ), INP(4) + i * D, nullptr, false, d)) return;
    if (conv_mat(r, INP(19) + (size_t)i * D * D, D, D, (bf16_t*)(lw + LW_WO), nullptr, nullptr, false, d)) return;
    if (conv_mat(r, INP(20) + (size_t)i * D * FF, D, FF, (bf16_t*)(lw + LW_W1), INP(5) + i * D, nullptr, false, d)) return;
    conv_mat(r, INP(21) + (size_t)i * FF * D, FF, D, (bf16_t*)(lw + LW_W2), nullptr, nullptr, false, d);
}
__device__ __forceinline__ void convert_job(PtrTab tab, unsigned char* ws_, int i, LAS float* scr, int gw, int NGW, int lane) {
    const int I_MIX = !(i & 1) ? (D / 64) * (2 * D / 32) + (D / 64) * (D / 32) : 4 * (256 / 64) * (256 / 32);
    const int NITEMS = (i < 0) ? 8 * (D / 64) * (D / 32) : I_MIX + 2 * (D / 64) * (D / 32) + 2 * (D / 64) * (FF / 32);
    int it = gw; if (it >= NITEMS) return;
    TrItem d0; float v0[32];
    decode_item(tab, ws_, i, it, d0); tr_load(d0, v0, lane);
    for (;;) {
        const int it2 = it + NGW; const bool has = it2 < NITEMS;
        TrItem d1; float v1[32];
        if (has) { decode_item(tab, ws_, i, it2, d1); tr_load(d1, v1, lane); }
        tr_finish(d0, v0, scr, lane);
        if (!has) break;
        d0 = d1; it = it2;
#pragma unroll
        for (int q = 0; q < 32; ++q) v0[q] = v1[q];
    }
}

__device__ __forceinline__ void dw_phase(const bf16_t* GLU, bf16_t* V, const float* wdw, const float* bdw, const float* lng, const float* lnb, LAS float* red, int bid, int G, int wave) {
    int laneA; asm volatile("v_mbcnt_lo_u32_b32 %0, -1, 0\n\tv_mbcnt_hi_u32_b32 %0, -1, %0" : "=v"(laneA));
    const int tid = wave * 64 + laneA;
    f32x2 wk[CW];
#pragma unroll
    for (int k = 0; k < CW; ++k) wk[k] = *(const f32x2*)(wdw + k * D + 2 * tid);
    const f32x2 bd = *(const f32x2*)(bdw + 2 * tid), lg = *(const f32x2*)(lng + 2 * tid), lb = *(const f32x2*)(lnb + 2 * tid);
    const unsigned* G32 = (const unsigned*)GLU; unsigned* V32 = (unsigned*)V;
    LAS f32x2* part = (LAS f32x2*)red;
    LAS f32x2* stat = (LAS f32x2*)(red + 256);
    const int ustart = (G == 256) ? (bid & 7) * 128 + (bid >> 3) * 4 : bid, ustep = (G == 256) ? 1 : G, uend = (G == 256) ? ustart + 4 : M / 16;
    unsigned raw[46];
    if (ustart < uend) { const int t0 = (ustart & 127) * 16; int vb = (ustart * 16 - 30) * 512 + tid; asm volatile("" : "+v"(vb));
#pragma unroll
        for (int r = 0; r < 46; ++r) raw[r] = (t0 - 30 + r >= 0) ? G32[vb + r * 512] : 0u; }
    for (int unit = ustart; unit < uend; unit += ustep) {
        const int t0 = (unit & 127) * 16, rowbase = unit * 16;
        f32x2 win[46];
#pragma unroll
        for (int r = 0; r < 46; ++r) win[r] = (f32x2){bf_lo(raw[r]), bf_hi(raw[r])};
        f32x2 o[16];
#pragma unroll
        for (int t = 0; t < 16; ++t) { f32x2 a = bd;
#pragma unroll
            for (int k = 0; k < CW; ++k) a = __builtin_elementwise_fma(wk[k], win[t + k], a);
            o[t] = a; }
        if (unit + ustep < uend) { const int nu = unit + ustep, nt0 = (nu & 127) * 16; int vb = (nu * 16 - 30) * 512 + tid; asm volatile("" : "+v"(vb));
#pragma unroll
            for (int r = 0; r < 46; ++r) raw[r] = (nt0 - 30 + r >= 0) ? G32[vb + r * 512] : 0u; }
        int lane; asm volatile("v_mbcnt_lo_u32_b32 %0, -1, 0\n\tv_mbcnt_hi_u32_b32 %0, -1, %0" : "=v"(lane)); const int tidB = wave * 64 + lane;
#pragma unroll
        for (int t = 0; t < 16; ++t) {
            const float s1 = wave_sum_dpp(o[t].x + o[t].y), s2 = wave_sum_dpp(o[t].x * o[t].x + o[t].y * o[t].y);
            if (lane == 0) part[wave * 16 + t] = (f32x2){s1, s2};
        }
        asm volatile("s_waitcnt lgkmcnt(0)" ::: "memory"); __builtin_amdgcn_s_barrier(); asm volatile("" ::: "memory");
        if (tidB < 16) { float s1 = 0.f, s2 = 0.f;
#pragma unroll
            for (int w = 0; w < 8; ++w) { const f32x2 p = part[w * 16 + tidB]; s1 += p.x; s2 += p.y; }
            const float mean = s1 * (1.0f / D), var = fmaxf(s2 * (1.0f / D) - mean * mean, 0.f);
            stat[tidB] = (f32x2){mean, rsqrtf(var + LN_EPS)}; }
        asm volatile("s_waitcnt lgkmcnt(0)" ::: "memory"); __builtin_amdgcn_s_barrier(); asm volatile("" ::: "memory");
#pragma unroll
        for (int t = 0; t < 16; ++t) {
            const f32x2 st = stat[t];
            float y0 = (o[t].x - st.x) * st.y * lg.x + lb.x, y1 = (o[t].y - st.x) * st.y * lg.y + lb.y;
            y0 = y0 * __builtin_amdgcn_rcpf(1.0f + __builtin_amdgcn_exp2f(-y0 * LOG2E)); y1 = y1 * __builtin_amdgcn_rcpf(1.0f + __builtin_amdgcn_exp2f(-y1 * LOG2E));
            V32[(size_t)(rowbase + t) * 512 + tidB] = cvt_pk_bf16(y0, y1);
        }
        asm volatile("s_waitcnt lgkmcnt(0)" ::: "memory"); __builtin_amdgcn_s_barrier(); asm volatile("" ::: "memory");
    }
}

__device__ __forceinline__ float bcast_lane(float v, int k) { return __int_as_float(__builtin_amdgcn_readlane(__float_as_int(v), k)); }
template <int W>
__device__ __forceinline__ void pl_span(const bf16_t* XBs, const u64* ssq, bf16_t* PP, int unit0, int nsub, int tid, int lane, f32x2 g) {
    const unsigned* X32 = (const unsigned*)XBs; unsigned* P32 = (unsigned*)PP;
    const int t0 = (unit0 & 127) * 16, rowbase = unit0 * 16;
    const bool first = (t0 == 0);
    int vb = rowbase * 512 + tid; asm volatile("" : "+v"(vb));
    unsigned xh[W - 1], xc[16];
#pragma unroll
    for (int j = 0; j < W - 1; ++j) xh[j] = X32[vb + (first ? 0 : (j - (W - 1))) * 512];
    const int l5 = lane & 31;
    u64 q = ssq[rowbase + (l5 < 16 ? l5 : (first ? 0 : l5 - 32))];
#pragma unroll
    for (int j = 0; j < 16; ++j) xc[j] = X32[vb + j * 512];
    float rsl = rstd_of(q);
    f32x2 hist[W - 1]; f32x2 S = (f32x2){0.f, 0.f};
#pragma unroll
    for (int j = 0; j < W - 1; ++j) { const float r0 = bcast_lane(rsl, 32 - (W - 1) + j), rs = first ? 0.f : r0; hist[j] = (f32x2){bf_lo(xh[j]) * rs, bf_hi(xh[j]) * rs}; S += hist[j]; }
    constexpr float INVW = 1.0f / (float)W;
    for (int c = 0; c < nsub; ++c) {
        const bool more = (c + 1 < nsub);
        f32x2 ext[W - 1 + 16];
#pragma unroll
        for (int j = 0; j < W - 1; ++j) ext[j] = hist[j];
#pragma unroll
        for (int j = 0; j < 16; ++j) { const float rs = bcast_lane(rsl, j); ext[W - 1 + j] = (f32x2){bf_lo(xc[j]) * rs, bf_hi(xc[j]) * rs}; }
        const bool head = first && c == 0;
#pragma unroll
        for (int j = 0; j < 16; ++j) {
            S += ext[W - 1 + j];
            const float inv = head ? (1.0f / (float)((j + 1 < W) ? j + 1 : W)) : INVW;
            const f32x2 p = (S * inv - ext[W - 1 + j]) * g;
            P32[vb + (16 * c + j) * 512] = cvt_pk_bf16(p.x, p.y);
            S -= ext[j];
        }
#pragma unroll
        for (int j = 0; j < W - 1; ++j) hist[j] = ext[16 + j];
        if (more) {
#pragma unroll
            for (int j = 0; j < 16; ++j) xc[j] = X32[vb + (16 * (c + 1) + j) * 512];
            rsl = rstd_of(ssq[rowbase + 16 * (c + 1) + (lane & 15)]);
        }
    }
}
__device__ __forceinline__ void pl_phase(const bf16_t* X, const u64* ssq, const float* gain, bf16_t* PP, int bid, int G, int wave) {
    int lane; asm volatile("v_mbcnt_lo_u32_b32 %0, -1, 0\n\tv_mbcnt_hi_u32_b32 %0, -1, %0" : "=v"(lane)); const int tid = wave * 64 + lane;
    const f32x2 g = *(const f32x2*)(gain + 2 * tid); const int grp = wave >> 1;
    const int ustart = (G == 256) ? (bid & 7) * 128 + (bid >> 3) * 4 : bid, ustep = (G == 256) ? 4 : G, uend = (G == 256) ? ustart + 4 : M / 16, nsub = (G == 256) ? 4 : 1;
    for (int unit = ustart; unit < uend; unit += ustep) {
        if (grp == 0) pl_span<2>(X, ssq, PP, unit, nsub, tid, lane, g);
        else if (grp == 1) pl_span<4>(X, ssq, PP, unit, nsub, tid, lane, g);
        else if (grp == 2) pl_span<8>(X, ssq, PP, unit, nsub, tid, lane, g);
        else pl_span<16>(X, ssq, PP, unit, nsub, tid, lane, g);
    }
}

#define XB_TMO      128
#define XB_XCNT(j)  (256  + 64 * (j))
#define XB_XSUB(j)  (1280 + 64 * (j))
#define XB_XGEN(j)  (2304 + 64 * (j))
#define XB_TOP      3328
#define XB_TOPGEN   3392
#define XB_LSUB(j)  (3456 + 64 * (j))
#define XB_LGEN(j)  (4480 + 64 * (j))
#define XB_GMASK(j) (5504 + (j))
#define XCD_BAR_WORDS 5632
#define XB_SPIN_CAP (1u << 18)
__device__ __forceinline__ unsigned xb_ld(unsigned* p)              { return __hip_atomic_load(p, __ATOMIC_RELAXED, __HIP_MEMORY_SCOPE_AGENT); }
__device__ __forceinline__ unsigned xb_add(unsigned* p, unsigned v) { return __hip_atomic_fetch_add(p, v, __ATOMIC_RELAXED, __HIP_MEMORY_SCOPE_AGENT); }
__device__ __forceinline__ unsigned xb_xcc_id() { return (unsigned)__builtin_amdgcn_s_getreg((3 << 11) | 20) & 0xFu; }
#define XB_SPIN(cond, bar) do { unsigned _sp = 0; while (cond) { __builtin_amdgcn_s_sleep(1); \
    if ((++_sp & 255u) == 0u) { if (xb_ld(&(bar)[XB_TMO])) break; if (_sp > XB_SPIN_CAP) { atomicAdd(&(bar)[XB_TMO], 1u); break; } } } } while (0)
struct XcdBarrier { unsigned* bar; unsigned x; volatile LAS unsigned* st; };
__device__ __forceinline__ void xcd_barrier_complete(unsigned* bar, unsigned x, unsigned& nloc, unsigned& nx) {
    const unsigned G = gridDim.x * gridDim.y * gridDim.z;
    unsigned sum, cnt, mine, sp = 0u;
    for (;;) {
        sum = 0u; cnt = 0u; mine = 0u;
#pragma unroll
        for (unsigned j = 0; j < 16; ++j) { const unsigned c = xb_ld(&bar[XB_XCNT(j)]); sum += c; cnt += (c > 0u) ? 1u : 0u; mine = (j == x) ? c : mine; }
        if (sum == G) break;
        __builtin_amdgcn_s_sleep(1);
        if ((++sp & 255u) == 0u) { if (xb_ld(&bar[XB_TMO])) break; if (sp > XB_SPIN_CAP) { atomicAdd(&bar[XB_TMO], 1u); break; } }
    }
    nloc = mine > 0u ? mine : 1u; nx = cnt > 0u ? cnt : 1u;
}
__device__ __forceinline__ void xcd_barrier(unsigned* bar_, volatile LAS unsigned* st_) {
    XcdBarrier b; b.bar = bar_; b.st = st_; b.x = xb_xcc_id();
    asm volatile("s_waitcnt vmcnt(0)" ::: "memory");
    __syncthreads();
    if (threadIdx.x == 0) {
        unsigned* bar = b.bar;
        __builtin_amdgcn_s_waitcnt(0);
        unsigned nloc = b.st[0], nx = b.st[1];
        if (nloc == 0u) { xcd_barrier_complete(bar, b.x, nloc, nx); b.st[0] = nloc; b.st[1] = nx; }
        const unsigned old = xb_add(&bar[XB_XSUB(b.x)], 1u);
        const unsigned gen = old / nloc;
        if (old + 1u == (gen + 1u) * nloc) {
            __builtin_amdgcn_fence(__ATOMIC_RELEASE, "agent");
            asm volatile("s_waitcnt vmcnt(0)" ::: "memory");
            const unsigned og = xb_add(&bar[XB_TOP], 1u);
            const unsigned tg = og / nx;
            if (og + 1u == (tg + 1u) * nx) xb_add(&bar[XB_TOPGEN], 1u);
            else XB_SPIN(xb_ld(&bar[XB_TOPGEN]) == tg, bar);
            __builtin_amdgcn_fence(__ATOMIC_ACQUIRE, "agent");
            xb_add(&bar[XB_XGEN(b.x)], 1u);
            asm volatile("s_waitcnt vmcnt(0)" ::: "memory");
        } else {
            XB_SPIN(xb_ld(&bar[XB_XGEN(b.x)]) == gen, bar);
            __builtin_amdgcn_fence(__ATOMIC_ACQUIRE, "agent");
            asm volatile("s_waitcnt vmcnt(0)" ::: "memory");
        }
    }
    __syncthreads();
}

__device__ __forceinline__ void xcd_local_barrier(unsigned* bar, unsigned grp, unsigned nloc) {
    asm volatile("s_waitcnt vmcnt(0)" ::: "memory");
    __syncthreads();
    if (threadIdx.x == 0) {
        __builtin_amdgcn_s_waitcnt(0);
        const unsigned old = xb_add(&bar[XB_LSUB(grp)], 1u);
        const unsigned gen = old / nloc;
        if (old + 1u == (gen + 1u) * nloc) xb_add(&bar[XB_LGEN(grp)], 1u);
        else XB_SPIN(xb_ld(&bar[XB_LGEN(grp)]) == gen, bar);
        __builtin_amdgcn_fence(__ATOMIC_ACQUIRE, "agent");
        asm volatile("s_waitcnt vmcnt(0)" ::: "memory");
    }
    __syncthreads();
}

enum { K_PRO = 0, K_KV, K_G1, K_DW, K_G2, K_PL, K_GP, K_GQ, K_S, K_PV, K_WO, K_UP, K_DOWN, K_FINAL };
constexpr int N_PHASES = 2 + 2 * 17 + 1;
__host__ __device__ __forceinline__ void decode_phase(int ph, int& kind, int& layer) {
    if (ph == 0) { kind = K_PRO; layer = 0; return; }
    if (ph == 1) { kind = K_KV; layer = 0; return; }
    if (ph == N_PHASES - 1) { kind = K_FINAL; layer = 0; return; }
    const int q = ph - 2, pair = q / 17, r = q % 17;
    if (r < 9) { layer = 2 * pair; kind = (r < 3) ? (K_G1 + r) : (K_GQ + (r - 3)); }
    else { layer = 2 * pair + 1; const int s = r - 9; kind = (s < 2) ? (K_PL + s) : (K_GQ + (s - 2)); }
}

__global__ void __launch_bounds__(512, 2) fwd_megakernel(Args args) {
    extern __shared__ __attribute__((aligned(16))) unsigned char lds_raw[];
    LAS unsigned char* lds = (LAS unsigned char*)lds_raw;
    const int G0 = gridDim.x, bid0 = blockIdx.x, bid = bid0;
    const int wave_s = __builtin_amdgcn_readfirstlane(threadIdx.x >> 6);
    unsigned char* ws = args.ws;
    u64* SSQ = (u64*)(ws + WS_SSQ);
    float* X = args.out;
    bf16_t* XB = (bf16_t*)(ws + WS_XB);
    bf16_t* KALL = (bf16_t*)(ws + WS_KALL); bf16_t* VT = (bf16_t*)(ws + WS_VT);
    bf16_t* S0 = (bf16_t*)(ws + WS_S0); bf16_t* S1 = (bf16_t*)(ws + WS_S1); bf16_t* S2 = (bf16_t*)(ws + WS_S2); bf16_t* HM = (bf16_t*)(ws + WS_H);
    LAS float* exf = (LAS float*)(lds + EX_OFF);
    if (threadIdx.x < 4) ((volatile LAS unsigned*)(lds + BARST_OFF))[threadIdx.x] = 0u;
    if (threadIdx.x == 0) {
#pragma unroll
        for (int k = 0; k < 23; ++k) ((LAS unsigned long long*)(lds + PTAB_OFF))[k] = (unsigned long long)args.in[k];
    }
    __syncthreads();
    PtrTab tab = (PtrTab)(lds + PTAB_OFF);
    if (threadIdx.x == 0) {
        unsigned* bar0 = (unsigned*)(args.ws + WS_BAR); const unsigned x = xb_xcc_id();
        (void)xb_add(bar0 + XB_XCNT(x), 1u); (void)__hip_atomic_fetch_or(bar0 + XB_GMASK(bid & 7), 1u << x, __ATOMIC_RELAXED, __HIP_MEMORY_SCOPE_AGENT);
    }
    if (args.lo < 0) cg::this_grid().sync();

#pragma unroll 1
    for (int ph = args.lo; ph < args.hi; ++ph) {
        int G = G0, bid = bid0, wave = wave_s; asm volatile("" : "+s"(G), "+s"(bid), "+s"(wave));
        const int gw = bid * 8 + wave, NGW = G * 8;
        LAS float* scr = (LAS float*)(lds + wave * 16384);
        int kind, i; decode_phase(ph, kind, i);
        if (ph >= LAST_PH && ph < N_PHASES - 1) kind = -1;
        const int j = i >> 1;
        unsigned char* lw = ws + WS_LW + (size_t)(i & 1) * LW_SET;
        switch (kind) {
        case K_PRO: {
            int lane; asm volatile("v_mbcnt_lo_u32_b32 %0, -1, 0\n\tv_mbcnt_hi_u32_b32 %0, -1, %0" : "=v"(lane)); const int tid = wave * 64 + lane; (void)tid;
            { unsigned z = 0u; asm volatile("" : "+v"(z));
              for (int u = bid * 512 + tid; u < 12 * M / 2; u += G * 512) ((u32x4*)(SSQ + M))[u] = (u32x4){z, z, z, z}; }
            convert_job(tab, ws, -1, scr, gw, NGW, lane);
            for (int m = gw; m < MEMR; m += NGW) {
                const f32x4* xr = (const f32x4*)(INP(1) + (size_t)m * D) + lane; f32x4 v[4]; float s = 0.f;
#pragma unroll
                for (int q = 0; q < 4; ++q) { v[q] = xr[64 * q]; s += (v[q].x * v[q].x + v[q].y * v[q].y) + (v[q].z * v[q].z + v[q].w * v[q].w); }
                const float rs = rsqrtf(wave_sum(s, lane) * (1.0f / D) + RMS_EPS);
                u32x2* o8 = (u32x2*)((bf16_t*)(ws + WS_MEMN) + (size_t)m * D) + lane;
#pragma unroll
                for (int q = 0; q < 4; ++q) { const f32x4 gq = ((const f32x4*)INP(2))[lane + 64 * q]; u32x2 w; w.x = cvt_pk_bf16(v[q].x * rs * gq.x, v[q].y * rs * gq.y); w.y = cvt_pk_bf16(v[q].z * rs * gq.z, v[q].w * rs * gq.w); o8[64 * q] = w; }
            }
            const int m0 = (G == 256) ? (bid & 7) * SEQ + (bid >> 3) * 8 + wave : gw, mstep = (G == 256) ? 256 : NGW, mend = (G == 256) ? ((bid & 7) + 1) * SEQ : M;
            for (int m = m0; m < mend; m += mstep) {
                const f32x4* xr = (const f32x4*)(INP(0) + (size_t)m * D) + lane; f32x4 v[4]; float s = 0.f;
                u32x2* o8 = (u32x2*)(XB + (size_t)m * D) + lane;
#pragma unroll
                for (int q = 0; q < 4; ++q) { v[q] = xr[64 * q]; u32x2 w; w.x = cvt_pk_bf16(v[q].x, v[q].y); w.y = cvt_pk_bf16(v[q].z, v[q].w); o8[64 * q] = w;
                    const float a = bf_lo(w.x), b = bf_hi(w.x), c = bf_lo(w.y), d = bf_hi(w.y); s += (a * a + b * b) + (c * c + d * d); }
                s = wave_sum(s, lane);
                if (lane == 0) SSQ[m] = (u64)(s * SSQ_SCALE);
            }
            convert_job(tab, ws, 0, scr, gw, NGW, lane);
        } break;
        case K_KV: {
            {
                pg8::Gemm g{(const bf16_t*)(ws + WS_MEMN), (const bf16_t*)(ws + WS_WKT), D, D, D, 256L * D, 0, 256L * D, 0};
                pg8::Order S; S.init(MEMR / 256, 4 * D / 256, G, bid);
                pg8::EpiBf E{KALL, 4 * D, nullptr, 1.0f, 0};
                pg8::gemm_phase<pg8::EpiBf, true>(lds, g, S, E, wave);
            }
            {
                pg8::Gemm g{(const bf16_t*)(ws + WS_WVT), (const bf16_t*)(ws + WS_MEMN), D, D, D, 256L * D, 0, 256L * D, 0};
                pg8::Order S; S.init(4 * D / 256, MEMR / 256, G, (bid + G / 2) % G);
                pg8::EpiBf E{VT, MEMR, nullptr, 1.0f, 0};
                pg8::gemm_phase<pg8::EpiBf, true>(lds, g, S, E, wave);
            }
        } break;
        case K_G1: {
            pg8::Gemm g{XB, (const bf16_t*)(lw + LW_WIN), D, D, D, 256L * D, 0, 256L * D, 0};
            pg8::Order S; S.init(M / 256, 2 * D / 256, G, bid);
            pg8::EpiGlu E{S0, INP(7) + j * 2 * D, SSQ + (size_t)(3 * i) * M};
            pg8::gemm_phase<pg8::EpiGlu, true>(lds, g, S, E, wave);
        } break;
        case K_DW: {
            dw_phase(S0, S1, INP(8) + (size_t)j * CW * D, INP(9) + j * D, INP(10) + j * D, INP(11) + j * D, exf, bid, G, wave);
        } break;
        case K_PL: {
            pl_phase(XB, SSQ + (size_t)(3 * i) * M, INP(3) + i * D, S0, bid, G, wave);
        } break;
        case K_G2: case K_GP: case K_WO: case K_DOWN: {
            pg8::Gemm g; pg8::EpiRes E; E.xb = XB; E.bias = nullptr;
            if (kind == K_G2) { g = pg8::Gemm{S1, (const bf16_t*)(lw + LW_WOUT), D, D, D, 256L * D, 0, 256L * D, 0}; E.bias = INP(13) + j * D; E.ssq_next = SSQ + (size_t)(3 * i + 1) * M; }
            else if (kind == K_GP) { g = pg8::Gemm{S0, (const bf16_t*)(lw + LW_WIN), D, 256, 256, 256L * D, 256, 65536, 0}; E.ssq_next = SSQ + (size_t)(3 * i + 1) * M; }
            else if (kind == K_WO) { g = pg8::Gemm{S2, (const bf16_t*)(lw + LW_WO), D, D, D, 256L * D, 0, 256L * D, 0}; E.ssq_next = SSQ + (size_t)(3 * i + 2) * M; }
            else { g = pg8::Gemm{HM, (const bf16_t*)(lw + LW_W2), FF, FF, FF, 256L * FF, 0, 256L * FF, 0}; E.ssq_next = SSQ + (size_t)(3 * i + 3) * M; }
            pg8::Order S; S.init(M / 256, D / 256, G, bid);
            pg8::gemm_phase<pg8::EpiRes, true>(lds, g, S, E, wave);
        } break;
        case K_GQ: case K_UP: case K_PV: {
            pg8::Gemm g; pg8::EpiBf E; int nN = D / 256;
            if (kind == K_GQ) { g = pg8::Gemm{XB, (const bf16_t*)(lw + LW_WQ), D, D, D, 256L * D, 0, 256L * D, 0}; E = pg8::EpiBf{S0, D, SSQ + (size_t)(3 * i + 1) * M, 0.0625f, 0}; }
            else if (kind == K_UP) { g = pg8::Gemm{XB, (const bf16_t*)(lw + LW_W1), D, D, D, 256L * D, 0, 256L * D, 0}; E = pg8::EpiBf{HM, FF, SSQ + (size_t)(3 * i + 2) * M, 1.0f, 1}; nN = FF / 256; }
            else { g = pg8::Gemm{S1, VT + (size_t)i * D * MEMR, D, MEMR, 256, 256L * D, 256, 256L * MEMR, 256}; E = pg8::EpiBf{S2, D, nullptr, 1.0f, 0}; }
            pg8::Order S; S.init(M / 256, nN, G, bid);
            pg8::gemm_phase<pg8::EpiBf, true>(lds, g, S, E, wave);
            if (kind == K_PV && i + 1 < 4) { int lane2; asm volatile("v_mbcnt_lo_u32_b32 %0, -1, 0\n\tv_mbcnt_hi_u32_b32 %0, -1, %0" : "=v"(lane2));
                convert_job(tab, ws, i + 1, scr, gw, NGW, lane2); }
        } break;
        case K_S: {
            pg8::Gemm g{S0, KALL + (size_t)i * D, D, 4 * D, 256, 256L * D, 256, 256, 256L * 4 * D};
            pg8::Order S; S.init(M / 256, D / 256, G, bid);
            pg8::EpiSoftmax E{S1, (LAS f32x2*)exf};
            pg8::gemm_phase<pg8::EpiSoftmax, true>(lds, g, S, E, wave);
        } break;
        case K_FINAL: {
            int lane; asm volatile("v_mbcnt_lo_u32_b32 %0, -1, 0\n\tv_mbcnt_hi_u32_b32 %0, -1, %0" : "=v"(lane)); const int tid = wave * 64 + lane; (void)tid;
            const int m0 = (G == 256) ? (bid & 7) * SEQ + (bid >> 3) * 8 + wave : gw, mstep = (G == 256) ? 256 : NGW, mend = (G == 256) ? ((bid & 7) + 1) * SEQ : M;
            for (int m = m0; m < mend; m += mstep) {
                f32x4* xr = (f32x4*)(X + (size_t)m * D) + lane; const u32x2* xi = (const u32x2*)(XB + (size_t)m * D) + lane; f32x4 v[4]; float s = 0.f;
#pragma unroll
                for (int q = 0; q < 4; ++q) { const u32x2 w = xi[64 * q]; v[q] = (f32x4){bf_lo(w.x), bf_hi(w.x), bf_lo(w.y), bf_hi(w.y)}; s += (v[q].x * v[q].x + v[q].y * v[q].y) + (v[q].z * v[q].z + v[q].w * v[q].w); }
                const float rs = rsqrtf(wave_sum(s, lane) * (1.0f / D) + RMS_EPS);
#pragma unroll
                for (int q = 0; q < 4; ++q) { const f32x4 gq = ((const f32x4*)INP(22))[lane + 64 * q]; f32x4 o = v[q] * rs; o.x *= gq.x; o.y *= gq.y; o.z *= gq.z; o.w *= gq.w; xr[64 * q] = o; }
            }
        } break;
        }
        if (ph + 1 < args.hi) {
            unsigned* bar = (unsigned*)(args.ws + WS_BAR); volatile LAS unsigned* st = (volatile LAS unsigned*)(lds + BARST_OFF);
            if (kind == K_GQ || kind == K_S) {
                asm volatile("s_waitcnt vmcnt(0)" ::: "memory"); __syncthreads();
                if (threadIdx.x == 0) { __builtin_amdgcn_fence(__ATOMIC_ACQUIRE, "agent"); asm volatile("s_waitcnt vmcnt(0)" ::: "memory"); }
                __syncthreads();
            } else if (ph <= 1 || (kind == K_DOWN && i < 3) || st[2] != 1u) {
                xcd_barrier(bar, st);
                if (ph == 1) {
                    if (threadIdx.x == 0) { bool pure = (G == 256 && st[0] == 32u && st[1] == 8u);
#pragma unroll
                        for (int g8 = 0; g8 < 8; ++g8) pure = pure && (__builtin_popcount(xb_ld(bar + XB_GMASK(g8))) == 1);
                        st[2] = (pure && !FORCE_FALLBACK) ? 1u : 2u; }
                    __syncthreads();
                }
            } else xcd_local_barrier(bar, (unsigned)(bid & 7), 32u);
        }
    }
}

extern "C" void kernel_launch(void* const* d_in, const int* in_sizes, int n_in, void* d_out, int out_size, void* d_ws, size_t ws_size, hipStream_t stream) {
    static int grid = 0;
    if (grid == 0) {
        if (n_in != 23 || out_size != M * D || ws_size < WS_END) { fprintf(stderr, "kernel_launch: unexpected problem (n_in %d out %d ws %zu)\n", n_in, out_size, ws_size); grid = -1; return; }
        int dev = 0, cus = 0, per_cu = 0;
        hipGetDevice(&dev); hipDeviceGetAttribute(&cus, hipDeviceAttributeMultiprocessorCount, dev);
        hipFuncSetAttribute((const void*)fwd_megakernel, hipFuncAttributeMaxDynamicSharedMemorySize, LDS_BYTES);
        if (hipOccupancyMaxActiveBlocksPerMultiprocessor(&per_cu, (const void*)fwd_megakernel, 512, LDS_BYTES) != hipSuccess || per_cu < 1) { fprintf(stderr, "kernel_launch: occupancy query gave %d\n", per_cu); per_cu = 1; }
        (void)hipGetLastError();
        grid = cus * per_cu;
    }
    if (grid < 0) return;
    (void)hipMemsetAsync((unsigned char*)d_ws + WS_BAR, 0, XCD_BAR_WORDS * 4, stream);
    Args a{};
    for (int i = 0; i < 23; ++i) a.in[i] = (const float*)d_in[i];
    a.out = (float*)d_out; a.ws = (unsigned char*)d_ws;
#if MK_PER_PHASE
    for (int ph = 0; ph < N_PHASES; ++ph) { a.lo = ph; a.hi = ph + 1; hipLaunchKernelGGL(fwd_megakernel, dim3(grid), dim3(512), LDS_BYTES, stream, a); }
#else
    a.lo = 0; a.hi = N_PHASES;
    void* kargs[] = {&a};
    hipError_t e = hipLaunchCooperativeKernel((const void*)fwd_megakernel, dim3(grid), dim3(512), kargs, LDS_BYTES, stream);
    if (e != hipSuccess) fprintf(stderr, "cooperative launch failed: %s (grid %d)\n", hipGetErrorString(e), grid);
#endif
}
```

```cpp
#include <hip/hip_runtime.h>
#include <hip/hip_cooperative_groups.h>
#include <cstdio>
#include <cstdint>
namespace cg = cooperative_groups;

#ifndef MK_PER_PHASE
#define MK_PER_PHASE 0
#endif

#ifndef LAST_PH
#define LAST_PH 99
#endif
#ifndef FORCE_FALLBACK
#define FORCE_FALLBACK 0
#endif
#define LAS __attribute__((address_space(3)))
typedef unsigned short bf16_t;
typedef short bf16x8 __attribute__((ext_vector_type(8)));
typedef float f32x4 __attribute__((ext_vector_type(4)));
typedef float f32x2 __attribute__((ext_vector_type(2)));
typedef unsigned u32x4 __attribute__((ext_vector_type(4)));
typedef unsigned u32x2 __attribute__((ext_vector_type(2)));

constexpr int D = 1024, NB = 8, SEQ = 2048, M = NB * SEQ, FF = 4096, MEML = 256, MEMR = NB * MEML, CW = 31;
constexpr float RMS_EPS = 1e-6f, LN_EPS = 1e-5f;
constexpr float LOG2E = 1.4426950408889634f;
typedef unsigned long long u64;
constexpr float SSQ_SCALE = 1048576.0f, SSQ_INV = 1.0f / (1048576.0f * 1024.0f);
__device__ __forceinline__ float rstd_of(u64 q) { return rsqrtf((float)q * SSQ_INV + 1e-6f); }

constexpr size_t MiB = 1u << 20;
constexpr size_t WS_SSQ = 0;
constexpr size_t WS_BAR = 2 * MiB - 32768;
constexpr size_t WS_LW = 2 * MiB;
constexpr size_t LW_SET = 26 * MiB;
constexpr size_t LW_WIN = 0, LW_WOUT = 4 * MiB, LW_WQ = 6 * MiB, LW_WO = 8 * MiB, LW_W1 = 10 * MiB, LW_W2 = 18 * MiB;
constexpr size_t WS_XB = WS_LW + 2 * LW_SET;
constexpr size_t WS_KALL = WS_XB + 32 * MiB;
constexpr size_t WS_VT = WS_KALL + 16 * MiB;
constexpr size_t WS_H = WS_VT + 16 * MiB;
constexpr size_t WS_S0 = WS_H, WS_S1 = WS_H + 32 * MiB, WS_S2 = WS_H + 64 * MiB, WS_S3 = WS_H + 96 * MiB;
constexpr size_t WS_WKT = WS_S3, WS_WVT = WS_S3 + 8 * MiB, WS_MEMN = WS_S3 + 16 * MiB;
constexpr size_t WS_END = WS_H + 128 * MiB;

constexpr int RING_BYTES = 131072, EX_OFF = RING_BYTES, BARST_OFF = RING_BYTES + 8192, PTAB_OFF = BARST_OFF + 64, LDS_BYTES = RING_BYTES + 8192 + 2048;

__device__ __forceinline__ unsigned cvt_pk_bf16(float lo, float hi) { unsigned r; asm volatile("v_cvt_pk_bf16_f32 %0, %1, %2" : "=v"(r) : "v"(lo), "v"(hi)); return r; }
__device__ __forceinline__ float shx(float v, int lane, int o) { return __int_as_float(__builtin_amdgcn_ds_bpermute((lane ^ o) << 2, __float_as_int(v))); }
__device__ __forceinline__ float wave_sum(float v, int lane) {
#pragma unroll
    for (int o = 1; o < 64; o <<= 1) v += shx(v, lane, o);
    return v;
}
template <int CTRL> __device__ __forceinline__ float dpp_mov(float v) { return __int_as_float(__builtin_amdgcn_update_dpp(0, __float_as_int(v), CTRL, 0xf, 0xf, false)); }
__device__ __forceinline__ float wave_sum_dpp(float v) {
    v += dpp_mov<0xB1>(v);
    v += dpp_mov<0x4E>(v);
    v += dpp_mov<0x141>(v);
    v += dpp_mov<0x140>(v);
    const int b = __float_as_int(v);
    return (__int_as_float(__builtin_amdgcn_readlane(b, 0)) + __int_as_float(__builtin_amdgcn_readlane(b, 16))) + (__int_as_float(__builtin_amdgcn_readlane(b, 32)) + __int_as_float(__builtin_amdgcn_readlane(b, 48)));
}
__device__ __forceinline__ float bf_lo(unsigned u) { return __uint_as_float(u << 16); }
__device__ __forceinline__ float bf_hi(unsigned u) { return __uint_as_float(u & 0xffff0000u); }

namespace pg8 {
constexpr int BM = 256, BK = 64, HALF = 128, HTB = HALF * BK * 2, STAGE_BYTES = 8 * HTB, NXCD = 8, WGM = 4;
__host__ __device__ __forceinline__ int lds_byte(int r, int c) { const int st = (r >> 4) * 2 + (c >> 5), rr = r & 15, cc = c & 31, ob = rr * 64 + cc * 2; return st * 1024 + (ob ^ (((ob >> 9) & 1) << 5)); }
__host__ __device__ __forceinline__ void stage_rc(int b, int& R, int& C) { const int st = b / 1024, sb = b % 1024, swz = sb ^ (((sb >> 9) & 1) << 5); R = (st >> 1) * 16 + swz / 64; C = (st & 1) * 32 + (swz % 64) / 2; }
__host__ __device__ __forceinline__ int perm32(int rho) { const int n = rho >> 4, i = rho & 15; return 8 * (i >> 2) + 4 * n + (i & 3); }

struct Unit { int pm, pn; };
struct Gemm { const bf16_t* A; const bf16_t* Bt; int lda, ldb, K; long a_pm, a_pn, b_pn, b_b; };

struct Order {
    int nM, nN, nwg, G, c;
    __device__ __forceinline__ void init(int nM_, int nN_, int G_, int c_) { nM = nM_; nN = nN_; nwg = nM * nN; G = G_; c = c_; }
    __device__ __forceinline__ bool next(int i, Unit& u) const {
        const long L = (long)i * G + c; if (L >= nwg) return false;
        int wgid = (int)L; { const int q = nwg / NXCD, r = nwg % NXCD, xcd = wgid % NXCD, off = wgid / NXCD; wgid = (xcd < r ? xcd * (q + 1) : r * (q + 1) + (xcd - r) * q) + off; }
        const int nig = WGM * nN, gid = wgid / nig, fm = gid * WGM, gsz = (nM - fm) < WGM ? (nM - fm) : WGM;
        u.pm = fm + ((wgid % nig) % gsz); u.pn = (wgid % nig) / gsz; return true;
    }
};


struct EpiBf {
    bf16_t* O; int ldc; const u64* ssq; float cs; int act;
    __device__ __forceinline__ void operator()(f32x4 (&acc)[2][2][4][2], const Unit& u, int wid, int lane_) const {
        int lane; asm volatile("v_mbcnt_lo_u32_b32 %0, -1, 0\n\tv_mbcnt_hi_u32_b32 %0, -1, %0" : "=v"(lane));
        (void)lane_;
        const int wr = wid >> 2, wc = wid & 3, fr = lane & 15, fq = lane >> 4;
        const int row0 = u.pm * BM + wr * 64 + fr, col0 = u.pn * BM + wc * 32 + 8 * fq;
#pragma unroll
        for (int ai = 0; ai < 2; ++ai)
#pragma unroll
            for (int m = 0; m < 4; ++m) {
                const int r = row0 + ai * HALF + m * 16;
                float rs = cs; if (ssq) rs *= rstd_of(ssq[r]);
                bf16_t* rowp = O + (size_t)r * ldc + col0;
#pragma unroll
                for (int bj = 0; bj < 2; ++bj) {
                    f32x4 v0 = acc[ai][bj][m][0] * rs, v1 = acc[ai][bj][m][1] * rs;
                    if (act) {
#pragma unroll
                        for (int j = 0; j < 4; ++j) { const float a = fmaxf(v0[j], 0.f), b = fmaxf(v1[j], 0.f); v0[j] = a * a; v1[j] = b * b; }
                    }
                    u32x4 w; w.x = cvt_pk_bf16(v0[0], v0[1]); w.y = cvt_pk_bf16(v0[2], v0[3]); w.z = cvt_pk_bf16(v1[0], v1[1]); w.w = cvt_pk_bf16(v1[2], v1[3]);
                    *(u32x4*)(rowp + bj * HALF) = w;
                }
            }
    }
};
struct EpiGlu {
    bf16_t* O; const float* bias; const u64* ssq;
    __device__ __forceinline__ void operator()(f32x4 (&acc)[2][2][4][2], const Unit& u, int wid, int lane_) const {
        int lane; asm volatile("v_mbcnt_lo_u32_b32 %0, -1, 0\n\tv_mbcnt_hi_u32_b32 %0, -1, %0" : "=v"(lane));
        (void)lane_;
        const int wr = wid >> 2, wc = wid & 3, fr = lane & 15, fq = lane >> 4;
        const int row0 = u.pm * BM + wr * 64 + fr, ch0 = u.pn * HALF + wc * 32 + 8 * fq;
        f32x4 ba[2], bg[2];
#pragma unroll
        for (int n = 0; n < 2; ++n) { ba[n] = *(const f32x4*)(bias + ch0 + 4 * n); bg[n] = *(const f32x4*)(bias + D + ch0 + 4 * n); }
#pragma unroll
        for (int ai = 0; ai < 2; ++ai)
#pragma unroll
            for (int m = 0; m < 4; ++m) {
                const int r = row0 + ai * HALF + m * 16;
                const float rs = rstd_of(ssq[r]);
                f32x4 o[2];
#pragma unroll
                for (int n = 0; n < 2; ++n) {
                    const f32x4 a = acc[ai][0][m][n] * rs + ba[n], g = acc[ai][1][m][n] * rs + bg[n];
#pragma unroll
                    for (int j = 0; j < 4; ++j) o[n][j] = a[j] * __builtin_amdgcn_rcpf(1.0f + __builtin_amdgcn_exp2f(-g[j] * LOG2E));
                }
                u32x4 w; w.x = cvt_pk_bf16(o[0][0], o[0][1]); w.y = cvt_pk_bf16(o[0][2], o[0][3]); w.z = cvt_pk_bf16(o[1][0], o[1][1]); w.w = cvt_pk_bf16(o[1][2], o[1][3]);
                *(u32x4*)(O + (size_t)r * D + ch0) = w;
            }
    }
};
struct EpiRes {
    bf16_t* xb; const float* bias; u64* ssq_next;
    __device__ __forceinline__ void operator()(f32x4 (&acc)[2][2][4][2], const Unit& u, int wid, int lane_) const {
        int lane; asm volatile("v_mbcnt_lo_u32_b32 %0, -1, 0\n\tv_mbcnt_hi_u32_b32 %0, -1, %0" : "=v"(lane));
        (void)lane_;
        const int wr = wid >> 2, wc = wid & 3, fr = lane & 15, fq = lane >> 4;
        const int row0 = u.pm * BM + wr * 64 + fr, col0 = u.pn * BM + wc * 32 + 8 * fq;
        f32x4 bv[2][2];
#pragma unroll
        for (int bj = 0; bj < 2; ++bj)
#pragma unroll
            for (int n = 0; n < 2; ++n) bv[bj][n] = bias ? *(const f32x4*)(bias + col0 + bj * HALF + 4 * n) : (f32x4){0.f, 0.f, 0.f, 0.f};
#pragma unroll
        for (int ai = 0; ai < 2; ++ai)
#pragma unroll
            for (int m = 0; m < 4; ++m) {
                const int r = row0 + ai * HALF + m * 16; const size_t off = (size_t)r * D + col0;
                float ss = 0.f;
#pragma unroll
                for (int bj = 0; bj < 2; ++bj) {
                    const u32x4 xo = *(const u32x4*)(xb + off + bj * HALF);
                    f32x4 x0 = (f32x4){bf_lo(xo.x), bf_hi(xo.x), bf_lo(xo.y), bf_hi(xo.y)}, x1 = (f32x4){bf_lo(xo.z), bf_hi(xo.z), bf_lo(xo.w), bf_hi(xo.w)};
                    x0 += acc[ai][bj][m][0] + bv[bj][0]; x1 += acc[ai][bj][m][1] + bv[bj][1];
                    u32x4 w; w.x = cvt_pk_bf16(x0[0], x0[1]); w.y = cvt_pk_bf16(x0[2], x0[3]); w.z = cvt_pk_bf16(x1[0], x1[1]); w.w = cvt_pk_bf16(x1[2], x1[3]);
                    *(u32x4*)(xb + off + bj * HALF) = w;
                    x0 = (f32x4){bf_lo(w.x), bf_hi(w.x), bf_lo(w.y), bf_hi(w.y)}; x1 = (f32x4){bf_lo(w.z), bf_hi(w.z), bf_lo(w.w), bf_hi(w.w)};
                    ss += (x0[0] * x0[0] + x0[1] * x0[1]) + (x0[2] * x0[2] + x0[3] * x0[3]) + (x1[0] * x1[0] + x1[1] * x1[1]) + (x1[2] * x1[2] + x1[3] * x1[3]);
                }
                ss += shx(ss, lane, 16); ss += shx(ss, lane, 32);
                if (fq == 0) __hip_atomic_fetch_add(ssq_next + r, (u64)(ss * SSQ_SCALE), __ATOMIC_RELAXED, __HIP_MEMORY_SCOPE_AGENT);
            }
    }
};
struct EpiSoftmax {
    bf16_t* P; LAS f32x2* ex;
    __device__ __forceinline__ void operator()(f32x4 (&acc)[2][2][4][2], const Unit& u, int wid, int lane_) const {
        int lane; asm volatile("v_mbcnt_lo_u32_b32 %0, -1, 0\n\tv_mbcnt_hi_u32_b32 %0, -1, %0" : "=v"(lane));
        (void)lane_;
        const int wr = wid >> 2, wc = wid & 3, fr = lane & 15, fq = lane >> 4;
        const int row0 = u.pm * BM + wr * 64 + fr, col0 = u.pn * BM + wc * 32 + 8 * fq;
        float mxs[2][4];
#pragma unroll
        for (int ai = 0; ai < 2; ++ai)
#pragma unroll
            for (int m = 0; m < 4; ++m) {
                float mx = -3.0e38f;
#pragma unroll
                for (int bj = 0; bj < 2; ++bj)
#pragma unroll
                    for (int n = 0; n < 2; ++n) { const f32x4 v = acc[ai][bj][m][n]; mx = fmaxf(mx, fmaxf(fmaxf(v[0], v[1]), fmaxf(v[2], v[3]))); }
                mx = fmaxf(mx, shx(mx, lane, 16)); mx = fmaxf(mx, shx(mx, lane, 32));
                float l = 0.f;
#pragma unroll
                for (int bj = 0; bj < 2; ++bj)
#pragma unroll
                    for (int n = 0; n < 2; ++n) { f32x4 v = acc[ai][bj][m][n];
#pragma unroll
                        for (int j = 0; j < 4; ++j) { v[j] = __builtin_amdgcn_exp2f((v[j] - mx) * LOG2E); l += v[j]; }
                        acc[ai][bj][m][n] = v; }
                l += shx(l, lane, 16); l += shx(l, lane, 32);
                mxs[ai][m] = mx;
                if (fq == 0) ex[(ai * HALF + wr * 64 + m * 16 + fr) * 4 + wc] = (f32x2){mx, l};
            }
        asm volatile("s_waitcnt lgkmcnt(0)" ::: "memory"); __builtin_amdgcn_s_barrier(); asm volatile("" ::: "memory");
#pragma unroll
        for (int ai = 0; ai < 2; ++ai)
#pragma unroll
            for (int m = 0; m < 4; ++m) {
                const int lr = ai * HALF + wr * 64 + m * 16 + fr;
                const f32x2 a = ex[lr * 4 + 0], b = ex[lr * 4 + 1], c = ex[lr * 4 + 2], d = ex[lr * 4 + 3];
                const float MX = fmaxf(fmaxf(a.x, b.x), fmaxf(c.x, d.x));
                const float L = a.y * __builtin_amdgcn_exp2f((a.x - MX) * LOG2E) + b.y * __builtin_amdgcn_exp2f((b.x - MX) * LOG2E)
                              + c.y * __builtin_amdgcn_exp2f((c.x - MX) * LOG2E) + d.y * __builtin_amdgcn_exp2f((d.x - MX) * LOG2E);
                const float f = __builtin_amdgcn_exp2f((mxs[ai][m] - MX) * LOG2E) / L;
                bf16_t* rowp = P + (size_t)(row0 + ai * HALF + m * 16) * D + col0;
#pragma unroll
                for (int bj = 0; bj < 2; ++bj) {
                    const f32x4 v0 = acc[ai][bj][m][0] * f, v1 = acc[ai][bj][m][1] * f;
                    u32x4 w; w.x = cvt_pk_bf16(v0[0], v0[1]); w.y = cvt_pk_bf16(v0[2], v0[3]); w.z = cvt_pk_bf16(v1[0], v1[1]); w.w = cvt_pk_bf16(v1[2], v1[3]);
                    *(u32x4*)(rowp + bj * HALF) = w;
                }
            }
        asm volatile("s_waitcnt lgkmcnt(0)" ::: "memory"); __builtin_amdgcn_s_barrier(); asm volatile("" ::: "memory");
    }
};

template <int LDSIMM, int GOFF>
__device__ __forceinline__ void glds_s(const char* sbase, unsigned voff, unsigned ldsbase) {
    asm volatile("s_add_u32 m0, %2, %3\n\ts_nop 0\n\tglobal_load_lds_dwordx4 %0, %1 offset:%4" :: "v"(voff), "s"(sbase), "s"(ldsbase), "i"(LDSIMM), "i"(GOFF) : "memory", "m0", "scc");
}
template <class Epi, bool ALIGN_EPI>
__device__ __forceinline__ void gemm_phase(LAS unsigned char* lds, const Gemm g, const Order& S, const Epi& E, const int wid) {
    int lane; asm volatile("v_mbcnt_lo_u32_b32 %0, -1, 0\n\tv_mbcnt_hi_u32_b32 %0, -1, %0" : "=v"(lane));
    const int tid = wid * 64 + lane, wr = wid >> 2, wc = wid & 3, fr = lane & 15, fq = lane >> 4;
    const int nt = g.K / BK;
    unsigned voffA[2], voffB[2];
#pragma unroll
    for (int i = 0; i < 2; ++i) { int R, C; stage_rc(tid * 16 + i * 8192, R, C); const int Rb = (R & ~31) + perm32(R & 31);
        voffA[i] = (unsigned)(R * g.lda + C) * 2u; voffB[i] = (unsigned)(Rb * g.ldb + C) * 2u; }
    const size_t kstep = (size_t)(BK * 2);
    const size_t hstepA = (size_t)HALF * g.lda * 2, hstepB = (size_t)HALF * g.ldb * 2;
    const unsigned ldsbase = (unsigned)(size_t)lds + (unsigned)wid * 1024u;
    const int aoff = lds_byte(wr * 64 + fr, fq * 8), boff = lds_byte(wc * 32 + fr, fq * 8);
#define PG8_SA(b, h) (((b) * 2 + (h)) * HTB)
#define PG8_SB(b, h) ((4 + (b) * 2 + (h)) * HTB)
#define PG8_STAGE(bufoff, gbase, voff) do { glds_s<(bufoff), 0>((const char*)(gbase), (voff)[0], ldsbase); glds_s<(bufoff) + 8192, 0>((const char*)(gbase), (voff)[1], ldsbase); } while (0)
#define PG8_LDA(dst, b, h) do { _Pragma("unroll") for (int m = 0; m < 4; ++m) _Pragma("unroll") for (int k = 0; k < 2; ++k) dst[m][k] = *(const LAS bf16x8*)(lds + PG8_SA(b, h) + aoff + m * 2048 + k * 1024); } while (0)
#define PG8_LDB(dst, b, h) do { _Pragma("unroll") for (int n = 0; n < 2; ++n) _Pragma("unroll") for (int k = 0; k < 2; ++k) dst[n][k] = *(const LAS bf16x8*)(lds + PG8_SB(b, h) + boff + n * 2048 + k * 1024); } while (0)
#define PG8_MMA(ai, bj, At, Bt) do { __builtin_amdgcn_s_setprio(1); _Pragma("unroll") for (int m = 0; m < 4; ++m) _Pragma("unroll") for (int n = 0; n < 2; ++n) _Pragma("unroll") for (int k = 0; k < 2; ++k) \
        acc[ai][bj][m][n] = __builtin_amdgcn_mfma_f32_16x16x32_bf16(Bt[n][k], At[m][k], acc[ai][bj][m][n], 0, 0, 0); __builtin_amdgcn_s_setprio(0); } while (0)
#define PG8_WAIT_V(n) asm volatile("s_waitcnt vmcnt(" #n ")" ::: "memory")
#define PG8_WAIT_L(n) asm volatile("s_waitcnt lgkmcnt(" #n ")" ::: "memory")
#define PG8_BAR __builtin_amdgcn_s_barrier()
#define PG8_SCHED __builtin_amdgcn_sched_barrier(0)
#define PG8_ABASE(u) ((const char*)(g.A + (size_t)(u).pm * g.a_pm + (size_t)(u).pn * g.a_pn))
#define PG8_BBASE(u) ((const char*)(g.Bt + (size_t)(u).pn * g.b_pn + (size_t)((u).pm >> 3) * g.b_b))
    Unit cur, nxt; int ui = 0;
    if (!S.next(0, cur)) return;
    f32x4 acc[2][2][4][2];
#pragma unroll
    for (int a = 0; a < 2; ++a)
#pragma unroll
        for (int b = 0; b < 2; ++b)
#pragma unroll
            for (int m = 0; m < 4; ++m)
#pragma unroll
                for (int n = 0; n < 2; ++n) acc[a][b][m][n] = (f32x4){0.f, 0.f, 0.f, 0.f};
    bf16x8 At[4][2], B0[2][2], B1[2][2];
    const char* cA = PG8_ABASE(cur); const char* cB = PG8_BBASE(cur);
    PG8_STAGE(PG8_SB(0, 0), cB, voffB); PG8_STAGE(PG8_SB(0, 1), cB + hstepB, voffB); PG8_STAGE(PG8_SA(0, 0), cA, voffA); PG8_STAGE(PG8_SA(0, 1), cA + hstepA, voffA);
    if (wr == 1) PG8_BAR;
    PG8_WAIT_V(2); PG8_BAR;
    PG8_STAGE(PG8_SB(1, 0), cB + kstep, voffB); PG8_STAGE(PG8_SA(1, 0), cA + kstep, voffA); PG8_STAGE(PG8_SB(1, 1), cB + hstepB + kstep, voffB);
    PG8_WAIT_V(6); PG8_BAR;
    for (;;) {
        const bool has_next = S.next(ui + 1, nxt);
        const char* nA = has_next ? PG8_ABASE(nxt) : cA; const char* nB = has_next ? PG8_BBASE(nxt) : cB;
        for (int t = 0; t < nt; t += 2) {
            const bool last = (t == nt - 2);
            const char* a1 = cA + (size_t)(t + 1) * kstep;
            const char* a2 = last ? nA : cA + (size_t)(t + 2) * kstep; const char* b2 = last ? nB : cB + (size_t)(t + 2) * kstep;
            const char* a3 = a2 + kstep; const char* b3 = b2 + kstep;
            PG8_LDB(B0, 0, 0); PG8_LDB(B1, 0, 1); PG8_SCHED; PG8_LDA(At, 0, 0); PG8_STAGE(PG8_SA(1, 1), a1 + hstepA, voffA);
            PG8_WAIT_V(8); PG8_WAIT_L(0); PG8_BAR; PG8_MMA(0, 0, At, B0); PG8_MMA(0, 1, At, B1); PG8_BAR; PG8_SCHED;
            PG8_LDA(At, 0, 1); PG8_STAGE(PG8_SB(0, 0), b2, voffB); PG8_STAGE(PG8_SB(0, 1), b2 + hstepB, voffB); PG8_STAGE(PG8_SA(0, 0), a2, voffA);
            PG8_WAIT_V(8); PG8_WAIT_L(0); PG8_BAR; PG8_MMA(1, 0, At, B0); PG8_MMA(1, 1, At, B1); PG8_BAR; PG8_SCHED;
            PG8_LDB(B0, 1, 0); PG8_LDB(B1, 1, 1); PG8_SCHED; PG8_LDA(At, 1, 0); PG8_STAGE(PG8_SA(0, 1), a2 + hstepA, voffA);
            PG8_WAIT_V(8); PG8_WAIT_L(0); PG8_BAR; PG8_MMA(0, 0, At, B0); PG8_MMA(0, 1, At, B1); PG8_BAR; PG8_SCHED;
            PG8_LDA(At, 1, 1); PG8_STAGE(PG8_SB(1, 0), b3, voffB); PG8_STAGE(PG8_SB(1, 1), b3 + hstepB, voffB); PG8_STAGE(PG8_SA(1, 0), a3, voffA);
            PG8_WAIT_V(8); PG8_WAIT_L(0); PG8_BAR; PG8_MMA(1, 0, At, B0); PG8_MMA(1, 1, At, B1); PG8_BAR; PG8_SCHED;
        }
        if constexpr (ALIGN_EPI) { if (wr == 0) PG8_BAR; }
        E(acc, cur, wid, lane);
        if (!has_next) break;
#pragma unroll
        for (int a = 0; a < 2; ++a)
#pragma unroll
            for (int b = 0; b < 2; ++b)
#pragma unroll
                for (int m = 0; m < 4; ++m)
#pragma unroll
                    for (int n = 0; n < 2; ++n) acc[a][b][m][n] = (f32x4){0.f, 0.f, 0.f, 0.f};
        cur = nxt; cA = nA; cB = nB; ++ui;
        if constexpr (ALIGN_EPI) { if (wr == 1) PG8_BAR; }
    }
    PG8_WAIT_V(0);
    if constexpr (!ALIGN_EPI) { if (wr == 0) PG8_BAR; }
    PG8_BAR;
#undef PG8_SA
#undef PG8_SB
#undef PG8_STAGE
#undef PG8_LDA
#undef PG8_LDB
#undef PG8_MMA
#undef PG8_WAIT_V
#undef PG8_WAIT_L
#undef PG8_BAR
#undef PG8_SCHED
#undef PG8_ABASE
#undef PG8_BBASE
}
}

struct TrItem { const float* W; int ldw, src_n0, k0; bf16_t* WT; int ldt, dst_n0; const float* rs; const float* cs; };
__device__ __forceinline__ void tr_load(const TrItem& d, float (&v)[32], int lane) {
    const float* wp = d.W + (size_t)(d.k0 + (lane >> 5)) * d.ldw + d.src_n0 + (lane & 31);
#pragma unroll
    for (int i = 0; i < 32; ++i) v[i] = wp[(size_t)(2 * i) * d.ldw];
}
__device__ __forceinline__ void tr_finish(const TrItem& d, const float (&v)[32], LAS float* scr, int lane) {
    const float csv = d.cs ? d.cs[d.src_n0 + (lane & 31)] : 1.0f;
#pragma unroll
    for (int i = 0; i < 32; ++i) { const int kk = 2 * i + (lane >> 5); float t = v[i]; if (d.rs) t *= d.rs[d.k0 + kk]; scr[kk * 33 + (lane & 31)] = t * csv; }
    asm volatile("s_waitcnt lgkmcnt(0)" ::: "memory");
    const int c = lane & 7;
#pragma unroll
    for (int j = 0; j < 4; ++j) { const int n = (lane >> 3) + 8 * j; const LAS float* s = scr + (8 * c) * 33 + n;
        u32x4 o; o.x = cvt_pk_bf16(s[0 * 33], s[1 * 33]); o.y = cvt_pk_bf16(s[2 * 33], s[3 * 33]); o.z = cvt_pk_bf16(s[4 * 33], s[5 * 33]); o.w = cvt_pk_bf16(s[6 * 33], s[7 * 33]);
        *(u32x4*)(d.WT + (size_t)(d.dst_n0 + n) * d.ldt + d.k0 + 8 * c) = o; }
    asm volatile("s_waitcnt lgkmcnt(0)" ::: "memory");
}
__device__ __forceinline__ bool conv_mat(int& r, const float* W, int K, int N, bf16_t* WT, const float* rs, const float* cs, bool glu, TrItem& d) {
    const int nblk = N / 32, items = (K / 64) * nblk;
    if (r >= items) { r -= items; return false; }
    const int kb = r / nblk, nb = r % nblk, n0 = nb * 32;
    d.W = W; d.ldw = N; d.src_n0 = glu ? ((n0 >> 8) * 128 + (n0 & 127) + ((n0 >> 7) & 1) * D) : n0; d.k0 = kb * 64; d.WT = WT; d.ldt = K; d.dst_n0 = n0; d.rs = rs; d.cs = cs;
    return true;
}

struct Args { const float* in[23]; float* out; unsigned char* ws; int lo, hi; };
typedef LAS const unsigned long long* PtrTab;
__device__ __forceinline__ const float* inptr(PtrTab tab, int k) {
    const unsigned long long v = tab[k];
    typedef const float __attribute__((address_space(1)))* GPF;
    return (const float*)(GPF)(((unsigned long long)(unsigned)__builtin_amdgcn_readfirstlane((int)(v >> 32)) << 32) | (unsigned long long)(unsigned)__builtin_amdgcn_readfirstlane((int)v));
}
#define INP(k) inptr(tab, (k))

__device__ __forceinline__ void decode_item(PtrTab tab, unsigned char* ws_, int i, int it, TrItem& d) {
    int r = it;
    if (i < 0) { constexpr int I1 = (D / 64) * (D / 32); const int mtx = it / I1, l = mtx & 3; r = it % I1;
        conv_mat(r, (mtx < 4 ? INP(17) : INP(18)) + (size_t)l * D * D, D, D, (bf16_t*)(ws_ + (mtx < 4 ? WS_WKT : WS_WVT)) + (size_t)l * D * D, nullptr, nullptr, false, d); return; }
    unsigned char* lw = ws_ + WS_LW + (size_t)(i & 1) * LW_SET; const int j = i >> 1;
    if (!(i & 1)) {
        if (conv_mat(r, INP(6) + (size_t)j * D * 2 * D, D, 2 * D, (bf16_t*)(lw + LW_WIN), INP(3) + i * D, nullptr, true, d)) return;
        if (conv_mat(r, INP(12) + (size_t)j * D * D, D, D, (bf16_t*)(lw + LW_WOUT), nullptr, nullptr, false, d)) return;
    } else {
        const int g = r >> 5;
        if (g < 4) { r &= 31; conv_mat(r, INP(14) + ((size_t)j * 4 + g) * 65536, 256, 256, (bf16_t*)(lw + LW_WIN) + (size_t)g * 65536, nullptr, INP(15) + j * D + g * 256, false, d); return; }
        r -= 128;
    }
    if (conv_mat(r, INP(16) + (size_t)i * D * D, D, D, (bf16_t*)(lw + LW_WQ), INP(4) + i * D, nullptr, false, d)) return;
    if (conv_mat(r, INP(19) + (size_t)i * D * D, D, D, (bf16_t*)(lw + LW_WO), nullptr, nullptr, false, d)) return;
    if (conv_mat(r, INP(20) + (size_t)i * D * FF, D, FF, (bf16_t*)(lw + LW_W1), INP(5) + i * D, nullptr, false, d)) return;
    conv_mat(r, INP(21) + (size_t)i * FF * D, FF, D, (bf16_t*)(lw + LW_W2), nullptr, nullptr, false, d);
}
__device__ __forceinline__ void convert_job(PtrTab tab, unsigned char* ws_, int i, LAS float* scr, int gw, int NGW, int lane) {
    const int I_MIX = !(i & 1) ? (D / 64) * (2 * D / 32) + (D / 64) * (D / 32) : 4 * (256 / 64) * (256 / 32);
    const int NITEMS = (i < 0) ? 8 * (D / 64) * (D / 32) : I_MIX + 2 * (D / 64) * (D / 32) + 2 * (D / 64) * (FF / 32);
    int it = gw; if (it >= NITEMS) return;
    TrItem d0; float v0[32];
    decode_item(tab, ws_, i, it, d0); tr_load(d0, v0, lane);
    for (;;) {
        const int it2 = it + NGW; const bool has = it2 < NITEMS;
        TrItem d1; float v1[32];
        if (has) { decode_item(tab, ws_, i, it2, d1); tr_load(d1, v1, lane); }
        tr_finish(d0, v0, scr, lane);
        if (!has) break;
        d0 = d1; it = it2;
#pragma unroll
        for (int q = 0; q < 32; ++q) v0[q] = v1[q];
    }
}

__device__ __forceinline__ void dw_phase(const bf16_t* GLU, bf16_t* V, const float* wdw, const float* bdw, const float* lng, const float* lnb, LAS float* red, int bid, int G, int wave) {
    int laneA; asm volatile("v_mbcnt_lo_u32_b32 %0, -1, 0\n\tv_mbcnt_hi_u32_b32 %0, -1, %0" : "=v"(laneA));
    const int tid = wave * 64 + laneA;
    f32x2 wk[CW];
#pragma unroll
    for (int k = 0; k < CW; ++k) wk[k] = *(const f32x2*)(wdw + k * D + 2 * tid);
    const f32x2 bd = *(const f32x2*)(bdw + 2 * tid), lg = *(const f32x2*)(lng + 2 * tid), lb = *(const f32x2*)(lnb + 2 * tid);
    const unsigned* G32 = (const unsigned*)GLU; unsigned* V32 = (unsigned*)V;
    LAS f32x2* part = (LAS f32x2*)red;
    LAS f32x2* stat = (LAS f32x2*)(red + 256);
    const int ustart = (G == 256) ? (bid & 7) * 128 + (bid >> 3) * 4 : bid, ustep = (G == 256) ? 1 : G, uend = (G == 256) ? ustart + 4 : M / 16;
    unsigned raw[46];
    if (ustart < uend) { const int t0 = (ustart & 127) * 16; int vb = (ustart * 16 - 30) * 512 + tid; asm volatile("" : "+v"(vb));
#pragma unroll
        for (int r = 0; r < 46; ++r) raw[r] = (t0 - 30 + r >= 0) ? G32[vb + r * 512] : 0u; }
    for (int unit = ustart; unit < uend; unit += ustep) {
        const int t0 = (unit & 127) * 16, rowbase = unit * 16;
        f32x2 win[46];
#pragma unroll
        for (int r = 0; r < 46; ++r) win[r] = (f32x2){bf_lo(raw[r]), bf_hi(raw[r])};
        f32x2 o[16];
#pragma unroll
        for (int t = 0; t < 16; ++t) { f32x2 a = bd;
#pragma unroll
            for (int k = 0; k < CW; ++k) a = __builtin_elementwise_fma(wk[k], win[t + k], a);
            o[t] = a; }
        if (unit + ustep < uend) { const int nu = unit + ustep, nt0 = (nu & 127) * 16; int vb = (nu * 16 - 30) * 512 + tid; asm volatile("" : "+v"(vb));
#pragma unroll
            for (int r = 0; r < 46; ++r) raw[r] = (nt0 - 30 + r >= 0) ? G32[vb + r * 512] : 0u; }
        int lane; asm volatile("v_mbcnt_lo_u32_b32 %0, -1, 0\n\tv_mbcnt_hi_u32_b32 %0, -1, %0" : "=v"(lane)); const int tidB = wave * 64 + lane;
#pragma unroll
        for (int t = 0; t < 16; ++t) {
            const float s1 = wave_sum_dpp(o[t].x + o[t].y), s2 = wave_sum_dpp(o[t].x * o[t].x + o[t].y * o[t].y);
            if (lane == 0) part[wave * 16 + t] = (f32x2){s1, s2};
        }
        asm volatile("s_waitcnt lgkmcnt(0)" ::: "memory"); __builtin_amdgcn_s_barrier(); asm volatile("" ::: "memory");
        if (tidB < 16) { float s1 = 0.f, s2 = 0.f;
#pragma unroll
            for (int w = 0; w < 8; ++w) { const f32x2 p = part[w * 16 + tidB]; s1 += p.x; s2 += p.y; }
            const float mean = s1 * (1.0f / D), var = fmaxf(s2 * (1.0f / D) - mean * mean, 0.f);
            stat[tidB] = (f32x2){mean, rsqrtf(var + LN_EPS)}; }
        asm volatile("s_waitcnt lgkmcnt(0)" ::: "memory"); __builtin_amdgcn_s_barrier(); asm volatile("" ::: "memory");
#pragma unroll
        for (int t = 0; t < 16; ++t) {
            const f32x2 st = stat[t];
            float y0 = (o[t].x - st.x) * st.y * lg.x + lb.x, y1 = (o[t].y - st.x) * st.y * lg.y + lb.y;
            y0 = y0 * __builtin_amdgcn_rcpf(1.0f + __builtin_amdgcn_exp2f(-y0 * LOG2E)); y1 = y1 * __builtin_amdgcn_rcpf(1.0f + __builtin_amdgcn_exp2f(-y1 * LOG2E));
            V32[(size_t)(rowbase + t) * 512 + tidB] = cvt_pk_bf16(y0, y1);
        }
        asm volatile("s_waitcnt lgkmcnt(0)" ::: "memory"); __builtin_amdgcn_s_barrier(); asm volatile("" ::: "memory");
    }
}

__device__ __forceinline__ float bcast_lane(float v, int k) { return __int_as_float(__builtin_amdgcn_readlane(__float_as_int(v), k)); }
template <int W>
__device__ __forceinline__ void pl_span(const bf16_t* XBs, const u64* ssq, bf16_t* PP, int unit0, int nsub, int tid, int lane, f32x2 g) {
    const unsigned* X32 = (const unsigned*)XBs; unsigned* P32 = (unsigned*)PP;
    const int t0 = (unit0 & 127) * 16, rowbase = unit0 * 16;
    const bool first = (t0 == 0);
    int vb = rowbase * 512 + tid; asm volatile("" : "+v"(vb));
    unsigned xh[W - 1], xc[16];
#pragma unroll
    for (int j = 0; j < W - 1; ++j) xh[j] = X32[vb + (first ? 0 : (j - (W - 1))) * 512];
    const int l5 = lane & 31;
    u64 q = ssq[rowbase + (l5 < 16 ? l5 : (first ? 0 : l5 - 32))];
#pragma unroll
    for (int j = 0; j < 16; ++j) xc[j] = X32[vb + j * 512];
    float rsl = rstd_of(q);
    f32x2 hist[W - 1]; f32x2 S = (f32x2){0.f, 0.f};
#pragma unroll
    for (int j = 0; j < W - 1; ++j) { const float r0 = bcast_lane(rsl, 32 - (W - 1) + j), rs = first ? 0.f : r0; hist[j] = (f32x2){bf_lo(xh[j]) * rs, bf_hi(xh[j]) * rs}; S += hist[j]; }
    constexpr float INVW = 1.0f / (float)W;
    for (int c = 0; c < nsub; ++c) {
        const bool more = (c + 1 < nsub);
        f32x2 ext[W - 1 + 16];
#pragma unroll
        for (int j = 0; j < W - 1; ++j) ext[j] = hist[j];
#pragma unroll
        for (int j = 0; j < 16; ++j) { const float rs = bcast_lane(rsl, j); ext[W - 1 + j] = (f32x2){bf_lo(xc[j]) * rs, bf_hi(xc[j]) * rs}; }
        const bool head = first && c == 0;
#pragma unroll
        for (int j = 0; j < 16; ++j) {
            S += ext[W - 1 + j];
            const float inv = head ? (1.0f / (float)((j + 1 < W) ? j + 1 : W)) : INVW;
            const f32x2 p = (S * inv - ext[W - 1 + j]) * g;
            P32[vb + (16 * c + j) * 512] = cvt_pk_bf16(p.x, p.y);
            S -= ext[j];
        }
#pragma unroll
        for (int j = 0; j < W - 1; ++j) hist[j] = ext[16 + j];
        if (more) {
#pragma unroll
            for (int j = 0; j < 16; ++j) xc[j] = X32[vb + (16 * (c + 1) + j) * 512];
            rsl = rstd_of(ssq[rowbase + 16 * (c + 1) + (lane & 15)]);
        }
    }
}
__device__ __forceinline__ void pl_phase(const bf16_t* X, const u64* ssq, const float* gain, bf16_t* PP, int bid, int G, int wave) {
    int lane; asm volatile("v_mbcnt_lo_u32_b32 %0, -1, 0\n\tv_mbcnt_hi_u32_b32 %0, -1, %0" : "=v"(lane)); const int tid = wave * 64 + lane;
    const f32x2 g = *(const f32x2*)(gain + 2 * tid); const int grp = wave >> 1;
    const int ustart = (G == 256) ? (bid & 7) * 128 + (bid >> 3) * 4 : bid, ustep = (G == 256) ? 4 : G, uend = (G == 256) ? ustart + 4 : M / 16, nsub = (G == 256) ? 4 : 1;
    for (int unit = ustart; unit < uend; unit += ustep) {
        if (grp == 0) pl_span<2>(X, ssq, PP, unit, nsub, tid, lane, g);
        else if (grp == 1) pl_span<4>(X, ssq, PP, unit, nsub, tid, lane, g);
        else if (grp == 2) pl_span<8>(X, ssq, PP, unit, nsub, tid, lane, g);
        else pl_span<16>(X, ssq, PP, unit, nsub, tid, lane, g);
    }
}

#define XB_TMO      128
#define XB_XCNT(j)  (256  + 64 * (j))
#define XB_XSUB(j)  (1280 + 64 * (j))
#define XB_XGEN(j)  (2304 + 64 * (j))
#define XB_TOP      3328
#define XB_TOPGEN   3392
#define XB_LSUB(j)  (3456 + 64 * (j))
#define XB_LGEN(j)  (4480 + 64 * (j))
#define XB_GMASK(j) (5504 + (j))
#define XCD_BAR_WORDS 5632
#define XB_SPIN_CAP (1u << 18)
__device__ __forceinline__ unsigned xb_ld(unsigned* p)              { return __hip_atomic_load(p, __ATOMIC_RELAXED, __HIP_MEMORY_SCOPE_AGENT); }
__device__ __forceinline__ unsigned xb_add(unsigned* p, unsigned v) { return __hip_atomic_fetch_add(p, v, __ATOMIC_RELAXED, __HIP_MEMORY_SCOPE_AGENT); }
__device__ __forceinline__ unsigned xb_xcc_id() { return (unsigned)__builtin_amdgcn_s_getreg((3 << 11) | 20) & 0xFu; }
#define XB_SPIN(cond, bar) do { unsigned _sp = 0; while (cond) { __builtin_amdgcn_s_sleep(1); \
    if ((++_sp & 255u) == 0u) { if (xb_ld(&(bar)[XB_TMO])) break; if (_sp > XB_SPIN_CAP) { atomicAdd(&(bar)[XB_TMO], 1u); break; } } } } while (0)
struct XcdBarrier { unsigned* bar; unsigned x; volatile LAS unsigned* st; };
__device__ __forceinline__ void xcd_barrier_complete(unsigned* bar, unsigned x, unsigned& nloc, unsigned& nx) {
    const unsigned G = gridDim.x * gridDim.y * gridDim.z;
    unsigned sum, cnt, mine, sp = 0u;
    for (;;) {
        sum = 0u; cnt = 0u; mine = 0u;
#pragma unroll
        for (unsigned j = 0; j < 16; ++j) { const unsigned c = xb_ld(&bar[XB_XCNT(j)]); sum += c; cnt += (c > 0u) ? 1u : 0u; mine = (j == x) ? c : mine; }
        if (sum == G) break;
        __builtin_amdgcn_s_sleep(1);
        if ((++sp & 255u) == 0u) { if (xb_ld(&bar[XB_TMO])) break; if (sp > XB_SPIN_CAP) { atomicAdd(&bar[XB_TMO], 1u); break; } }
    }
    nloc = mine > 0u ? mine : 1u; nx = cnt > 0u ? cnt : 1u;
}
__device__ __forceinline__ void xcd_barrier(unsigned* bar_, volatile LAS unsigned* st_) {
    XcdBarrier b; b.bar = bar_; b.st = st_; b.x = xb_xcc_id();
    asm volatile("s_waitcnt vmcnt(0)" ::: "memory");
    __syncthreads();
    if (threadIdx.x == 0) {
        unsigned* bar = b.bar;
        __builtin_amdgcn_s_waitcnt(0);
        unsigned nloc = b.st[0], nx = b.st[1];
        if (nloc == 0u) { xcd_barrier_complete(bar, b.x, nloc, nx); b.st[0] = nloc; b.st[1] = nx; }
        const unsigned old = xb_add(&bar[XB_XSUB(b.x)], 1u);
        const unsigned gen = old / nloc;
        if (old + 1u == (gen + 1u) * nloc) {
            __builtin_amdgcn_fence(__ATOMIC_RELEASE, "agent");
            asm volatile("s_waitcnt vmcnt(0)" ::: "memory");
            const unsigned og = xb_add(&bar[XB_TOP], 1u);
            const unsigned tg = og / nx;
            if (og + 1u == (tg + 1u) * nx) xb_add(&bar[XB_TOPGEN], 1u);
            else XB_SPIN(xb_ld(&bar[XB_TOPGEN]) == tg, bar);
            __builtin_amdgcn_fence(__ATOMIC_ACQUIRE, "agent");
            xb_add(&bar[XB_XGEN(b.x)], 1u);
            asm volatile("s_waitcnt vmcnt(0)" ::: "memory");
        } else {
            XB_SPIN(xb_ld(&bar[XB_XGEN(b.x)]) == gen, bar);
            __builtin_amdgcn_fence(__ATOMIC_ACQUIRE, "agent");
            asm volatile("s_waitcnt vmcnt(0)" ::: "memory");
        }
    }
    __syncthreads();
}

__device__ __forceinline__ void xcd_local_barrier(unsigned* bar, unsigned grp, unsigned nloc) {
    asm volatile("s_waitcnt vmcnt(0)" ::: "memory");
    __syncthreads();
    if (threadIdx.x == 0) {
        __builtin_amdgcn_s_waitcnt(0);
        const unsigned old = xb_add(&bar[XB_LSUB(grp)], 1u);
        const unsigned gen = old / nloc;
        if (old + 1u == (gen + 1u) * nloc) xb_add(&bar[XB_LGEN(grp)], 1u);
        else XB_SPIN(xb_ld(&bar[XB_LGEN(grp)]) == gen, bar);
        __builtin_amdgcn_fence(__ATOMIC_ACQUIRE, "agent");
        asm volatile("s_waitcnt vmcnt(0)" ::: "memory");
    }
    __syncthreads();
}

enum { K_PRO = 0, K_KV, K_G1, K_DW, K_G2, K_PL, K_GP, K_GQ, K_S, K_PV, K_WO, K_UP, K_DOWN, K_FINAL };
constexpr int N_PHASES = 2 + 2 * 17 + 1;
__host__ __device__ __forceinline__ void decode_phase(int ph, int& kind, int& layer) {
    if (ph == 0) { kind = K_PRO; layer = 0; return; }
    if (ph == 1) { kind = K_KV; layer = 0; return; }
    if (ph == N_PHASES - 1) { kind = K_FINAL; layer = 0; return; }
    const int q = ph - 2, pair = q / 17, r = q % 17;
    if (r < 9) { layer = 2 * pair; kind = (r < 3) ? (K_G1 + r) : (K_GQ + (r - 3)); }
    else { layer = 2 * pair + 1; const int s = r - 9; kind = (s < 2) ? (K_PL + s) : (K_GQ + (s - 2)); }
}

__global__ void __launch_bounds__(512, 2) fwd_megakernel(Args args) {
    extern __shared__ __attribute__((aligned(16))) unsigned char lds_raw[];
    LAS unsigned char* lds = (LAS unsigned char*)lds_raw;
    const int G0 = gridDim.x, bid0 = blockIdx.x, bid = bid0;
    const int wave_s = __builtin_amdgcn_readfirstlane(threadIdx.x >> 6);
    unsigned char* ws = args.ws;
    u64* SSQ = (u64*)(ws + WS_SSQ);
    float* X = args.out;
    bf16_t* XB = (bf16_t*)(ws + WS_XB);
    bf16_t* KALL = (bf16_t*)(ws + WS_KALL); bf16_t* VT = (bf16_t*)(ws + WS_VT);
    bf16_t* S0 = (bf16_t*)(ws + WS_S0); bf16_t* S1 = (bf16_t*)(ws + WS_S1); bf16_t* S2 = (bf16_t*)(ws + WS_S2); bf16_t* HM = (bf16_t*)(ws + WS_H);
    LAS float* exf = (LAS float*)(lds + EX_OFF);
    if (threadIdx.x < 4) ((volatile LAS unsigned*)(lds + BARST_OFF))[threadIdx.x] = 0u;
    if (threadIdx.x == 0) {
#pragma unroll
        for (int k = 0; k < 23; ++k) ((LAS unsigned long long*)(lds + PTAB_OFF))[k] = (unsigned long long)args.in[k];
    }
    __syncthreads();
    PtrTab tab = (PtrTab)(lds + PTAB_OFF);
    if (threadIdx.x == 0) {
        unsigned* bar0 = (unsigned*)(args.ws + WS_BAR); const unsigned x = xb_xcc_id();
        (void)xb_add(bar0 + XB_XCNT(x), 1u); (void)__hip_atomic_fetch_or(bar0 + XB_GMASK(bid & 7), 1u << x, __ATOMIC_RELAXED, __HIP_MEMORY_SCOPE_AGENT);
    }
    if (args.lo < 0) cg::this_grid().sync();

#pragma unroll 1
    for (int ph = args.lo; ph < args.hi; ++ph) {
        int G = G0, bid = bid0, wave = wave_s; asm volatile("" : "+s"(G), "+s"(bid), "+s"(wave));
        const int gw = bid * 8 + wave, NGW = G * 8;
        LAS float* scr = (LAS float*)(lds + wave * 16384);
        int kind, i; decode_phase(ph, kind, i);
        if (ph >= LAST_PH && ph < N_PHASES - 1) kind = -1;
        const int j = i >> 1;
        unsigned char* lw = ws + WS_LW + (size_t)(i & 1) * LW_SET;
        switch (kind) {
        case K_PRO: {
            int lane; asm volatile("v_mbcnt_lo_u32_b32 %0, -1, 0\n\tv_mbcnt_hi_u32_b32 %0, -1, %0" : "=v"(lane)); const int tid = wave * 64 + lane; (void)tid;
            { unsigned z = 0u; asm volatile("" : "+v"(z));
              for (int u = bid * 512 + tid; u < 12 * M / 2; u += G * 512) ((u32x4*)(SSQ + M))[u] = (u32x4){z, z, z, z}; }
            convert_job(tab, ws, -1, scr, gw, NGW, lane);
            for (int m = gw; m < MEMR; m += NGW) {
                const f32x4* xr = (const f32x4*)(INP(1) + (size_t)m * D) + lane; f32x4 v[4]; float s = 0.f;
#pragma unroll
                for (int q = 0; q < 4; ++q) { v[q] = xr[64 * q]; s += (v[q].x * v[q].x + v[q].y * v[q].y) + (v[q].z * v[q].z + v[q].w * v[q].w); }
                const float rs = rsqrtf(wave_sum(s, lane) * (1.0f / D) + RMS_EPS);
                u32x2* o8 = (u32x2*)((bf16_t*)(ws + WS_MEMN) + (size_t)m * D) + lane;
#pragma unroll
                for (int q = 0; q < 4; ++q) { const f32x4 gq = ((const f32x4*)INP(2))[lane + 64 * q]; u32x2 w; w.x = cvt_pk_bf16(v[q].x * rs * gq.x, v[q].y * rs * gq.y); w.y = cvt_pk_bf16(v[q].z * rs * gq.z, v[q].w * rs * gq.w); o8[64 * q] = w; }
            }
            const int m0 = (G == 256) ? (bid & 7) * SEQ + (bid >> 3) * 8 + wave : gw, mstep = (G == 256) ? 256 : NGW, mend = (G == 256) ? ((bid & 7) + 1) * SEQ : M;
            for (int m = m0; m < mend; m += mstep) {
                const f32x4* xr = (const f32x4*)(INP(0) + (size_t)m * D) + lane; f32x4 v[4]; float s = 0.f;
                u32x2* o8 = (u32x2*)(XB + (size_t)m * D) + lane;
#pragma unroll
                for (int q = 0; q < 4; ++q) { v[q] = xr[64 * q]; u32x2 w; w.x = cvt_pk_bf16(v[q].x, v[q].y); w.y = cvt_pk_bf16(v[q].z, v[q].w); o8[64 * q] = w;
                    const float a = bf_lo(w.x), b = bf_hi(w.x), c = bf_lo(w.y), d = bf_hi(w.y); s += (a * a + b * b) + (c * c + d * d); }
                s = wave_sum(s, lane);
                if (lane == 0) SSQ[m] = (u64)(s * SSQ_SCALE);
            }
            convert_job(tab, ws, 0, scr, gw, NGW, lane);
        } break;
        case K_KV: {
            {
                pg8::Gemm g{(const bf16_t*)(ws + WS_MEMN), (const bf16_t*)(ws + WS_WKT), D, D, D, 256L * D, 0, 256L * D, 0};
                pg8::Order S; S.init(MEMR / 256, 4 * D / 256, G, bid);
                pg8::EpiBf E{KALL, 4 * D, nullptr, 1.0f, 0};
                pg8::gemm_phase<pg8::EpiBf, true>(lds, g, S, E, wave);
            }
            {
                pg8::Gemm g{(const bf16_t*)(ws + WS_WVT), (const bf16_t*)(ws + WS_MEMN), D, D, D, 256L * D, 0, 256L * D, 0};
                pg8::Order S; S.init(4 * D / 256, MEMR / 256, G, (bid + G / 2) % G);
                pg8::EpiBf E{VT, MEMR, nullptr, 1.0f, 0};
                pg8::gemm_phase<pg8::EpiBf, true>(lds, g, S, E, wave);
            }
        } break;
        case K_G1: {
            pg8::Gemm g{XB, (const bf16_t*)(lw + LW_WIN), D, D, D, 256L * D, 0, 256L * D, 0};
            pg8::Order S; S.init(M / 256, 2 * D / 256, G, bid);
            pg8::EpiGlu E{S0, INP(7) + j * 2 * D, SSQ + (size_t)(3 * i) * M};
            pg8::gemm_phase<pg8::EpiGlu, true>(lds, g, S, E, wave);
        } break;
        case K_DW: {
            dw_phase(S0, S1, INP(8) + (size_t)j * CW * D, INP(9) + j * D, INP(10) + j * D, INP(11) + j * D, exf, bid, G, wave);
        } break;
        case K_PL: {
            pl_phase(XB, SSQ + (size_t)(3 * i) * M, INP(3) + i * D, S0, bid, G, wave);
        } break;
        case K_G2: case K_GP: case K_WO: case K_DOWN: {
            pg8::Gemm g; pg8::EpiRes E; E.xb = XB; E.bias = nullptr;
            if (kind == K_G2) { g = pg8::Gemm{S1, (const bf16_t*)(lw + LW_WOUT), D, D, D, 256L * D, 0, 256L * D, 0}; E.bias = INP(13) + j * D; E.ssq_next = SSQ + (size_t)(3 * i + 1) * M; }
            else if (kind == K_GP) { g = pg8::Gemm{S0, (const bf16_t*)(lw + LW_WIN), D, 256, 256, 256L * D, 256, 65536, 0}; E.ssq_next = SSQ + (size_t)(3 * i + 1) * M; }
            else if (kind == K_WO) { g = pg8::Gemm{S2, (const bf16_t*)(lw + LW_WO), D, D, D, 256L * D, 0, 256L * D, 0}; E.ssq_next = SSQ + (size_t)(3 * i + 2) * M; }
            else { g = pg8::Gemm{HM, (const bf16_t*)(lw + LW_W2), FF, FF, FF, 256L * FF, 0, 256L * FF, 0}; E.ssq_next = SSQ + (size_t)(3 * i + 3) * M; }
            pg8::Order S; S.init(M / 256, D / 256, G, bid);
            pg8::gemm_phase<pg8::EpiRes, true>(lds, g, S, E, wave);
        } break;
        case K_GQ: case K_UP: case K_PV: {
            pg8::Gemm g; pg8::EpiBf E; int nN = D / 256;
            if (kind == K_GQ) { g = pg8::Gemm{XB, (const bf16_t*)(lw + LW_WQ), D, D, D, 256L * D, 0, 256L * D, 0}; E = pg8::EpiBf{S0, D, SSQ + (size_t)(3 * i + 1) * M, 0.0625f, 0}; }
            else if (kind == K_UP) { g = pg8::Gemm{XB, (const bf16_t*)(lw + LW_W1), D, D, D, 256L * D, 0, 256L * D, 0}; E = pg8::EpiBf{HM, FF, SSQ + (size_t)(3 * i + 2) * M, 1.0f, 1}; nN = FF / 256; }
            else { g = pg8::Gemm{S1, VT + (size_t)i * D * MEMR, D, MEMR, 256, 256L * D, 256, 256L * MEMR, 256}; E = pg8::EpiBf{S2, D, nullptr, 1.0f, 0}; }
            pg8::Order S; S.init(M / 256, nN, G, bid);
            pg8::gemm_phase<pg8::EpiBf, true>(lds, g, S, E, wave);
            if (kind == K_PV && i + 1 < 4) { int lane2; asm volatile("v_mbcnt_lo_u32_b32 %0, -1, 0\n\tv_mbcnt_hi_u32_b32 %0, -1, %0" : "=v"(lane2));
                convert_job(tab, ws, i + 1, scr, gw, NGW, lane2); }
        } break;
        case K_S: {
            pg8::Gemm g{S0, KALL + (size_t)i * D, D, 4 * D, 256, 256L * D, 256, 256, 256L * 4 * D};
            pg8::Order S; S.init(M / 256, D / 256, G, bid);
            pg8::EpiSoftmax E{S1, (LAS f32x2*)exf};
            pg8::gemm_phase<pg8::EpiSoftmax, true>(lds, g, S, E, wave);
        } break;
        case K_FINAL: {
            int lane; asm volatile("v_mbcnt_lo_u32_b32 %0, -1, 0\n\tv_mbcnt_hi_u32_b32 %0, -1, %0" : "=v"(lane)); const int tid = wave * 64 + lane; (void)tid;
            const int m0 = (G == 256) ? (bid & 7) * SEQ + (bid >> 3) * 8 + wave : gw, mstep = (G == 256) ? 256 : NGW, mend = (G == 256) ? ((bid & 7) + 1) * SEQ : M;
            for (int m = m0; m < mend; m += mstep) {
                f32x4* xr = (f32x4*)(X + (size_t)m * D) + lane; const u32x2* xi = (const u32x2*)(XB + (size_t)m * D) + lane; f32x4 v[4]; float s = 0.f;
#pragma unroll
                for (int q = 0; q < 4; ++q) { const u32x2 w = xi[64 * q]; v[q] = (f32x4){bf_lo(w.x), bf_hi(w.x), bf_lo(w.y), bf_hi(w.y)}; s += (v[q].x * v[q].x + v[q].y * v[q].y) + (v[q].z * v[q].z + v[q].w * v[q].w); }
                const float rs = rsqrtf(wave_sum(s, lane) * (1.0f / D) + RMS_EPS);
#pragma unroll
                for (int q = 0; q < 4; ++q) { const f32x4 gq = ((const f32x4*)INP(22))[lane + 64 * q]; f32x4 o = v[q] * rs; o.x *= gq.x; o.y *= gq.y; o.z *= gq.z; o.w *= gq.w; xr[64 * q] = o; }
            }
        } break;
        }
        if (ph + 1 < args.hi) {
            unsigned* bar = (unsigned*)(args.ws + WS_BAR); volatile LAS unsigned* st = (volatile LAS unsigned*)(lds + BARST_OFF);
            if (kind == K_GQ || kind == K_S) {
                asm volatile("s_waitcnt vmcnt(0)" ::: "memory"); __syncthreads();
                if (threadIdx.x == 0) { __builtin_amdgcn_fence(__ATOMIC_ACQUIRE, "agent"); asm volatile("s_waitcnt vmcnt(0)" ::: "memory"); }
                __syncthreads();
            } else if (ph <= 1 || (kind == K_DOWN && i < 3) || st[2] != 1u) {
                xcd_barrier(bar, st);
                if (ph == 1) {
                    if (threadIdx.x == 0) { bool pure = (G == 256 && st[0] == 32u && st[1] == 8u);
#pragma unroll
                        for (int g8 = 0; g8 < 8; ++g8) pure = pure && (__builtin_popcount(xb_ld(bar + XB_GMASK(g8))) == 1);
                        st[2] = (pure && !FORCE_FALLBACK) ? 1u : 2u; }
                    __syncthreads();
                }
            } else xcd_local_barrier(bar, (unsigned)(bid & 7), 32u);
        }
    }
}

extern "C" void kernel_launch(void* const* d_in, const int* in_sizes, int n_in, void* d_out, int out_size, void* d_ws, size_t ws_size, hipStream_t stream) {
    static int grid = 0;
    if (grid == 0) {
        if (n_in != 23 || out_size != M * D || ws_size < WS_END) { fprintf(stderr, "kernel_launch: unexpected problem (n_in %d out %d ws %zu)\n", n_in, out_size, ws_size); grid = -1; return; }
        int dev = 0, cus = 0, per_cu = 0;
        hipGetDevice(&dev); hipDeviceGetAttribute(&cus, hipDeviceAttributeMultiprocessorCount, dev);
        hipFuncSetAttribute((const void*)fwd_megakernel, hipFuncAttributeMaxDynamicSharedMemorySize, LDS_BYTES);
        if (hipOccupancyMaxActiveBlocksPerMultiprocessor(&per_cu, (const void*)fwd_megakernel, 512, LDS_BYTES) != hipSuccess || per_cu < 1) { fprintf(stderr, "kernel_launch: occupancy query gave %d\n", per_cu); per_cu = 1; }
        (void)hipGetLastError();
        grid = cus * per_cu;
    }
    if (grid < 0) return;
    (void)hipMemsetAsync((unsigned char*)d_ws + WS_BAR, 0, XCD_BAR_WORDS * 4, stream);
    Args a{};
    for (int i = 0; i < 23; ++i) a.in[i] = (const float*)d_in[i];
    a.out = (float*)d_out; a.ws = (unsigned char*)d_ws;
#if MK_PER_PHASE
    for (int ph = 0; ph < N_PHASES; ++ph) { a.lo = ph; a.hi = ph + 1; hipLaunchKernelGGL(fwd_megakernel, dim3(grid), dim3(512), LDS_BYTES, stream, a); }
#else
    a.lo = 0; a.hi = N_PHASES;
    void* kargs[] = {&a};
    hipError_t e = hipLaunchCooperativeKernel((const void*)fwd_megakernel, dim3(grid), dim3(512), kargs, LDS_BYTES, stream);
    if (e != hipSuccess) fprintf(stderr, "cooperative launch failed: %s (grid %d)\n", hipGetErrorString(e), grid);
#endif
}
```

```cpp
#include <hip/hip_runtime.h>
#include <hip/hip_cooperative_groups.h>
#include <cstdio>
#include <cstdint>
namespace cg = cooperative_groups;

#ifndef MK_PER_PHASE
#define MK_PER_PHASE 0
#endif

#ifndef LAST_PH
#define LAST_PH 99
#endif
#ifndef FORCE_FALLBACK
#define FORCE_FALLBACK 0
#endif
#define LAS __attribute__((address_space(3)))
typedef unsigned short bf16_t;
typedef short bf16x8 __attribute__((ext_vector_type(8)));
typedef float f32x4 __attribute__((ext_vector_type(4)));
typedef float f32x2 __attribute__((ext_vector_type(2)));
typedef unsigned u32x4 __attribute__((ext_vector_type(4)));
typedef unsigned u32x2 __attribute__((ext_vector_type(2)));

constexpr int D = 1024, NB = 8, SEQ = 2048, M = NB * SEQ, FF = 4096, MEML = 256, MEMR = NB * MEML, CW = 31;
constexpr float RMS_EPS = 1e-6f, LN_EPS = 1e-5f;
constexpr float LOG2E = 1.4426950408889634f;
typedef unsigned long long u64;
constexpr float SSQ_SCALE = 1048576.0f, SSQ_INV = 1.0f / (1048576.0f * 1024.0f);
__device__ __forceinline__ float rstd_of(u64 q) { return rsqrtf((float)q * SSQ_INV + 1e-6f); }

constexpr size_t MiB = 1u << 20;
constexpr size_t WS_SSQ = 0;
constexpr size_t WS_BAR = 2 * MiB - 32768;
constexpr size_t WS_LW = 2 * MiB;
constexpr size_t LW_SET = 26 * MiB;
constexpr size_t LW_WIN = 0, LW_WOUT = 4 * MiB, LW_WQ = 6 * MiB, LW_WO = 8 * MiB, LW_W1 = 10 * MiB, LW_W2 = 18 * MiB;
constexpr size_t WS_XB = WS_LW + 2 * LW_SET;
constexpr size_t WS_KALL = WS_XB + 32 * MiB;
constexpr size_t WS_VT = WS_KALL + 16 * MiB;
constexpr size_t WS_H = WS_VT + 16 * MiB;
constexpr size_t WS_S0 = WS_H, WS_S1 = WS_H + 32 * MiB, WS_S2 = WS_H + 64 * MiB, WS_S3 = WS_H + 96 * MiB;
constexpr size_t WS_WKT = WS_S3, WS_WVT = WS_S3 + 8 * MiB, WS_MEMN = WS_S3 + 16 * MiB;
constexpr size_t WS_END = WS_H + 128 * MiB;

constexpr int RING_BYTES = 131072, EX_OFF = RING_BYTES, BARST_OFF = RING_BYTES + 8192, PTAB_OFF = BARST_OFF + 64, LDS_BYTES = RING_BYTES + 8192 + 2048;

__device__ __forceinline__ unsigned cvt_pk_bf16(float lo, float hi) { unsigned r; asm volatile("v_cvt_pk_bf16_f32 %0, %1, %2" : "=v"(r) : "v"(lo), "v"(hi)); return r; }
__device__ __forceinline__ float shx(float v, int lane, int o) { return __int_as_float(__builtin_amdgcn_ds_bpermute((lane ^ o) << 2, __float_as_int(v))); }
__device__ __forceinline__ float wave_sum(float v, int lane) {
#pragma unroll
    for (int o = 1; o < 64; o <<= 1) v += shx(v, lane, o);
    return v;
}
template <int CTRL> __device__ __forceinline__ float dpp_mov(float v) { return __int_as_float(__builtin_amdgcn_update_dpp(0, __float_as_int(v), CTRL, 0xf, 0xf, false)); }
__device__ __forceinline__ float wave_sum_dpp(float v) {
    v += dpp_mov<0xB1>(v);
    v += dpp_mov<0x4E>(v);
    v += dpp_mov<0x141>(v);
    v += dpp_mov<0x140>(v);
    const int b = __float_as_int(v);
    return (__int_as_float(__builtin_amdgcn_readlane(b, 0)) + __int_as_float(__builtin_amdgcn_readlane(b, 16))) + (__int_as_float(__builtin_amdgcn_readlane(b, 32)) + __int_as_float(__builtin_amdgcn_readlane(b, 48)));
}
__device__ __forceinline__ float bf_lo(unsigned u) { return __uint_as_float(u << 16); }
__device__ __forceinline__ float bf_hi(unsigned u) { return __uint_as_float(u & 0xffff0000u); }

namespace pg8 {
constexpr int BM = 256, BK = 64, HALF = 128, HTB = HALF * BK * 2, STAGE_BYTES = 8 * HTB, NXCD = 8, WGM = 1;
__host__ __device__ __forceinline__ int lds_byte(int r, int c) { const int st = (r >> 4) * 2 + (c >> 5), rr = r & 15, cc = c & 31, ob = rr * 64 + cc * 2; return st * 1024 + (ob ^ (((ob >> 9) & 1) << 5)); }
__host__ __device__ __forceinline__ void stage_rc(int b, int& R, int& C) { const int st = b / 1024, sb = b % 1024, swz = sb ^ (((sb >> 9) & 1) << 5); R = (st >> 1) * 16 + swz / 64; C = (st & 1) * 32 + (swz % 64) / 2; }
__host__ __device__ __forceinline__ int perm32(int rho) { const int n = rho >> 4, i = rho & 15; return 8 * (i >> 2) + 4 * n + (i & 3); }

struct Unit { int pm, pn; };
struct Gemm { const bf16_t* A; const bf16_t* Bt; int lda, ldb, K; long a_pm, a_pn, b_pn, b_b; };

struct Order {
    int nM, nN, nwg, G, c;
    __device__ __forceinline__ void init(int nM_, int nN_, int G_, int c_) { nM = nM_; nN = nN_; nwg = nM * nN; G = G_; c = c_; }
    __device__ __forceinline__ bool next(int i, Unit& u) const {
        const long L = (long)i * G + c; if (L >= nwg) return false;
        int wgid = (int)L; { const int q = nwg / NXCD, r = nwg % NXCD, xcd = wgid % NXCD, off = wgid / NXCD; wgid = (xcd < r ? xcd * (q + 1) : r * (q + 1) + (xcd - r) * q) + off; }
        const int nig = WGM * nN, gid = wgid / nig, fm = gid * WGM, gsz = (nM - fm) < WGM ? (nM - fm) : WGM;
        u.pm = fm + ((wgid % nig) % gsz); u.pn = (wgid % nig) / gsz; return true;
    }
};


struct EpiBf {
    bf16_t* O; int ldc; const u64* ssq; float cs; int act;
    __device__ __forceinline__ void operator()(f32x4 (&acc)[2][2][4][2], const Unit& u, int wid, int lane_) const {
        int lane; asm volatile("v_mbcnt_lo_u32_b32 %0, -1, 0\n\tv_mbcnt_hi_u32_b32 %0, -1, %0" : "=v"(lane));
        (void)lane_;
        const int wr = wid >> 2, wc = wid & 3, fr = lane & 15, fq = lane >> 4;
        const int row0 = u.pm * BM + wr * 64 + fr, col0 = u.pn * BM + wc * 32 + 8 * fq;
#pragma unroll
        for (int ai = 0; ai < 2; ++ai)
#pragma unroll
            for (int m = 0; m < 4; ++m) {
                const int r = row0 + ai * HALF + m * 16;
                float rs = cs; if (ssq) rs *= rstd_of(ssq[r]);
                bf16_t* rowp = O + (size_t)r * ldc + col0;
#pragma unroll
                for (int bj = 0; bj < 2; ++bj) {
                    f32x4 v0 = acc[ai][bj][m][0] * rs, v1 = acc[ai][bj][m][1] * rs;
                    if (act) {
#pragma unroll
                        for (int j = 0; j < 4; ++j) { const float a = fmaxf(v0[j], 0.f), b = fmaxf(v1[j], 0.f); v0[j] = a * a; v1[j] = b * b; }
                    }
                    u32x4 w; w.x = cvt_pk_bf16(v0[0], v0[1]); w.y = cvt_pk_bf16(v0[2], v0[3]); w.z = cvt_pk_bf16(v1[0], v1[1]); w.w = cvt_pk_bf16(v1[2], v1[3]);
                    *(u32x4*)(rowp + bj * HALF) = w;
                }
            }
    }
};
struct EpiGlu {
    bf16_t* O; const float* bias; const u64* ssq;
    __device__ __forceinline__ void operator()(f32x4 (&acc)[2][2][4][2], const Unit& u, int wid, int lane_) const {
        int lane; asm volatile("v_mbcnt_lo_u32_b32 %0, -1, 0\n\tv_mbcnt_hi_u32_b32 %0, -1, %0" : "=v"(lane));
        (void)lane_;
        const int wr = wid >> 2, wc = wid & 3, fr = lane & 15, fq = lane >> 4;
        const int row0 = u.pm * BM + wr * 64 + fr, ch0 = u.pn * HALF + wc * 32 + 8 * fq;
        f32x4 ba[2], bg[2];
#pragma unroll
        for (int n = 0; n < 2; ++n) { ba[n] = *(const f32x4*)(bias + ch0 + 4 * n); bg[n] = *(const f32x4*)(bias + D + ch0 + 4 * n); }
#pragma unroll
        for (int ai = 0; ai < 2; ++ai)
#pragma unroll
            for (int m = 0; m < 4; ++m) {
                const int r = row0 + ai * HALF + m * 16;
                const float rs = rstd_of(ssq[r]);
                f32x4 o[2];
#pragma unroll
                for (int n = 0; n < 2; ++n) {
                    const f32x4 a = acc[ai][0][m][n] * rs + ba[n], g = acc[ai][1][m][n] * rs + bg[n];
#pragma unroll
                    for (int j = 0; j < 4; ++j) o[n][j] = a[j] * __builtin_amdgcn_rcpf(1.0f + __builtin_amdgcn_exp2f(-g[j] * LOG2E));
                }
                u32x4 w; w.x = cvt_pk_bf16(o[0][0], o[0][1]); w.y = cvt_pk_bf16(o[0][2], o[0][3]); w.z = cvt_pk_bf16(o[1][0], o[1][1]); w.w = cvt_pk_bf16(o[1][2], o[1][3]);
                *(u32x4*)(O + (size_t)r * D + ch0) = w;
            }
    }
};
struct EpiRes {
    bf16_t* xb; const float* bias; u64* ssq_next;
    __device__ __forceinline__ void operator()(f32x4 (&acc)[2][2][4][2], const Unit& u, int wid, int lane_) const {
        int lane; asm volatile("v_mbcnt_lo_u32_b32 %0, -1, 0\n\tv_mbcnt_hi_u32_b32 %0, -1, %0" : "=v"(lane));
        (void)lane_;
        const int wr = wid >> 2, wc = wid & 3, fr = lane & 15, fq = lane >> 4;
        const int row0 = u.pm * BM + wr * 64 + fr, col0 = u.pn * BM + wc * 32 + 8 * fq;
        f32x4 bv[2][2];
#pragma unroll
        for (int bj = 0; bj < 2; ++bj)
#pragma unroll
            for (int n = 0; n < 2; ++n) bv[bj][n] = bias ? *(const f32x4*)(bias + col0 + bj * HALF + 4 * n) : (f32x4){0.f, 0.f, 0.f, 0.f};
#pragma unroll
        for (int ai = 0; ai < 2; ++ai)
#pragma unroll
            for (int m = 0; m < 4; ++m) {
                const int r = row0 + ai * HALF + m * 16; const size_t off = (size_t)r * D + col0;
                float ss = 0.f;
#pragma unroll
                for (int bj = 0; bj < 2; ++bj) {
                    const u32x4 xo = *(const u32x4*)(xb + off + bj * HALF);
                    f32x4 x0 = (f32x4){bf_lo(xo.x), bf_hi(xo.x), bf_lo(xo.y), bf_hi(xo.y)}, x1 = (f32x4){bf_lo(xo.z), bf_hi(xo.z), bf_lo(xo.w), bf_hi(xo.w)};
                    x0 += acc[ai][bj][m][0] + bv[bj][0]; x1 += acc[ai][bj][m][1] + bv[bj][1];
                    u32x4 w; w.x = cvt_pk_bf16(x0[0], x0[1]); w.y = cvt_pk_bf16(x0[2], x0[3]); w.z = cvt_pk_bf16(x1[0], x1[1]); w.w = cvt_pk_bf16(x1[2], x1[3]);
                    *(u32x4*)(xb + off + bj * HALF) = w;
                    x0 = (f32x4){bf_lo(w.x), bf_hi(w.x), bf_lo(w.y), bf_hi(w.y)}; x1 = (f32x4){bf_lo(w.z), bf_hi(w.z), bf_lo(w.w), bf_hi(w.w)};
                    ss += (x0[0] * x0[0] + x0[1] * x0[1]) + (x0[2] * x0[2] + x0[3] * x0[3]) + (x1[0] * x1[0] + x1[1] * x1[1]) + (x1[2] * x1[2] + x1[3] * x1[3]);
                }
                ss += shx(ss, lane, 16); ss += shx(ss, lane, 32);
                if (fq == 0) __hip_atomic_fetch_add(ssq_next + r, (u64)(ss * SSQ_SCALE), __ATOMIC_RELAXED, __HIP_MEMORY_SCOPE_AGENT);
            }
    }
};
struct EpiSoftmax {
    bf16_t* P; LAS f32x2* ex;
    __device__ __forceinline__ void operator()(f32x4 (&acc)[2][2][4][2], const Unit& u, int wid, int lane_) const {
        int lane; asm volatile("v_mbcnt_lo_u32_b32 %0, -1, 0\n\tv_mbcnt_hi_u32_b32 %0, -1, %0" : "=v"(lane));
        (void)lane_;
        const int wr = wid >> 2, wc = wid & 3, fr = lane & 15, fq = lane >> 4;
        const int row0 = u.pm * BM + wr * 64 + fr, col0 = u.pn * BM + wc * 32 + 8 * fq;
        float mxs[2][4];
#pragma unroll
        for (int ai = 0; ai < 2; ++ai)
#pragma unroll
            for (int m = 0; m < 4; ++m) {
                float mx = -3.0e38f;
#pragma unroll
                for (int bj = 0; bj < 2; ++bj)
#pragma unroll
                    for (int n = 0; n < 2; ++n) { const f32x4 v = acc[ai][bj][m][n]; mx = fmaxf(mx, fmaxf(fmaxf(v[0], v[1]), fmaxf(v[2], v[3]))); }
                mx = fmaxf(mx, shx(mx, lane, 16)); mx = fmaxf(mx, shx(mx, lane, 32));
                float l = 0.f;
#pragma unroll
                for (int bj = 0; bj < 2; ++bj)
#pragma unroll
                    for (int n = 0; n < 2; ++n) { f32x4 v = acc[ai][bj][m][n];
#pragma unroll
                        for (int j = 0; j < 4; ++j) { v[j] = __builtin_amdgcn_exp2f((v[j] - mx) * LOG2E); l += v[j]; }
                        acc[ai][bj][m][n] = v; }
                l += shx(l, lane, 16); l += shx(l, lane, 32);
                mxs[ai][m] = mx;
                if (fq == 0) ex[(ai * HALF + wr * 64 + m * 16 + fr) * 4 + wc] = (f32x2){mx, l};
            }
        asm volatile("s_waitcnt lgkmcnt(0)" ::: "memory"); __builtin_amdgcn_s_barrier(); asm volatile("" ::: "memory");
#pragma unroll
        for (int ai = 0; ai < 2; ++ai)
#pragma unroll
            for (int m = 0; m < 4; ++m) {
                const int lr = ai * HALF + wr * 64 + m * 16 + fr;
                const f32x2 a = ex[lr * 4 + 0], b = ex[lr * 4 + 1], c = ex[lr * 4 + 2], d = ex[lr * 4 + 3];
                const float MX = fmaxf(fmaxf(a.x, b.x), fmaxf(c.x, d.x));
                const float L = a.y * __builtin_amdgcn_exp2f((a.x - MX) * LOG2E) + b.y * __builtin_amdgcn_exp2f((b.x - MX) * LOG2E)
                              + c.y * __builtin_amdgcn_exp2f((c.x - MX) * LOG2E) + d.y * __builtin_amdgcn_exp2f((d.x - MX) * LOG2E);
                const float f = __builtin_amdgcn_exp2f((mxs[ai][m] - MX) * LOG2E) / L;
                bf16_t* rowp = P + (size_t)(row0 + ai * HALF + m * 16) * D + col0;
#pragma unroll
                for (int bj = 0; bj < 2; ++bj) {
                    const f32x4 v0 = acc[ai][bj][m][0] * f, v1 = acc[ai][bj][m][1] * f;
                    u32x4 w; w.x = cvt_pk_bf16(v0[0], v0[1]); w.y = cvt_pk_bf16(v0[2], v0[3]); w.z = cvt_pk_bf16(v1[0], v1[1]); w.w = cvt_pk_bf16(v1[2], v1[3]);
                    *(u32x4*)(rowp + bj * HALF) = w;
                }
            }
        asm volatile("s_waitcnt lgkmcnt(0)" ::: "memory"); __builtin_amdgcn_s_barrier(); asm volatile("" ::: "memory");
    }
};

template <int LDSIMM, int GOFF>
__device__ __forceinline__ void glds_s(const char* sbase, unsigned voff, unsigned ldsbase) {
    asm volatile("s_add_u32 m0, %2, %3\n\ts_nop 0\n\tglobal_load_lds_dwordx4 %0, %1 offset:%4" :: "v"(voff), "s"(sbase), "s"(ldsbase), "i"(LDSIMM), "i"(GOFF) : "memory", "m0", "scc");
}
template <class Epi, bool ALIGN_EPI>
__device__ __forceinline__ void gemm_phase(LAS unsigned char* lds, const Gemm g, const Order& S, const Epi& E, const int wid) {
    int lane; asm volatile("v_mbcnt_lo_u32_b32 %0, -1, 0\n\tv_mbcnt_hi_u32_b32 %0, -1, %0" : "=v"(lane));
    const int tid = wid * 64 + lane, wr = wid >> 2, wc = wid & 3, fr = lane & 15, fq = lane >> 4;
    const int nt = g.K / BK;
    unsigned voffA[2], voffB[2];
#pragma unroll
    for (int i = 0; i < 2; ++i) { int R, C; stage_rc(tid * 16 + i * 8192, R, C); const int Rb = (R & ~31) + perm32(R & 31);
        voffA[i] = (unsigned)(R * g.lda + C) * 2u; voffB[i] = (unsigned)(Rb * g.ldb + C) * 2u; }
    const size_t kstep = (size_t)(BK * 2);
    const size_t hstepA = (size_t)HALF * g.lda * 2, hstepB = (size_t)HALF * g.ldb * 2;
    const unsigned ldsbase = (unsigned)(size_t)lds + (unsigned)wid * 1024u;
    const int aoff = lds_byte(wr * 64 + fr, fq * 8), boff = lds_byte(wc * 32 + fr, fq * 8);
#define PG8_SA(b, h) (((b) * 2 + (h)) * HTB)
#define PG8_SB(b, h) ((4 + (b) * 2 + (h)) * HTB)
#define PG8_STAGE(bufoff, gbase, voff) do { glds_s<(bufoff), 0>((const char*)(gbase), (voff)[0], ldsbase); glds_s<(bufoff) + 8192, 0>((const char*)(gbase), (voff)[1], ldsbase); } while (0)
#define PG8_LDA(dst, b, h) do { _Pragma("unroll") for (int m = 0; m < 4; ++m) _Pragma("unroll") for (int k = 0; k < 2; ++k) dst[m][k] = *(const LAS bf16x8*)(lds + PG8_SA(b, h) + aoff + m * 2048 + k * 1024); } while (0)
#define PG8_LDB(dst, b, h) do { _Pragma("unroll") for (int n = 0; n < 2; ++n) _Pragma("unroll") for (int k = 0; k < 2; ++k) dst[n][k] = *(const LAS bf16x8*)(lds + PG8_SB(b, h) + boff + n * 2048 + k * 1024); } while (0)
#define PG8_MMA(ai, bj, At, Bt) do { __builtin_amdgcn_s_setprio(1); _Pragma("unroll") for (int m = 0; m < 4; ++m) _Pragma("unroll") for (int n = 0; n < 2; ++n) _Pragma("unroll") for (int k = 0; k < 2; ++k) \
        acc[ai][bj][m][n] = __builtin_amdgcn_mfma_f32_16x16x32_bf16(Bt[n][k], At[m][k], acc[ai][bj][m][n], 0, 0, 0); __builtin_amdgcn_s_setprio(0); } while (0)
#define PG8_WAIT_V(n) asm volatile("s_waitcnt vmcnt(" #n ")" ::: "memory")
#define PG8_WAIT_L(n) asm volatile("s_waitcnt lgkmcnt(" #n ")" ::: "memory")
#define PG8_BAR __builtin_amdgcn_s_barrier()
#define PG8_SCHED __builtin_amdgcn_sched_barrier(0)
#define PG8_ABASE(u) ((const char*)(g.A + (size_t)(u).pm * g.a_pm + (size_t)(u).pn * g.a_pn))
#define PG8_BBASE(u) ((const char*)(g.Bt + (size_t)(u).pn * g.b_pn + (size_t)((u).pm >> 3) * g.b_b))
    Unit cur, nxt; int ui = 0;
    if (!S.next(0, cur)) return;
    f32x4 acc[2][2][4][2];
#pragma unroll
    for (int a = 0; a < 2; ++a)
#pragma unroll
        for (int b = 0; b < 2; ++b)
#pragma unroll
            for (int m = 0; m < 4; ++m)
#pragma unroll
                for (int n = 0; n < 2; ++n) acc[a][b][m][n] = (f32x4){0.f, 0.f, 0.f, 0.f};
    bf16x8 At[4][2], B0[2][2], B1[2][2];
    const char* cA = PG8_ABASE(cur); const char* cB = PG8_BBASE(cur);
    PG8_STAGE(PG8_SB(0, 0), cB, voffB); PG8_STAGE(PG8_SB(0, 1), cB + hstepB, voffB); PG8_STAGE(PG8_SA(0, 0), cA, voffA); PG8_STAGE(PG8_SA(0, 1), cA + hstepA, voffA);
    if (wr == 1) PG8_BAR;
    PG8_WAIT_V(2); PG8_BAR;
    PG8_STAGE(PG8_SB(1, 0), cB + kstep, voffB); PG8_STAGE(PG8_SA(1, 0), cA + kstep, voffA); PG8_STAGE(PG8_SB(1, 1), cB + hstepB + kstep, voffB);
    PG8_WAIT_V(6); PG8_BAR;
    for (;;) {
        const bool has_next = S.next(ui + 1, nxt);
        const char* nA = has_next ? PG8_ABASE(nxt) : cA; const char* nB = has_next ? PG8_BBASE(nxt) : cB;
        for (int t = 0; t < nt; t += 2) {
            const bool last = (t == nt - 2);
            const char* a1 = cA + (size_t)(t + 1) * kstep;
            const char* a2 = last ? nA : cA + (size_t)(t + 2) * kstep; const char* b2 = last ? nB : cB + (size_t)(t + 2) * kstep;
            const char* a3 = a2 + kstep; const char* b3 = b2 + kstep;
            PG8_LDB(B0, 0, 0); PG8_LDB(B1, 0, 1); PG8_SCHED; PG8_LDA(At, 0, 0); PG8_STAGE(PG8_SA(1, 1), a1 + hstepA, voffA);
            PG8_WAIT_V(8); PG8_WAIT_L(0); PG8_BAR; PG8_MMA(0, 0, At, B0); PG8_MMA(0, 1, At, B1); PG8_BAR; PG8_SCHED;
            PG8_LDA(At, 0, 1); PG8_STAGE(PG8_SB(0, 0), b2, voffB); PG8_STAGE(PG8_SB(0, 1), b2 + hstepB, voffB); PG8_STAGE(PG8_SA(0, 0), a2, voffA);
            PG8_WAIT_V(8); PG8_WAIT_L(0); PG8_BAR; PG8_MMA(1, 0, At, B0); PG8_MMA(1, 1, At, B1); PG8_BAR; PG8_SCHED;
            PG8_LDB(B0, 1, 0); PG8_LDB(B1, 1, 1); PG8_SCHED; PG8_LDA(At, 1, 0); PG8_STAGE(PG8_SA(0, 1), a2 + hstepA, voffA);
            PG8_WAIT_V(8); PG8_WAIT_L(0); PG8_BAR; PG8_MMA(0, 0, At, B0); PG8_MMA(0, 1, At, B1); PG8_BAR; PG8_SCHED;
            PG8_LDA(At, 1, 1); PG8_STAGE(PG8_SB(1, 0), b3, voffB); PG8_STAGE(PG8_SB(1, 1), b3 + hstepB, voffB); PG8_STAGE(PG8_SA(1, 0), a3, voffA);
            PG8_WAIT_V(8); PG8_WAIT_L(0); PG8_BAR; PG8_MMA(1, 0, At, B0); PG8_MMA(1, 1, At, B1); PG8_BAR; PG8_SCHED;
        }
        if constexpr (ALIGN_EPI) { if (wr == 0) PG8_BAR; }
        E(acc, cur, wid, lane);
        if (!has_next) break;
#pragma unroll
        for (int a = 0; a < 2; ++a)
#pragma unroll
            for (int b = 0; b < 2; ++b)
#pragma unroll
                for (int m = 0; m < 4; ++m)
#pragma unroll
                    for (int n = 0; n < 2; ++n) acc[a][b][m][n] = (f32x4){0.f, 0.f, 0.f, 0.f};
        cur = nxt; cA = nA; cB = nB; ++ui;
        if constexpr (ALIGN_EPI) { if (wr == 1) PG8_BAR; }
    }
    PG8_WAIT_V(0);
    if constexpr (!ALIGN_EPI) { if (wr == 0) PG8_BAR; }
    PG8_BAR;
#undef PG8_SA
#undef PG8_SB
#undef PG8_STAGE
#undef PG8_LDA
#undef PG8_LDB
#undef PG8_MMA
#undef PG8_WAIT_V
#undef PG8_WAIT_L
#undef PG8_BAR
#undef PG8_SCHED
#undef PG8_ABASE
#undef PG8_BBASE
}
}

struct TrItem { const float* W; int ldw, src_n0, k0; bf16_t* WT; int ldt, dst_n0; const float* rs; const float* cs; };
__device__ __forceinline__ void tr_load(const TrItem& d, float (&v)[32], int lane) {
    const float* wp = d.W + (size_t)(d.k0 + (lane >> 5)) * d.ldw + d.src_n0 + (lane & 31);
#pragma unroll
    for (int i = 0; i < 32; ++i) v[i] = wp[(size_t)(2 * i) * d.ldw];
}
__device__ __forceinline__ void tr_finish(const TrItem& d, const float (&v)[32], LAS float* scr, int lane) {
    const float csv = d.cs ? d.cs[d.src_n0 + (lane & 31)] : 1.0f;
#pragma unroll
    for (int i = 0; i < 32; ++i) { const int kk = 2 * i + (lane >> 5); float t = v[i]; if (d.rs) t *= d.rs[d.k0 + kk]; scr[kk * 33 + (lane & 31)] = t * csv; }
    asm volatile("s_waitcnt lgkmcnt(0)" ::: "memory");
    const int c = lane & 7;
#pragma unroll
    for (int j = 0; j < 4; ++j) { const int n = (lane >> 3) + 8 * j; const LAS float* s = scr + (8 * c) * 33 + n;
        u32x4 o; o.x = cvt_pk_bf16(s[0 * 33], s[1 * 33]); o.y = cvt_pk_bf16(s[2 * 33], s[3 * 33]); o.z = cvt_pk_bf16(s[4 * 33], s[5 * 33]); o.w = cvt_pk_bf16(s[6 * 33], s[7 * 33]);
        *(u32x4*)(d.WT + (size_t)(d.dst_n0 + n) * d.ldt + d.k0 + 8 * c) = o; }
    asm volatile("s_waitcnt lgkmcnt(0)" ::: "memory");
}
__device__ __forceinline__ bool conv_mat(int& r, const float* W, int K, int N, bf16_t* WT, const float* rs, const float* cs, bool glu, TrItem& d) {
    const int nblk = N / 32, items = (K / 64) * nblk;
    if (r >= items) { r -= items; return false; }
    const int kb = r / nblk, nb = r % nblk, n0 = nb * 32;
    d.W = W; d.ldw = N; d.src_n0 = glu ? ((n0 >> 8) * 128 + (n0 & 127) + ((n0 >> 7) & 1) * D) : n0; d.k0 = kb * 64; d.WT = WT; d.ldt = K; d.dst_n0 = n0; d.rs = rs; d.cs = cs;
    return true;
}

struct Args { const float* in[23]; float* out; unsigned char* ws; int lo, hi; };
typedef LAS const unsigned long long* PtrTab;
__device__ __forceinline__ const float* inptr(PtrTab tab, int k) {
    const unsigned long long v = tab[k];
    typedef const float __attribute__((address_space(1)))* GPF;
    return (const float*)(GPF)(((unsigned long long)(unsigned)__builtin_amdgcn_readfirstlane((int)(v >> 32)) << 32) | (unsigned long long)(unsigned)__builtin_amdgcn_readfirstlane((int)v));
}
#define INP(k) inptr(tab, (k))

__device__ __forceinline__ void decode_item(PtrTab tab, unsigned char* ws_, int i, int it, TrItem& d) {
    int r = it;
    if (i < 0) { constexpr int I1 = (D / 64) * (D / 32); const int mtx = it / I1, l = mtx & 3; r = it % I1;
        conv_mat(r, (mtx < 4 ? INP(17) : INP(18)) + (size_t)l * D * D, D, D, (bf16_t*)(ws_ + (mtx < 4 ? WS_WKT : WS_WVT)) + (size_t)l * D * D, nullptr, nullptr, false, d); return; }
    unsigned char* lw = ws_ + WS_LW + (size_t)(i & 1) * LW_SET; const int j = i >> 1;
    if (!(i & 1)) {
        if (conv_mat(r, INP(6) + (size_t)j * D * 2 * D, D, 2 * D, (bf16_t*)(lw + LW_WIN), INP(3) + i * D, nullptr, true, d)) return;
        if (conv_mat(r, INP(12) + (size_t)j * D * D, D, D, (bf16_t*)(lw + LW_WOUT), nullptr, nullptr, false, d)) return;
    } else {
        const int g = r >> 5;
        if (g < 4) { r &= 31; conv_mat(r, INP(14) + ((size_t)j * 4 + g) * 65536, 256, 256, (bf16_t*)(lw + LW_WIN) + (size_t)g * 65536, nullptr, INP(15) + j * D + g * 256, false, d); return; }
        r -= 128;
    }
    if (conv_mat(r, INP(16) + (size_t)i * D * D, D, D, (bf16_t*)(lw + LW_WQ), INP(4) + i * D, nullptr, false, d)) return;
    if (conv_mat(r, INP(19) + (size_t)i * D * D, D, D, (bf16_t*)(lw + LW_WO), nullptr, nullptr, false, d)) return;
    if (conv_mat(r, INP(20) + (size_t)i * D * FF, D, FF, (bf16_t*)(lw + LW_W1), INP(5) + i * D, nullptr, false, d)) return;
    conv_mat(r, INP(21) + (size_t)i * FF * D, FF, D, (bf16_t*)(lw + LW_W2), nullptr, nullptr, false, d);
}
__device__ __forceinline__ void convert_job(PtrTab tab, unsigned char* ws_, int i, LAS float* scr, int gw, int NGW, int lane) {
    const int I_MIX = !(i & 1) ? (D / 64) * (2 * D / 32) + (D / 64) * (D / 32) : 4 * (256 / 64) * (256 / 32);
    const int NITEMS = (i < 0) ? 8 * (D / 64) * (D / 32) : I_MIX + 2 * (D / 64) * (D / 32) + 2 * (D / 64) * (FF / 32);
    int it = gw; if (it >= NITEMS) return;
    TrItem d0; float v0[32];
    decode_item(tab, ws_, i, it, d0); tr_load(d0, v0, lane);
    for (;;) {
        const int it2 = it + NGW; const bool has = it2 < NITEMS;
        TrItem d1; float v1[32];
        if (has) { decode_item(tab, ws_, i, it2, d1); tr_load(d1, v1, lane); }
        tr_finish(d0, v0, scr, lane);
        if (!has) break;
        d0 = d1; it = it2;
#pragma unroll
        for (int q = 0; q < 32; ++q) v0[q] = v1[q];
    }
}

__device__ __forceinline__ void dw_phase(const bf16_t* GLU, bf16_t* V, const float* wdw, const float* bdw, const float* lng, const float* lnb, LAS float* red, int bid, int G, int wave) {
    int laneA; asm volatile("v_mbcnt_lo_u32_b32 %0, -1, 0\n\tv_mbcnt_hi_u32_b32 %0, -1, %0" : "=v"(laneA));
    const int tid = wave * 64 + laneA;
    f32x2 wk[CW];
#pragma unroll
    for (int k = 0; k < CW; ++k) wk[k] = *(const f32x2*)(wdw + k * D + 2 * tid);
    const f32x2 bd = *(const f32x2*)(bdw + 2 * tid), lg = *(const f32x2*)(lng + 2 * tid), lb = *(const f32x2*)(lnb + 2 * tid);
    const unsigned* G32 = (const unsigned*)GLU; unsigned* V32 = (unsigned*)V;
    LAS f32x2* part = (LAS f32x2*)red;
    LAS f32x2* stat = (LAS f32x2*)(red + 256);
    const int ustart = (G == 256) ? (bid & 7) * 128 + (bid >> 3) * 4 : bid, ustep = (G == 256) ? 1 : G, uend = (G == 256) ? ustart + 4 : M / 16;
    unsigned raw[46];
    if (ustart < uend) { const int t0 = (ustart & 127) * 16; int vb = (ustart * 16 - 30) * 512 + tid; asm volatile("" : "+v"(vb));
#pragma unroll
        for (int r = 0; r < 46; ++r) raw[r] = (t0 - 30 + r >= 0) ? G32[vb + r * 512] : 0u; }
    for (int unit = ustart; unit < uend; unit += ustep) {
        const int t0 = (unit & 127) * 16, rowbase = unit * 16;
        f32x2 win[46];
#pragma unroll
        for (int r = 0; r < 46; ++r) win[r] = (f32x2){bf_lo(raw[r]), bf_hi(raw[r])};
        f32x2 o[16];
#pragma unroll
        for (int t = 0; t < 16; ++t) { f32x2 a = bd;
#pragma unroll
            for (int k = 0; k < CW; ++k) a = __builtin_elementwise_fma(wk[k], win[t + k], a);
            o[t] = a; }
        if (unit + ustep < uend) { const int nu = unit + ustep, nt0 = (nu & 127) * 16; int vb = (nu * 16 - 30) * 512 + tid; asm volatile("" : "+v"(vb));
#pragma unroll
            for (int r = 0; r < 46; ++r) raw[r] = (nt0 - 30 + r >= 0) ? G32[vb + r * 512] : 0u; }
        int lane; asm volatile("v_mbcnt_lo_u32_b32 %0, -1, 0\n\tv_mbcnt_hi_u32_b32 %0, -1, %0" : "=v"(lane)); const int tidB = wave * 64 + lane;
#pragma unroll
        for (int t = 0; t < 16; ++t) {
            const float s1 = wave_sum_dpp(o[t].x + o[t].y), s2 = wave_sum_dpp(o[t].x * o[t].x + o[t].y * o[t].y);
            if (lane == 0) part[wave * 16 + t] = (f32x2){s1, s2};
        }
        asm volatile("s_waitcnt lgkmcnt(0)" ::: "memory"); __builtin_amdgcn_s_barrier(); asm volatile("" ::: "memory");
        if (tidB < 16) { float s1 = 0.f, s2 = 0.f;
#pragma unroll
            for (int w = 0; w < 8; ++w) { const f32x2 p = part[w * 16 + tidB]; s1 += p.x; s2 += p.y; }
            const float mean = s1 * (1.0f / D), var = fmaxf(s2 * (1.0f / D) - mean * mean, 0.f);
            stat[tidB] = (f32x2){mean, rsqrtf(var + LN_EPS)}; }
        asm volatile("s_waitcnt lgkmcnt(0)" ::: "memory"); __builtin_amdgcn_s_barrier(); asm volatile("" ::: "memory");
#pragma unroll
        for (int t = 0; t < 16; ++t) {
            const f32x2 st = stat[t];
            float y0 = (o[t].x - st.x) * st.y * lg.x + lb.x, y1 = (o[t].y - st.x) * st.y * lg.y + lb.y;
            y0 = y0 * __builtin_amdgcn_rcpf(1.0f + __builtin_amdgcn_exp2f(-y0 * LOG2E)); y1 = y1 * __builtin_amdgcn_rcpf(1.0f + __builtin_amdgcn_exp2f(-y1 * LOG2E));
            V32[(size_t)(rowbase + t) * 512 + tidB] = cvt_pk_bf16(y0, y1);
        }
        asm volatile("s_waitcnt lgkmcnt(0)" ::: "memory"); __builtin_amdgcn_s_barrier(); asm volatile("" ::: "memory");
    }
}

__device__ __forceinline__ float bcast_lane(float v, int k) { return __int_as_float(__builtin_amdgcn_readlane(__float_as_int(v), k)); }
template <int W>
__device__ __forceinline__ void pl_span(const bf16_t* XBs, const u64* ssq, bf16_t* PP, int unit0, int nsub, int tid, int lane, f32x2 g) {
    const unsigned* X32 = (const unsigned*)XBs; unsigned* P32 = (unsigned*)PP;
    const int t0 = (unit0 & 127) * 16, rowbase = unit0 * 16;
    const bool first = (t0 == 0);
    int vb = rowbase * 512 + tid; asm volatile("" : "+v"(vb));
    unsigned xh[W - 1], xc[16];
#pragma unroll
    for (int j = 0; j < W - 1; ++j) xh[j] = X32[vb + (first ? 0 : (j - (W - 1))) * 512];
    const int l5 = lane & 31;
    u64 q = ssq[rowbase + (l5 < 16 ? l5 : (first ? 0 : l5 - 32))];
#pragma unroll
    for (int j = 0; j < 16; ++j) xc[j] = X32[vb + j * 512];
    float rsl = rstd_of(q);
    f32x2 hist[W - 1]; f32x2 S = (f32x2){0.f, 0.f};
#pragma unroll
    for (int j = 0; j < W - 1; ++j) { const float r0 = bcast_lane(rsl, 32 - (W - 1) + j), rs = first ? 0.f : r0; hist[j] = (f32x2){bf_lo(xh[j]) * rs, bf_hi(xh[j]) * rs}; S += hist[j]; }
    constexpr float INVW = 1.0f / (float)W;
    for (int c = 0; c < nsub; ++c) {
        const bool more = (c + 1 < nsub);
        f32x2 ext[W - 1 + 16];
#pragma unroll
        for (int j = 0; j < W - 1; ++j) ext[j] = hist[j];
#pragma unroll
        for (int j = 0; j < 16; ++j) { const float rs = bcast_lane(rsl, j); ext[W - 1 + j] = (f32x2){bf_lo(xc[j]) * rs, bf_hi(xc[j]) * rs}; }
        const bool head = first && c == 0;
#pragma unroll
        for (int j = 0; j < 16; ++j) {
            S += ext[W - 1 + j];
            const float inv = head ? (1.0f / (float)((j + 1 < W) ? j + 1 : W)) : INVW;
            const f32x2 p = (S * inv - ext[W - 1 + j]) * g;
            P32[vb + (16 * c + j) * 512] = cvt_pk_bf16(p.x, p.y);
            S -= ext[j];
        }
#pragma unroll
        for (int j = 0; j < W - 1; ++j) hist[j] = ext[16 + j];
        if (more) {
#pragma unroll
            for (int j = 0; j < 16; ++j) xc[j] = X32[vb + (16 * (c + 1) + j) * 512];
            rsl = rstd_of(ssq[rowbase + 16 * (c + 1) + (lane & 15)]);
        }
    }
}
__device__ __forceinline__ void pl_phase(const bf16_t* X, const u64* ssq, const float* gain, bf16_t* PP, int bid, int G, int wave) {
    int lane; asm volatile("v_mbcnt_lo_u32_b32 %0, -1, 0\n\tv_mbcnt_hi_u32_b32 %0, -1, %0" : "=v"(lane)); const int tid = wave * 64 + lane;
    const f32x2 g = *(const f32x2*)(gain + 2 * tid); const int grp = wave >> 1;
    const int ustart = (G == 256) ? (bid & 7) * 128 + (bid >> 3) * 4 : bid, ustep = (G == 256) ? 4 : G, uend = (G == 256) ? ustart + 4 : M / 16, nsub = (G == 256) ? 4 : 1;
    for (int unit = ustart; unit < uend; unit += ustep) {
        if (grp == 0) pl_span<2>(X, ssq, PP, unit, nsub, tid, lane, g);
        else if (grp == 1) pl_span<4>(X, ssq, PP, unit, nsub, tid, lane, g);
        else if (grp == 2) pl_span<8>(X, ssq, PP, unit, nsub, tid, lane, g);
        else pl_span<16>(X, ssq, PP, unit, nsub, tid, lane, g);
    }
}

#define XB_TMO      128
#define XB_XCNT(j)  (256  + 64 * (j))
#define XB_XSUB(j)  (1280 + 64 * (j))
#define XB_XGEN(j)  (2304 + 64 * (j))
#define XB_TOP      3328
#define XB_TOPGEN   3392
#define XB_LSUB(j)  (3456 + 64 * (j))
#define XB_LGEN(j)  (4480 + 64 * (j))
#define XB_GMASK(j) (5504 + (j))
#define XCD_BAR_WORDS 5632
#define XB_SPIN_CAP (1u << 18)
__device__ __forceinline__ unsigned xb_ld(unsigned* p)              { return __hip_atomic_load(p, __ATOMIC_RELAXED, __HIP_MEMORY_SCOPE_AGENT); }
__device__ __forceinline__ unsigned xb_add(unsigned* p, unsigned v) { return __hip_atomic_fetch_add(p, v, __ATOMIC_RELAXED, __HIP_MEMORY_SCOPE_AGENT); }
__device__ __forceinline__ unsigned xb_xcc_id() { return (unsigned)__builtin_amdgcn_s_getreg((3 << 11) | 20) & 0xFu; }
#define XB_SPIN(cond, bar) do { unsigned _sp = 0; while (cond) { __builtin_amdgcn_s_sleep(1); \
    if ((++_sp & 255u) == 0u) { if (xb_ld(&(bar)[XB_TMO])) break; if (_sp > XB_SPIN_CAP) { atomicAdd(&(bar)[XB_TMO], 1u); break; } } } } while (0)
struct XcdBarrier { unsigned* bar; unsigned x; volatile LAS unsigned* st; };
__device__ __forceinline__ void xcd_barrier_complete(unsigned* bar, unsigned x, unsigned& nloc, unsigned& nx) {
    const unsigned G = gridDim.x * gridDim.y * gridDim.z;
    unsigned sum, cnt, mine, sp = 0u;
    for (;;) {
        sum = 0u; cnt = 0u; mine = 0u;
#pragma unroll
        for (unsigned j = 0; j < 16; ++j) { const unsigned c = xb_ld(&bar[XB_XCNT(j)]); sum += c; cnt += (c > 0u) ? 1u : 0u; mine = (j == x) ? c : mine; }
        if (sum == G) break;
        __builtin_amdgcn_s_sleep(1);
        if ((++sp & 255u) == 0u) { if (xb_ld(&bar[XB_TMO])) break; if (sp > XB_SPIN_CAP) { atomicAdd(&bar[XB_TMO], 1u); break; } }
    }
    nloc = mine > 0u ? mine : 1u; nx = cnt > 0u ? cnt : 1u;
}
__device__ __forceinline__ void xcd_barrier(unsigned* bar_, volatile LAS unsigned* st_) {
    XcdBarrier b; b.bar = bar_; b.st = st_; b.x = xb_xcc_id();
    asm volatile("s_waitcnt vmcnt(0)" ::: "memory");
    __syncthreads();
    if (threadIdx.x == 0) {
        unsigned* bar = b.bar;
        __builtin_amdgcn_s_waitcnt(0);
        unsigned nloc = b.st[0], nx = b.st[1];
        if (nloc == 0u) { xcd_barrier_complete(bar, b.x, nloc, nx); b.st[0] = nloc; b.st[1] = nx; }
        const unsigned old = xb_add(&bar[XB_XSUB(b.x)], 1u);
        const unsigned gen = old / nloc;
        if (old + 1u == (gen + 1u) * nloc) {
            __builtin_amdgcn_fence(__ATOMIC_RELEASE, "agent");
            asm volatile("s_waitcnt vmcnt(0)" ::: "memory");
            const unsigned og = xb_add(&bar[XB_TOP], 1u);
            const unsigned tg = og / nx;
            if (og + 1u == (tg + 1u) * nx) xb_add(&bar[XB_TOPGEN], 1u);
            else XB_SPIN(xb_ld(&bar[XB_TOPGEN]) == tg, bar);
            __builtin_amdgcn_fence(__ATOMIC_ACQUIRE, "agent");
            xb_add(&bar[XB_XGEN(b.x)], 1u);
            asm volatile("s_waitcnt vmcnt(0)" ::: "memory");
        } else {
            XB_SPIN(xb_ld(&bar[XB_XGEN(b.x)]) == gen, bar);
            __builtin_amdgcn_fence(__ATOMIC_ACQUIRE, "agent");
            asm volatile("s_waitcnt vmcnt(0)" ::: "memory");
        }
    }
    __syncthreads();
}

__device__ __forceinline__ void xcd_local_barrier(unsigned* bar, unsigned grp, unsigned nloc) {
    asm volatile("s_waitcnt vmcnt(0)" ::: "memory");
    __syncthreads();
    if (threadIdx.x == 0) {
        __builtin_amdgcn_s_waitcnt(0);
        const unsigned old = xb_add(&bar[XB_LSUB(grp)], 1u);
        const unsigned gen = old / nloc;
        if (old + 1u == (gen + 1u) * nloc) xb_add(&bar[XB_LGEN(grp)], 1u);
        else XB_SPIN(xb_ld(&bar[XB_LGEN(grp)]) == gen, bar);
        __builtin_amdgcn_fence(__ATOMIC_ACQUIRE, "agent");
        asm volatile("s_waitcnt vmcnt(0)" ::: "memory");
    }
    __syncthreads();
}

enum { K_PRO = 0, K_KV, K_G1, K_DW, K_G2, K_PL, K_GP, K_GQ, K_S, K_PV, K_WO, K_UP, K_DOWN, K_FINAL };
constexpr int N_PHASES = 2 + 2 * 17 + 1;
__host__ __device__ __forceinline__ void decode_phase(int ph, int& kind, int& layer) {
    if (ph == 0) { kind = K_PRO; layer = 0; return; }
    if (ph == 1) { kind = K_KV; layer = 0; return; }
    if (ph == N_PHASES - 1) { kind = K_FINAL; layer = 0; return; }
    const int q = ph - 2, pair = q / 17, r = q % 17;
    if (r < 9) { layer = 2 * pair; kind = (r < 3) ? (K_G1 + r) : (K_GQ + (r - 3)); }
    else { layer = 2 * pair + 1; const int s = r - 9; kind = (s < 2) ? (K_PL + s) : (K_GQ + (s - 2)); }
}

__global__ void __launch_bounds__(512, 2) fwd_megakernel(Args args) {
    extern __shared__ __attribute__((aligned(16))) unsigned char lds_raw[];
    LAS unsigned char* lds = (LAS unsigned char*)lds_raw;
    const int G0 = gridDim.x, bid0 = blockIdx.x, bid = bid0;
    const int wave_s = __builtin_amdgcn_readfirstlane(threadIdx.x >> 6);
    unsigned char* ws = args.ws;
    u64* SSQ = (u64*)(ws + WS_SSQ);
    float* X = args.out;
    bf16_t* XB = (bf16_t*)(ws + WS_XB);
    bf16_t* KALL = (bf16_t*)(ws + WS_KALL); bf16_t* VT = (bf16_t*)(ws + WS_VT);
    bf16_t* S0 = (bf16_t*)(ws + WS_S0); bf16_t* S1 = (bf16_t*)(ws + WS_S1); bf16_t* S2 = (bf16_t*)(ws + WS_S2); bf16_t* HM = (bf16_t*)(ws + WS_H);
    LAS float* exf = (LAS float*)(lds + EX_OFF);
    if (threadIdx.x < 4) ((volatile LAS unsigned*)(lds + BARST_OFF))[threadIdx.x] = 0u;
    if (threadIdx.x == 0) {
#pragma unroll
        for (int k = 0; k < 23; ++k) ((LAS unsigned long long*)(lds + PTAB_OFF))[k] = (unsigned long long)args.in[k];
    }
    __syncthreads();
    PtrTab tab = (PtrTab)(lds + PTAB_OFF);
    if (threadIdx.x == 0) {
        unsigned* bar0 = (unsigned*)(args.ws + WS_BAR); const unsigned x = xb_xcc_id();
        (void)xb_add(bar0 + XB_XCNT(x), 1u); (void)__hip_atomic_fetch_or(bar0 + XB_GMASK(bid & 7), 1u << x, __ATOMIC_RELAXED, __HIP_MEMORY_SCOPE_AGENT);
    }
    if (args.lo < 0) cg::this_grid().sync();

#pragma unroll 1
    for (int ph = args.lo; ph < args.hi; ++ph) {
        int G = G0, bid = bid0, wave = wave_s; asm volatile("" : "+s"(G), "+s"(bid), "+s"(wave));
        const int gw = bid * 8 + wave, NGW = G * 8;
        LAS float* scr = (LAS float*)(lds + wave * 16384);
        int kind, i; decode_phase(ph, kind, i);
        if (ph >= LAST_PH && ph < N_PHASES - 1) kind = -1;
        const int j = i >> 1;
        unsigned char* lw = ws + WS_LW + (size_t)(i & 1) * LW_SET;
        switch (kind) {
        case K_PRO: {
            int lane; asm volatile("v_mbcnt_lo_u32_b32 %0, -1, 0\n\tv_mbcnt_hi_u32_b32 %0, -1, %0" : "=v"(lane)); const int tid = wave * 64 + lane; (void)tid;
            { unsigned z = 0u; asm volatile("" : "+v"(z));
              for (int u = bid * 512 + tid; u < 12 * M / 2; u += G * 512) ((u32x4*)(SSQ + M))[u] = (u32x4){z, z, z, z}; }
            convert_job(tab, ws, -1, scr, gw, NGW, lane);
            for (int m = gw; m < MEMR; m += NGW) {
                const f32x4* xr = (const f32x4*)(INP(1) + (size_t)m * D) + lane; f32x4 v[4]; float s = 0.f;
#pragma unroll
                for (int q = 0; q < 4; ++q) { v[q] = xr[64 * q]; s += (v[q].x * v[q].x + v[q].y * v[q].y) + (v[q].z * v[q].z + v[q].w * v[q].w); }
                const float rs = rsqrtf(wave_sum(s, lane) * (1.0f / D) + RMS_EPS);
                u32x2* o8 = (u32x2*)((bf16_t*)(ws + WS_MEMN) + (size_t)m * D) + lane;
#pragma unroll
                for (int q = 0; q < 4; ++q) { const f32x4 gq = ((const f32x4*)INP(2))[lane + 64 * q]; u32x2 w; w.x = cvt_pk_bf16(v[q].x * rs * gq.x, v[q].y * rs * gq.y); w.y = cvt_pk_bf16(v[q].z * rs * gq.z, v[q].w * rs * gq.w); o8[64 * q] = w; }
            }
            const int m0 = (G == 256) ? (bid & 7) * SEQ + (bid >> 3) * 8 + wave : gw, mstep = (G == 256) ? 256 : NGW, mend = (G == 256) ? ((bid & 7) + 1) * SEQ : M;
            for (int m = m0; m < mend; m += mstep) {
                const f32x4* xr = (const f32x4*)(INP(0) + (size_t)m * D) + lane; f32x4 v[4]; float s = 0.f;
                u32x2* o8 = (u32x2*)(XB + (size_t)m * D) + lane;
#pragma unroll
                for (int q = 0; q < 4; ++q) { v[q] = xr[64 * q]; u32x2 w; w.x = cvt_pk_bf16(v[q].x, v[q].y); w.y = cvt_pk_bf16(v[q].z, v[q].w); o8[64 * q] = w;
                    const float a = bf_lo(w.x), b = bf_hi(w.x), c = bf_lo(w.y), d = bf_hi(w.y); s += (a * a + b * b) + (c * c + d * d); }
                s = wave_sum(s, lane);
                if (lane == 0) SSQ[m] = (u64)(s * SSQ_SCALE);
            }
            convert_job(tab, ws, 0, scr, gw, NGW, lane);
        } break;
        case K_KV: {
            {
                pg8::Gemm g{(const bf16_t*)(ws + WS_MEMN), (const bf16_t*)(ws + WS_WKT), D, D, D, 256L * D, 0, 256L * D, 0};
                pg8::Order S; S.init(MEMR / 256, 4 * D / 256, G, bid);
                pg8::EpiBf E{KALL, 4 * D, nullptr, 1.0f, 0};
                pg8::gemm_phase<pg8::EpiBf, true>(lds, g, S, E, wave);
            }
            {
                pg8::Gemm g{(const bf16_t*)(ws + WS_WVT), (const bf16_t*)(ws + WS_MEMN), D, D, D, 256L * D, 0, 256L * D, 0};
                pg8::Order S; S.init(4 * D / 256, MEMR / 256, G, (bid + G / 2) % G);
                pg8::EpiBf E{VT, MEMR, nullptr, 1.0f, 0};
                pg8::gemm_phase<pg8::EpiBf, true>(lds, g, S, E, wave);
            }
        } break;
        case K_G1: {
            pg8::Gemm g{XB, (const bf16_t*)(lw + LW_WIN), D, D, D, 256L * D, 0, 256L * D, 0};
            pg8::Order S; S.init(M / 256, 2 * D / 256, G, bid);
            pg8::EpiGlu E{S0, INP(7) + j * 2 * D, SSQ + (size_t)(3 * i) * M};
            pg8::gemm_phase<pg8::EpiGlu, true>(lds, g, S, E, wave);
        } break;
        case K_DW: {
            dw_phase(S0, S1, INP(8) + (size_t)j * CW * D, INP(9) + j * D, INP(10) + j * D, INP(11) + j * D, exf, bid, G, wave);
        } break;
        case K_PL: {
            pl_phase(XB, SSQ + (size_t)(3 * i) * M, INP(3) + i * D, S0, bid, G, wave);
        } break;
        case K_G2: case K_GP: case K_WO: case K_DOWN: {
            pg8::Gemm g; pg8::EpiRes E; E.xb = XB; E.bias = nullptr;
            if (kind == K_G2) { g = pg8::Gemm{S1, (const bf16_t*)(lw + LW_WOUT), D, D, D, 256L * D, 0, 256L * D, 0}; E.bias = INP(13) + j * D; E.ssq_next = SSQ + (size_t)(3 * i + 1) * M; }
            else if (kind == K_GP) { g = pg8::Gemm{S0, (const bf16_t*)(lw + LW_WIN), D, 256, 256, 256L * D, 256, 65536, 0}; E.ssq_next = SSQ + (size_t)(3 * i + 1) * M; }
            else if (kind == K_WO) { g = pg8::Gemm{S2, (const bf16_t*)(lw + LW_WO), D, D, D, 256L * D, 0, 256L * D, 0}; E.ssq_next = SSQ + (size_t)(3 * i + 2) * M; }
            else { g = pg8::Gemm{HM, (const bf16_t*)(lw + LW_W2), FF, FF, FF, 256L * FF, 0, 256L * FF, 0}; E.ssq_next = SSQ + (size_t)(3 * i + 3) * M; }
            pg8::Order S; S.init(M / 256, D / 256, G, bid);
            pg8::gemm_phase<pg8::EpiRes, true>(lds, g, S, E, wave);
        } break;
        case K_GQ: case K_UP: case K_PV: {
            pg8::Gemm g; pg8::EpiBf E; int nN = D / 256;
            if (kind == K_GQ) { g = pg8::Gemm{XB, (const bf16_t*)(lw + LW_WQ), D, D, D, 256L * D, 0, 256L * D, 0}; E = pg8::EpiBf{S0, D, SSQ + (size_t)(3 * i + 1) * M, 0.0625f, 0}; }
            else if (kind == K_UP) { g = pg8::Gemm{XB, (const bf16_t*)(lw + LW_W1), D, D, D, 256L * D, 0, 256L * D, 0}; E = pg8::EpiBf{HM, FF, SSQ + (size_t)(3 * i + 2) * M, 1.0f, 1}; nN = FF / 256; }
            else { g = pg8::Gemm{S1, VT + (size_t)i * D * MEMR, D, MEMR, 256, 256L * D, 256, 256L * MEMR, 256}; E = pg8::EpiBf{S2, D, nullptr, 1.0f, 0}; }
            pg8::Order S; S.init(M / 256, nN, G, bid);
            pg8::gemm_phase<pg8::EpiBf, true>(lds, g, S, E, wave);
            if (kind == K_PV && i + 1 < 4) { int lane2; asm volatile("v_mbcnt_lo_u32_b32 %0, -1, 0\n\tv_mbcnt_hi_u32_b32 %0, -1, %0" : "=v"(lane2));
                convert_job(tab, ws, i + 1, scr, gw, NGW, lane2); }
        } break;
        case K_S: {
            pg8::Gemm g{S0, KALL + (size_t)i * D, D, 4 * D, 256, 256L * D, 256, 256, 256L * 4 * D};
            pg8::Order S; S.init(M / 256, D / 256, G, bid);
            pg8::EpiSoftmax E{S1, (LAS f32x2*)exf};
            pg8::gemm_phase<pg8::EpiSoftmax, true>(lds, g, S, E, wave);
        } break;
        case K_FINAL: {
            int lane; asm volatile("v_mbcnt_lo_u32_b32 %0, -1, 0\n\tv_mbcnt_hi_u32_b32 %0, -1, %0" : "=v"(lane)); const int tid = wave * 64 + lane; (void)tid;
            const int m0 = (G == 256) ? (bid & 7) * SEQ + (bid >> 3) * 8 + wave : gw, mstep = (G == 256) ? 256 : NGW, mend = (G == 256) ? ((bid & 7) + 1) * SEQ : M;
            for (int m = m0; m < mend; m += mstep) {
                f32x4* xr = (f32x4*)(X + (size_t)m * D) + lane; const u32x2* xi = (const u32x2*)(XB + (size_t)m * D) + lane; f32x4 v[4]; float s = 0.f;
#pragma unroll
                for (int q = 0; q < 4; ++q) { const u32x2 w = xi[64 * q]; v[q] = (f32x4){bf_lo(w.x), bf_hi(w.x), bf_lo(w.y), bf_hi(w.y)}; s += (v[q].x * v[q].x + v[q].y * v[q].y) + (v[q].z * v[q].z + v[q].w * v[q].w); }
                const float rs = rsqrtf(wave_sum(s, lane) * (1.0f / D) + RMS_EPS);
#pragma unroll
                for (int q = 0; q < 4; ++q) { const f32x4 gq = ((const f32x4*)INP(22))[lane + 64 * q]; f32x4 o = v[q] * rs; o.x *= gq.x; o.y *= gq.y; o.z *= gq.z; o.w *= gq.w; xr[64 * q] = o; }
            }
        } break;
        }
        if (ph + 1 < args.hi) {
            unsigned* bar = (unsigned*)(args.ws + WS_BAR); volatile LAS unsigned* st = (volatile LAS unsigned*)(lds + BARST_OFF);
            if (kind == K_GQ || kind == K_S) {
                asm volatile("s_waitcnt vmcnt(0)" ::: "memory"); __syncthreads();
                if (threadIdx.x == 0) { __builtin_amdgcn_fence(__ATOMIC_ACQUIRE, "agent"); asm volatile("s_waitcnt vmcnt(0)" ::: "memory"); }
                __syncthreads();
            } else if (ph <= 1 || (kind == K_DOWN && i < 3) || st[2] != 1u) {
                xcd_barrier(bar, st);
                if (ph == 1) {
                    if (threadIdx.x == 0) { bool pure = (G == 256 && st[0] == 32u && st[1] == 8u);
#pragma unroll
                        for (int g8 = 0; g8 < 8; ++g8) pure = pure && (__builtin_popcount(xb_ld(bar + XB_GMASK(g8))) == 1);
                        st[2] = (pure && !FORCE_FALLBACK) ? 1u : 2u; }
                    __syncthreads();
                }
            } else xcd_local_barrier(bar, (unsigned)(bid & 7), 32u);
        }
    }
}

extern "C" void kernel_launch(void* const* d_in, const int* in_sizes, int n_in, void* d_out, int out_size, void* d_ws, size_t ws_size, hipStream_t stream) {
    static int grid = 0;
    if (grid == 0) {
        if (n_in != 23 || out_size != M * D || ws_size < WS_END) { fprintf(stderr, "kernel_launch: unexpected problem (n_in %d out %d ws %zu)\n", n_in, out_size, ws_size); grid = -1; return; }
        int dev = 0, cus = 0, per_cu = 0;
        hipGetDevice(&dev); hipDeviceGetAttribute(&cus, hipDeviceAttributeMultiprocessorCount, dev);
        hipFuncSetAttribute((const void*)fwd_megakernel, hipFuncAttributeMaxDynamicSharedMemorySize, LDS_BYTES);
        if (hipOccupancyMaxActiveBlocksPerMultiprocessor(&per_cu, (const void*)fwd_megakernel, 512, LDS_BYTES) != hipSuccess || per_cu < 1) { fprintf(stderr, "kernel_launch: occupancy query gave %d\n", per_cu); per_cu = 1; }
        (void)hipGetLastError();
        grid = cus * per_cu;
    }
    if (grid < 0) return;
    (void)hipMemsetAsync((unsigned char*)d_ws + WS_BAR, 0, XCD_BAR_WORDS * 4, stream);
    Args a{};
    for (int i = 0; i < 23; ++i) a.in[i] = (const float*)d_in[i];
    a.out = (float*)d_out; a.ws = (unsigned char*)d_ws;
#if MK_PER_PHASE
    for (int ph = 0; ph < N_PHASES; ++ph) { a.lo = ph; a.hi = ph + 1; hipLaunchKernelGGL(fwd_megakernel, dim3(grid), dim3(512), LDS_BYTES, stream, a); }
#else
    a.lo = 0; a.hi = N_PHASES;
    void* kargs[] = {&a};
    hipError_t e = hipLaunchCooperativeKernel((const void*)fwd_megakernel, dim3(grid), dim3(512), kargs, LDS_BYTES, stream);
    if (e != hipSuccess) fprintf(stderr, "cooperative launch failed: %s (grid %d)\n", hipGetErrorString(e), grid);
#endif
}
```

```cpp
#include <hip/hip_runtime.h>
#include <hip/hip_cooperative_groups.h>
#include <cstdio>
#include <cstdint>
namespace cg = cooperative_groups;

#ifndef MK_PER_PHASE
#define MK_PER_PHASE 0
#endif

#ifndef LAST_PH
#define LAST_PH 99
#endif
#ifndef FORCE_FALLBACK
#define FORCE_FALLBACK 0
#endif
#define LAS __attribute__((address_space(3)))
typedef unsigned short bf16_t;
typedef short bf16x8 __attribute__((ext_vector_type(8)));
typedef float f32x4 __attribute__((ext_vector_type(4)));
typedef float f32x2 __attribute__((ext_vector_type(2)));
typedef unsigned u32x4 __attribute__((ext_vector_type(4)));
typedef unsigned u32x2 __attribute__((ext_vector_type(2)));

constexpr int D = 1024, NB = 8, SEQ = 2048, M = NB * SEQ, FF = 4096, MEML = 256, MEMR = NB * MEML, CW = 31;
constexpr float RMS_EPS = 1e-6f, LN_EPS = 1e-5f;
constexpr float LOG2E = 1.4426950408889634f;
typedef unsigned long long u64;
constexpr float SSQ_SCALE = 1048576.0f, SSQ_INV = 1.0f / (1048576.0f * 1024.0f);
__device__ __forceinline__ float rstd_of(u64 q) { return rsqrtf((float)q * SSQ_INV + 1e-6f); }

constexpr size_t MiB = 1u << 20;
constexpr size_t WS_SSQ = 0;
constexpr size_t WS_BAR = 2 * MiB - 32768;
constexpr size_t WS_LW = 2 * MiB;
constexpr size_t LW_SET = 26 * MiB;
constexpr size_t LW_WIN = 0, LW_WOUT = 4 * MiB, LW_WQ = 6 * MiB, LW_WO = 8 * MiB, LW_W1 = 10 * MiB, LW_W2 = 18 * MiB;
constexpr size_t WS_XB = WS_LW + 2 * LW_SET;
constexpr size_t WS_KALL = WS_XB + 32 * MiB;
constexpr size_t WS_VT = WS_KALL + 16 * MiB;
constexpr size_t WS_H = WS_VT + 16 * MiB;
constexpr size_t WS_S0 = WS_H, WS_S1 = WS_H + 32 * MiB, WS_S2 = WS_H + 64 * MiB, WS_S3 = WS_H + 96 * MiB;
constexpr size_t WS_WKT = WS_S3, WS_WVT = WS_S3 + 8 * MiB, WS_MEMN = WS_S3 + 16 * MiB;
constexpr size_t WS_END = WS_H + 128 * MiB;

constexpr int RING_BYTES = 131072, EX_OFF = RING_BYTES, BARST_OFF = RING_BYTES + 8192, PTAB_OFF = BARST_OFF + 64, LDS_BYTES = RING_BYTES + 8192 + 2048;

__device__ __forceinline__ unsigned cvt_pk_bf16(float lo, float hi) { unsigned r; asm volatile("v_cvt_pk_bf16_f32 %0, %1, %2" : "=v"(r) : "v"(lo), "v"(hi)); return r; }
__device__ __forceinline__ float shx(float v, int lane, int o) { return __int_as_float(__builtin_amdgcn_ds_bpermute((lane ^ o) << 2, __float_as_int(v))); }
__device__ __forceinline__ float wave_sum(float v, int lane) {
#pragma unroll
    for (int o = 1; o < 64; o <<= 1) v += shx(v, lane, o);
    return v;
}
template <int CTRL> __device__ __forceinline__ float dpp_mov(float v) { return __int_as_float(__builtin_amdgcn_update_dpp(0, __float_as_int(v), CTRL, 0xf, 0xf, false)); }
__device__ __forceinline__ float wave_sum_dpp(float v) {
    v += dpp_mov<0xB1>(v);
    v += dpp_mov<0x4E>(v);
    v += dpp_mov<0x141>(v);
    v += dpp_mov<0x140>(v);
    const int b = __float_as_int(v);
    return (__int_as_float(__builtin_amdgcn_readlane(b, 0)) + __int_as_float(__builtin_amdgcn_readlane(b, 16))) + (__int_as_float(__builtin_amdgcn_readlane(b, 32)) + __int_as_float(__builtin_amdgcn_readlane(b, 48)));
}
__device__ __forceinline__ float bf_lo(unsigned u) { return __uint_as_float(u << 16); }
__device__ __forceinline__ float bf_hi(unsigned u) { return __uint_as_float(u & 0xffff0000u); }

namespace pg8 {
constexpr int BM = 256, BK = 64, HALF = 128, HTB = HALF * BK * 2, STAGE_BYTES = 8 * HTB, NXCD = 8, WGM = 1;
__host__ __device__ __forceinline__ int lds_byte(int r, int c) { const int st = (r >> 4) * 2 + (c >> 5), rr = r & 15, cc = c & 31, ob = rr * 64 + cc * 2; return st * 1024 + (ob ^ (((ob >> 9) & 1) << 5)); }
__host__ __device__ __forceinline__ void stage_rc(int b, int& R, int& C) { const int st = b / 1024, sb = b % 1024, swz = sb ^ (((sb >> 9) & 1) << 5); R = (st >> 1) * 16 + swz / 64; C = (st & 1) * 32 + (swz % 64) / 2; }
__host__ __device__ __forceinline__ int perm32(int rho) { const int n = rho >> 4, i = rho & 15; return 8 * (i >> 2) + 4 * n + (i & 3); }

struct Unit { int pm, pn; };
struct Gemm { const bf16_t* A; const bf16_t* Bt; int lda, ldb, K; long a_pm, a_pn, b_pn, b_b; };

struct Order {
    int nM, nN, nwg, G, c;
    __device__ __forceinline__ void init(int nM_, int nN_, int G_, int c_) { nM = nM_; nN = nN_; nwg = nM * nN; G = G_; c = c_; }
    __device__ __forceinline__ bool next(int i, Unit& u) const {
        const long L = (long)i * G + c; if (L >= nwg) return false;
        int wgid = (int)L; { const int q = nwg / NXCD, r = nwg % NXCD, xcd = wgid % NXCD, off = wgid / NXCD; wgid = (xcd < r ? xcd * (q + 1) : r * (q + 1) + (xcd - r) * q) + off; }
        const int nig = WGM * nN, gid = wgid / nig, fm = gid * WGM, gsz = (nM - fm) < WGM ? (nM - fm) : WGM;
        u.pm = fm + ((wgid % nig) % gsz); u.pn = (wgid % nig) / gsz; return true;
    }
};


struct EpiBf {
    bf16_t* O; int ldc; const u64* ssq; float cs; int act;
    __device__ __forceinline__ void operator()(f32x4 (&acc)[2][2][4][2], const Unit& u, int wid, int lane_) const {
        int lane; asm volatile("v_mbcnt_lo_u32_b32 %0, -1, 0\n\tv_mbcnt_hi_u32_b32 %0, -1, %0" : "=v"(lane));
        (void)lane_;
        const int wr = wid >> 2, wc = wid & 3, fr = lane & 15, fq = lane >> 4;
        const int row0 = u.pm * BM + wr * 64 + fr, col0 = u.pn * BM + wc * 32 + 8 * fq;
#pragma unroll
        for (int ai = 0; ai < 2; ++ai)
#pragma unroll
            for (int m = 0; m < 4; ++m) {
                const int r = row0 + ai * HALF + m * 16;
                float rs = cs; if (ssq) rs *= rstd_of(ssq[r]);
                bf16_t* rowp = O + (size_t)r * ldc + col0;
#pragma unroll
                for (int bj = 0; bj < 2; ++bj) {
                    f32x4 v0 = acc[ai][bj][m][0] * rs, v1 = acc[ai][bj][m][1] * rs;
                    if (act) {
#pragma unroll
                        for (int j = 0; j < 4; ++j) { const float a = fmaxf(v0[j], 0.f), b = fmaxf(v1[j], 0.f); v0[j] = a * a; v1[j] = b * b; }
                    }
                    u32x4 w; w.x = cvt_pk_bf16(v0[0], v0[1]); w.y = cvt_pk_bf16(v0[2], v0[3]); w.z = cvt_pk_bf16(v1[0], v1[1]); w.w = cvt_pk_bf16(v1[2], v1[3]);
                    *(u32x4*)(rowp + bj * HALF) = w;
                }
            }
    }
};
struct EpiGlu {
    bf16_t* O; const float* bias; const u64* ssq;
    __device__ __forceinline__ void operator()(f32x4 (&acc)[2][2][4][2], const Unit& u, int wid, int lane_) const {
        int lane; asm volatile("v_mbcnt_lo_u32_b32 %0, -1, 0\n\tv_mbcnt_hi_u32_b32 %0, -1, %0" : "=v"(lane));
        (void)lane_;
        const int wr = wid >> 2, wc = wid & 3, fr = lane & 15, fq = lane >> 4;
        const int row0 = u.pm * BM + wr * 64 + fr, ch0 = u.pn * HALF + wc * 32 + 8 * fq;
        f32x4 ba[2], bg[2];
#pragma unroll
        for (int n = 0; n < 2; ++n) { ba[n] = *(const f32x4*)(bias + ch0 + 4 * n); bg[n] = *(const f32x4*)(bias + D + ch0 + 4 * n); }
#pragma unroll
        for (int ai = 0; ai < 2; ++ai)
#pragma unroll
            for (int m = 0; m < 4; ++m) {
                const int r = row0 + ai * HALF + m * 16;
                const float rs = rstd_of(ssq[r]);
                f32x4 o[2];
#pragma unroll
                for (int n = 0; n < 2; ++n) {
                    const f32x4 a = acc[ai][0][m][n] * rs + ba[n], g = acc[ai][1][m][n] * rs + bg[n];
#pragma unroll
                    for (int j = 0; j < 4; ++j) o[n][j] = a[j] * __builtin_amdgcn_rcpf(1.0f + __builtin_amdgcn_exp2f(-g[j] * LOG2E));
                }
                u32x4 w; w.x = cvt_pk_bf16(o[0][0], o[0][1]); w.y = cvt_pk_bf16(o[0][2], o[0][3]); w.z = cvt_pk_bf16(o[1][0], o[1][1]); w.w = cvt_pk_bf16(o[1][2], o[1][3]);
                *(u32x4*)(O + (size_t)r * D + ch0) = w;
            }
    }
};
struct EpiRes {
    bf16_t* xb; const float* bias; u64* ssq_next;
    __device__ __forceinline__ void operator()(f32x4 (&acc)[2][2][4][2], const Unit& u, int wid, int lane_) const {
        int lane; asm volatile("v_mbcnt_lo_u32_b32 %0, -1, 0\n\tv_mbcnt_hi_u32_b32 %0, -1, %0" : "=v"(lane));
        (void)lane_;
        const int wr = wid >> 2, wc = wid & 3, fr = lane & 15, fq = lane >> 4;
        const int row0 = u.pm * BM + wr * 64 + fr, col0 = u.pn * BM + wc * 32 + 8 * fq;
        f32x4 bv[2][2];
#pragma unroll
        for (int bj = 0; bj < 2; ++bj)
#pragma unroll
            for (int n = 0; n < 2; ++n) bv[bj][n] = bias ? *(const f32x4*)(bias + col0 + bj * HALF + 4 * n) : (f32x4){0.f, 0.f, 0.f, 0.f};
#pragma unroll
        for (int ai = 0; ai < 2; ++ai)
#pragma unroll
            for (int m = 0; m < 4; ++m) {
                const int r = row0 + ai * HALF + m * 16; const size_t off = (size_t)r * D + col0;
                float ss = 0.f;
#pragma unroll
                for (int bj = 0; bj < 2; ++bj) {
                    const u32x4 xo = *(const u32x4*)(xb + off + bj * HALF);
                    f32x4 x0 = (f32x4){bf_lo(xo.x), bf_hi(xo.x), bf_lo(xo.y), bf_hi(xo.y)}, x1 = (f32x4){bf_lo(xo.z), bf_hi(xo.z), bf_lo(xo.w), bf_hi(xo.w)};
                    x0 += acc[ai][bj][m][0] + bv[bj][0]; x1 += acc[ai][bj][m][1] + bv[bj][1];
                    u32x4 w; w.x = cvt_pk_bf16(x0[0], x0[1]); w.y = cvt_pk_bf16(x0[2], x0[3]); w.z = cvt_pk_bf16(x1[0], x1[1]); w.w = cvt_pk_bf16(x1[2], x1[3]);
                    *(u32x4*)(xb + off + bj * HALF) = w;
                    x0 = (f32x4){bf_lo(w.x), bf_hi(w.x), bf_lo(w.y), bf_hi(w.y)}; x1 = (f32x4){bf_lo(w.z), bf_hi(w.z), bf_lo(w.w), bf_hi(w.w)};
                    ss += (x0[0] * x0[0] + x0[1] * x0[1]) + (x0[2] * x0[2] + x0[3] * x0[3]) + (x1[0] * x1[0] + x1[1] * x1[1]) + (x1[2] * x1[2] + x1[3] * x1[3]);
                }
                ss += shx(ss, lane, 16); ss += shx(ss, lane, 32);
                if (fq == 0) __hip_atomic_fetch_add(ssq_next + r, (u64)(ss * SSQ_SCALE), __ATOMIC_RELAXED, __HIP_MEMORY_SCOPE_AGENT);
            }
    }
};
struct EpiSoftmax {
    bf16_t* P; LAS f32x2* ex;
    __device__ __forceinline__ void operator()(f32x4 (&acc)[2][2][4][2], const Unit& u, int wid, int lane_) const {
        int lane; asm volatile("v_mbcnt_lo_u32_b32 %0, -1, 0\n\tv_mbcnt_hi_u32_b32 %0, -1, %0" : "=v"(lane));
        (void)lane_;
        const int wr = wid >> 2, wc = wid & 3, fr = lane & 15, fq = lane >> 4;
        const int row0 = u.pm * BM + wr * 64 + fr, col0 = u.pn * BM + wc * 32 + 8 * fq;
        float mxs[2][4];
#pragma unroll
        for (int ai = 0; ai < 2; ++ai)
#pragma unroll
            for (int m = 0; m < 4; ++m) {
                float mx = -3.0e38f;
#pragma unroll
                for (int bj = 0; bj < 2; ++bj)
#pragma unroll
                    for (int n = 0; n < 2; ++n) { const f32x4 v = acc[ai][bj][m][n]; mx = fmaxf(mx, fmaxf(fmaxf(v[0], v[1]), fmaxf(v[2], v[3]))); }
                mx = fmaxf(mx, shx(mx, lane, 16)); mx = fmaxf(mx, shx(mx, lane, 32));
                float l = 0.f;
#pragma unroll
                for (int bj = 0; bj < 2; ++bj)
#pragma unroll
                    for (int n = 0; n < 2; ++n) { f32x4 v = acc[ai][bj][m][n];
#pragma unroll
                        for (int j = 0; j < 4; ++j) { v[j] = __builtin_amdgcn_exp2f((v[j] - mx) * LOG2E); l += v[j]; }
                        acc[ai][bj][m][n] = v; }
                l += shx(l, lane, 16); l += shx(l, lane, 32);
                mxs[ai][m] = mx;
                if (fq == 0) ex[(ai * HALF + wr * 64 + m * 16 + fr) * 4 + wc] = (f32x2){mx, l};
            }
        asm volatile("s_waitcnt lgkmcnt(0)" ::: "memory"); __builtin_amdgcn_s_barrier(); asm volatile("" ::: "memory");
#pragma unroll
        for (int ai = 0; ai < 2; ++ai)
#pragma unroll
            for (int m = 0; m < 4; ++m) {
                const int lr = ai * HALF + wr * 64 + m * 16 + fr;
                const f32x2 a = ex[lr * 4 + 0], b = ex[lr * 4 + 1], c = ex[lr * 4 + 2], d = ex[lr * 4 + 3];
                const float MX = fmaxf(fmaxf(a.x, b.x), fmaxf(c.x, d.x));
                const float L = a.y * __builtin_amdgcn_exp2f((a.x - MX) * LOG2E) + b.y * __builtin_amdgcn_exp2f((b.x - MX) * LOG2E)
                              + c.y * __builtin_amdgcn_exp2f((c.x - MX) * LOG2E) + d.y * __builtin_amdgcn_exp2f((d.x - MX) * LOG2E);
                const float f = __builtin_amdgcn_exp2f((mxs[ai][m] - MX) * LOG2E) / L;
                bf16_t* rowp = P + (size_t)(row0 + ai * HALF + m * 16) * D + col0;
#pragma unroll
                for (int bj = 0; bj < 2; ++bj) {
                    const f32x4 v0 = acc[ai][bj][m][0] * f, v1 = acc[ai][bj][m][1] * f;
                    u32x4 w; w.x = cvt_pk_bf16(v0[0], v0[1]); w.y = cvt_pk_bf16(v0[2], v0[3]); w.z = cvt_pk_bf16(v1[0], v1[1]); w.w = cvt_pk_bf16(v1[2], v1[3]);
                    *(u32x4*)(rowp + bj * HALF) = w;
                }
            }
        asm volatile("s_waitcnt lgkmcnt(0)" ::: "memory"); __builtin_amdgcn_s_barrier(); asm volatile("" ::: "memory");
    }
};

template <int LDSIMM, int GOFF>
__device__ __forceinline__ void glds_s(const char* sbase, unsigned voff, unsigned ldsbase) {
    asm volatile("s_add_u32 m0, %2, %3\n\ts_nop 0\n\tglobal_load_lds_dwordx4 %0, %1 offset:%4" :: "v"(voff), "s"(sbase), "s"(ldsbase), "i"(LDSIMM), "i"(GOFF) : "memory", "m0", "scc");
}
template <class Epi, bool ALIGN_EPI>
__device__ __forceinline__ void gemm_phase(LAS unsigned char* lds, const Gemm g, const Order& S, const Epi& E, const int wid) {
    int lane; asm volatile("v_mbcnt_lo_u32_b32 %0, -1, 0\n\tv_mbcnt_hi_u32_b32 %0, -1, %0" : "=v"(lane));
    const int tid = wid * 64 + lane, wr = wid >> 2, wc = wid & 3, fr = lane & 15, fq = lane >> 4;
    const int nt = g.K / BK;
    unsigned voffA[2], voffB[2];
#pragma unroll
    for (int i = 0; i < 2; ++i) { int R, C; stage_rc(tid * 16 + i * 8192, R, C); const int Rb = (R & ~31) + perm32(R & 31);
        voffA[i] = (unsigned)(R * g.lda + C) * 2u; voffB[i] = (unsigned)(Rb * g.ldb + C) * 2u; }
    const size_t kstep = (size_t)(BK * 2);
    const size_t hstepA = (size_t)HALF * g.lda * 2, hstepB = (size_t)HALF * g.ldb * 2;
    const unsigned ldsbase = (unsigned)(size_t)lds + (unsigned)wid * 1024u;
    const int aoff = lds_byte(wr * 64 + fr, fq * 8), boff = lds_byte(wc * 32 + fr, fq * 8);
#define PG8_SA(b, h) (((b) * 2 + (h)) * HTB)
#define PG8_SB(b, h) ((4 + (b) * 2 + (h)) * HTB)
#define PG8_STAGE(bufoff, gbase, voff) do { glds_s<(bufoff), 0>((const char*)(gbase), (voff)[0], ldsbase); glds_s<(bufoff) + 8192, 0>((const char*)(gbase), (voff)[1], ldsbase); } while (0)
#define PG8_LDA(dst, b, h) do { _Pragma("unroll") for (int m = 0; m < 4; ++m) _Pragma("unroll") for (int k = 0; k < 2; ++k) dst[m][k] = *(const LAS bf16x8*)(lds + PG8_SA(b, h) + aoff + m * 2048 + k * 1024); } while (0)
#define PG8_LDB(dst, b, h) do { _Pragma("unroll") for (int n = 0; n < 2; ++n) _Pragma("unroll") for (int k = 0; k < 2; ++k) dst[n][k] = *(const LAS bf16x8*)(lds + PG8_SB(b, h) + boff + n * 2048 + k * 1024); } while (0)
#define PG8_MMA(ai, bj, At, Bt) do { __builtin_amdgcn_s_setprio(1); _Pragma("unroll") for (int m = 0; m < 4; ++m) _Pragma("unroll") for (int n = 0; n < 2; ++n) _Pragma("unroll") for (int k = 0; k < 2; ++k) \
        acc[ai][bj][m][n] = __builtin_amdgcn_mfma_f32_16x16x32_bf16(Bt[n][k], At[m][k], acc[ai][bj][m][n], 0, 0, 0); __builtin_amdgcn_s_setprio(0); } while (0)
#define PG8_WAIT_V(n) asm volatile("s_waitcnt vmcnt(" #n ")" ::: "memory")
#define PG8_WAIT_L(n) asm volatile("s_waitcnt lgkmcnt(" #n ")" ::: "memory")
#define PG8_BAR __builtin_amdgcn_s_barrier()
#define PG8_SCHED __builtin_amdgcn_sched_barrier(0)
#define PG8_ABASE(u) ((const char*)(g.A + (size_t)(u).pm * g.a_pm + (size_t)(u).pn * g.a_pn))
#define PG8_BBASE(u) ((const char*)(g.Bt + (size_t)(u).pn * g.b_pn + (size_t)((u).pm >> 3) * g.b_b))
    Unit cur, nxt; int ui = 0;
    if (!S.next(0, cur)) return;
    f32x4 acc[2][2][4][2];
#pragma unroll
    for (int a = 0; a < 2; ++a)
#pragma unroll
        for (int b = 0; b < 2; ++b)
#pragma unroll
            for (int m = 0; m < 4; ++m)
#pragma unroll
                for (int n = 0; n < 2; ++n) acc[a][b][m][n] = (f32x4){0.f, 0.f, 0.f, 0.f};
    bf16x8 At[4][2], B0[2][2], B1[2][2];
    const char* cA = PG8_ABASE(cur); const char* cB = PG8_BBASE(cur);
    PG8_STAGE(PG8_SB(0, 0), cB, voffB); PG8_STAGE(PG8_SB(0, 1), cB + hstepB, voffB); PG8_STAGE(PG8_SA(0, 0), cA, voffA); PG8_STAGE(PG8_SA(0, 1), cA + hstepA, voffA);
    if (wr == 1) PG8_BAR;
    PG8_WAIT_V(2); PG8_BAR;
    PG8_STAGE(PG8_SB(1, 0), cB + kstep, voffB); PG8_STAGE(PG8_SA(1, 0), cA + kstep, voffA); PG8_STAGE(PG8_SB(1, 1), cB + hstepB + kstep, voffB);
    PG8_WAIT_V(6); PG8_BAR;
    for (;;) {
        const bool has_next = S.next(ui + 1, nxt);
        const char* nA = has_next ? PG8_ABASE(nxt) : cA; const char* nB = has_next ? PG8_BBASE(nxt) : cB;
        for (int t = 0; t < nt; t += 2) {
            const bool last = (t == nt - 2);
            const char* a1 = cA + (size_t)(t + 1) * kstep;
            const char* a2 = last ? nA : cA + (size_t)(t + 2) * kstep; const char* b2 = last ? nB : cB + (size_t)(t + 2) * kstep;
            const char* a3 = a2 + kstep; const char* b3 = b2 + kstep;
            PG8_LDB(B0, 0, 0); PG8_LDB(B1, 0, 1); PG8_SCHED; PG8_LDA(At, 0, 0); PG8_STAGE(PG8_SA(1, 1), a1 + hstepA, voffA);
            PG8_WAIT_V(8); PG8_WAIT_L(0); PG8_BAR; PG8_MMA(0, 0, At, B0); PG8_MMA(0, 1, At, B1); PG8_BAR; PG8_SCHED;
            PG8_LDA(At, 0, 1); PG8_STAGE(PG8_SB(0, 0), b2, voffB); PG8_STAGE(PG8_SB(0, 1), b2 + hstepB, voffB); PG8_STAGE(PG8_SA(0, 0), a2, voffA);
            PG8_WAIT_V(8); PG8_WAIT_L(0); PG8_BAR; PG8_MMA(1, 0, At, B0); PG8_MMA(1, 1, At, B1); PG8_BAR; PG8_SCHED;
            PG8_LDB(B0, 1, 0); PG8_LDB(B1, 1, 1); PG8_SCHED; PG8_LDA(At, 1, 0); PG8_STAGE(PG8_SA(0, 1), a2 + hstepA, voffA);
            PG8_WAIT_V(8); PG8_WAIT_L(0); PG8_BAR; PG8_MMA(0, 0, At, B0); PG8_MMA(0, 1, At, B1); PG8_BAR; PG8_SCHED;
            PG8_LDA(At, 1, 1); PG8_STAGE(PG8_SB(1, 0), b3, voffB); PG8_STAGE(PG8_SB(1, 1), b3 + hstepB, voffB); PG8_STAGE(PG8_SA(1, 0), a3, voffA);
            PG8_WAIT_V(8); PG8_WAIT_L(0); PG8_BAR; PG8_MMA(1, 0, At, B0); PG8_MMA(1, 1, At, B1); PG8_BAR; PG8_SCHED;
        }
        if constexpr (ALIGN_EPI) { if (wr == 0) PG8_BAR; }
        E(acc, cur, wid, lane);
        if (!has_next) break;
#pragma unroll
        for (int a = 0; a < 2; ++a)
#pragma unroll
            for (int b = 0; b < 2; ++b)
#pragma unroll
                for (int m = 0; m < 4; ++m)
#pragma unroll
                    for (int n = 0; n < 2; ++n) acc[a][b][m][n] = (f32x4){0.f, 0.f, 0.f, 0.f};
        cur = nxt; cA = nA; cB = nB; ++ui;
        if constexpr (ALIGN_EPI) { if (wr == 1) PG8_BAR; }
    }
    PG8_WAIT_V(0);
    if constexpr (!ALIGN_EPI) { if (wr == 0) PG8_BAR; }
    PG8_BAR;
#undef PG8_SA
#undef PG8_SB
#undef PG8_STAGE
#undef PG8_LDA
#undef PG8_LDB
#undef PG8_MMA
#undef PG8_WAIT_V
#undef PG8_WAIT_L
#undef PG8_BAR
#undef PG8_SCHED
#undef PG8_ABASE
#undef PG8_BBASE
}
}

struct TrItem { const float* W; int ldw, src_n0, k0; bf16_t* WT; int ldt, dst_n0; const float* rs; const float* cs; };
__device__ __forceinline__ void tr_load(const TrItem& d, float (&v)[32], int lane) {
    const float* wp = d.W + (size_t)(d.k0 + (lane >> 5)) * d.ldw + d.src_n0 + (lane & 31);
#pragma unroll
    for (int i = 0; i < 32; ++i) v[i] = __builtin_nontemporal_load(wp + (size_t)(2 * i) * d.ldw);
}
__device__ __forceinline__ void tr_finish(const TrItem& d, const float (&v)[32], LAS float* scr, int lane) {
    const float csv = d.cs ? d.cs[d.src_n0 + (lane & 31)] : 1.0f;
#pragma unroll
    for (int i = 0; i < 32; ++i) { const int kk = 2 * i + (lane >> 5); float t = v[i]; if (d.rs) t *= d.rs[d.k0 + kk]; scr[kk * 33 + (lane & 31)] = t * csv; }
    asm volatile("s_waitcnt lgkmcnt(0)" ::: "memory");
    const int c = lane & 7;
#pragma unroll
    for (int j = 0; j < 4; ++j) { const int n = (lane >> 3) + 8 * j; const LAS float* s = scr + (8 * c) * 33 + n;
        u32x4 o; o.x = cvt_pk_bf16(s[0 * 33], s[1 * 33]); o.y = cvt_pk_bf16(s[2 * 33], s[3 * 33]); o.z = cvt_pk_bf16(s[4 * 33], s[5 * 33]); o.w = cvt_pk_bf16(s[6 * 33], s[7 * 33]);
        *(u32x4*)(d.WT + (size_t)(d.dst_n0 + n) * d.ldt + d.k0 + 8 * c) = o; }
    asm volatile("s_waitcnt lgkmcnt(0)" ::: "memory");
}
__device__ __forceinline__ bool conv_mat(int& r, const float* W, int K, int N, bf16_t* WT, const float* rs, const float* cs, bool glu, TrItem& d) {
    const int nblk = N / 32, items = (K / 64) * nblk;
    if (r >= items) { r -= items; return false; }
    const int kb = r / nblk, nb = r % nblk, n0 = nb * 32;
    d.W = W; d.ldw = N; d.src_n0 = glu ? ((n0 >> 8) * 128 + (n0 & 127) + ((n0 >> 7) & 1) * D) : n0; d.k0 = kb * 64; d.WT = WT; d.ldt = K; d.dst_n0 = n0; d.rs = rs; d.cs = cs;
    return true;
}

struct Args { const float* in[23]; float* out; unsigned char* ws; int lo, hi; };
typedef LAS const unsigned long long* PtrTab;
__device__ __forceinline__ const float* inptr(PtrTab tab, int k) {
    const unsigned long long v = tab[k];
    typedef const float __attribute__((address_space(1)))* GPF;
    return (const float*)(GPF)(((unsigned long long)(unsigned)__builtin_amdgcn_readfirstlane((int)(v >> 32)) << 32) | (unsigned long long)(unsigned)__builtin_amdgcn_readfirstlane((int)v));
}
#define INP(k) inptr(tab, (k))

__device__ __forceinline__ void decode_item(PtrTab tab, unsigned char* ws_, int i, int it, TrItem& d) {
    int r = it;
    if (i < 0) { constexpr int I1 = (D / 64) * (D / 32); const int mtx = it / I1, l = mtx & 3; r = it % I1;
        conv_mat(r, (mtx < 4 ? INP(17) : INP(18)) + (size_t)l * D * D, D, D, (bf16_t*)(ws_ + (mtx < 4 ? WS_WKT : WS_WVT)) + (size_t)l * D * D, nullptr, nullptr, false, d); return; }
    unsigned char* lw = ws_ + WS_LW + (size_t)(i & 1) * LW_SET; const int j = i >> 1;
    if (!(i & 1)) {
        if (conv_mat(r, INP(6) + (size_t)j * D * 2 * D, D, 2 * D, (bf16_t*)(lw + LW_WIN), INP(3) + i * D, nullptr, true, d)) return;
        if (conv_mat(r, INP(12) + (size_t)j * D * D, D, D, (bf16_t*)(lw + LW_WOUT), nullptr, nullptr, false, d)) return;
    } else {
        const int g = r >> 5;
        if (g < 4) { r &= 31; conv_mat(r, INP(14) + ((size_t)j * 4 + g) * 65536, 256, 256, (bf16_t*)(lw + LW_WIN) + (size_t)g * 65536, nullptr, INP(15) + j * D + g * 256, false, d); return; }
        r -= 128;
    }
    if (conv_mat(r, INP(16) + (size_t)i * D * D, D, D, (bf16_t*)(lw + LW_WQ), INP(4) + i * D, nullptr, false, d)) return;
    if (conv_mat(r, INP(19) + (size_t)i * D * D, D, D, (bf16_t*)(lw + LW_WO), nullptr, nullptr, false, d)) return;
    if (conv_mat(r, INP(20) + (size_t)i * D * FF, D, FF, (bf16_t*)(lw + LW_W1), INP(5) + i * D, nullptr, false, d)) return;
    conv_mat(r, INP(21) + (size_t)i * FF * D, FF, D, (bf16_t*)(lw + LW_W2), nullptr, nullptr, false, d);
}
__device__ __forceinline__ void convert_job(PtrTab tab, unsigned char* ws_, int i, LAS float* scr, int gw, int NGW, int lane) {
    const int I_MIX = !(i & 1) ? (D / 64) * (2 * D / 32) + (D / 64) * (D / 32) : 4 * (256 / 64) * (256 / 32);
    const int NITEMS = (i < 0) ? 8 * (D / 64) * (D / 32) : I_MIX + 2 * (D / 64) * (D / 32) + 2 * (D / 64) * (FF / 32);
    int it = gw; if (it >= NITEMS) return;
    TrItem d0; float v0[32];
    decode_item(tab, ws_, i, it, d0); tr_load(d0, v0, lane);
    for (;;) {
        const int it2 = it + NGW; const bool has = it2 < NITEMS;
        TrItem d1; float v1[32];
        if (has) { decode_item(tab, ws_, i, it2, d1); tr_load(d1, v1, lane); }
        tr_finish(d0, v0, scr, lane);
        if (!has) break;
        d0 = d1; it = it2;
#pragma unroll
        for (int q = 0; q < 32; ++q) v0[q] = v1[q];
    }
}

__device__ __forceinline__ void dw_phase(const bf16_t* GLU, bf16_t* V, const float* wdw, const float* bdw, const float* lng, const float* lnb, LAS float* red, int bid, int G, int wave) {
    int laneA; asm volatile("v_mbcnt_lo_u32_b32 %0, -1, 0\n\tv_mbcnt_hi_u32_b32 %0, -1, %0" : "=v"(laneA));
    const int tid = wave * 64 + laneA;
    f32x2 wk[CW];
#pragma unroll
    for (int k = 0; k < CW; ++k) wk[k] = *(const f32x2*)(wdw + k * D + 2 * tid);
    const f32x2 bd = *(const f32x2*)(bdw + 2 * tid), lg = *(const f32x2*)(lng + 2 * tid), lb = *(const f32x2*)(lnb + 2 * tid);
    const unsigned* G32 = (const unsigned*)GLU; unsigned* V32 = (unsigned*)V;
    LAS f32x2* part = (LAS f32x2*)red;
    LAS f32x2* stat = (LAS f32x2*)(red + 256);
    const int ustart = (G == 256) ? (bid & 7) * 128 + (bid >> 3) * 4 : bid, ustep = (G == 256) ? 1 : G, uend = (G == 256) ? ustart + 4 : M / 16;
    unsigned raw[46];
    if (ustart < uend) { const int t0 = (ustart & 127) * 16; int vb = (ustart * 16 - 30) * 512 + tid; asm volatile("" : "+v"(vb));
#pragma unroll
        for (int r = 0; r < 46; ++r) raw[r] = (t0 - 30 + r >= 0) ? G32[vb + r * 512] : 0u; }
    for (int unit = ustart; unit < uend; unit += ustep) {
        const int t0 = (unit & 127) * 16, rowbase = unit * 16;
        f32x2 win[46];
#pragma unroll
        for (int r = 0; r < 46; ++r) win[r] = (f32x2){bf_lo(raw[r]), bf_hi(raw[r])};
        f32x2 o[16];
#pragma unroll
        for (int t = 0; t < 16; ++t) { f32x2 a = bd;
#pragma unroll
            for (int k = 0; k < CW; ++k) a = __builtin_elementwise_fma(wk[k], win[t + k], a);
            o[t] = a; }
        if (unit + ustep < uend) { const int nu = unit + ustep, nt0 = (nu & 127) * 16; int vb = (nu * 16 - 30) * 512 + tid; asm volatile("" : "+v"(vb));
#pragma unroll
            for (int r = 0; r < 46; ++r) raw[r] = (nt0 - 30 + r >= 0) ? G32[vb + r * 512] : 0u; }
        int lane; asm volatile("v_mbcnt_lo_u32_b32 %0, -1, 0\n\tv_mbcnt_hi_u32_b32 %0, -1, %0" : "=v"(lane)); const int tidB = wave * 64 + lane;
#pragma unroll
        for (int t = 0; t < 16; ++t) {
            const float s1 = wave_sum_dpp(o[t].x + o[t].y), s2 = wave_sum_dpp(o[t].x * o[t].x + o[t].y * o[t].y);
            if (lane == 0) part[wave * 16 + t] = (f32x2){s1, s2};
        }
        asm volatile("s_waitcnt lgkmcnt(0)" ::: "memory"); __builtin_amdgcn_s_barrier(); asm volatile("" ::: "memory");
        if (tidB < 16) { float s1 = 0.f, s2 = 0.f;
#pragma unroll
            for (int w = 0; w < 8; ++w) { const f32x2 p = part[w * 16 + tidB]; s1 += p.x; s2 += p.y; }
            const float mean = s1 * (1.0f / D), var = fmaxf(s2 * (1.0f / D) - mean * mean, 0.f);
            stat[tidB] = (f32x2){mean, rsqrtf(var + LN_EPS)}; }
        asm volatile("s_waitcnt lgkmcnt(0)" ::: "memory"); __builtin_amdgcn_s_barrier(); asm volatile("" ::: "memory");
#pragma unroll
        for (int t = 0; t < 16; ++t) {
            const f32x2 st = stat[t];
            float y0 = (o[t].x - st.x) * st.y * lg.x + lb.x, y1 = (o[t].y - st.x) * st.y * lg.y + lb.y;
            y0 = y0 * __builtin_amdgcn_rcpf(1.0f + __builtin_amdgcn_exp2f(-y0 * LOG2E)); y1 = y1 * __builtin_amdgcn_rcpf(1.0f + __builtin_amdgcn_exp2f(-y1 * LOG2E));
            V32[(size_t)(rowbase + t) * 512 + tidB] = cvt_pk_bf16(y0, y1);
        }
        asm volatile("s_waitcnt lgkmcnt(0)" ::: "memory"); __builtin_amdgcn_s_barrier(); asm volatile("" ::: "memory");
    }
}

__device__ __forceinline__ float bcast_lane(float v, int k) { return __int_as_float(__builtin_amdgcn_readlane(__float_as_int(v), k)); }
template <int W>
__device__ __forceinline__ void pl_span(const bf16_t* XBs, const u64* ssq, bf16_t* PP, int unit0, int nsub, int tid, int lane, f32x2 g) {
    const unsigned* X32 = (const unsigned*)XBs; unsigned* P32 = (unsigned*)PP;
    const int t0 = (unit0 & 127) * 16, rowbase = unit0 * 16;
    const bool first = (t0 == 0);
    int vb = rowbase * 512 + tid; asm volatile("" : "+v"(vb));
    unsigned xh[W - 1], xc[16];
#pragma unroll
    for (int j = 0; j < W - 1; ++j) xh[j] = X32[vb + (first ? 0 : (j - (W - 1))) * 512];
    const int l5 = lane & 31;
    u64 q = ssq[rowbase + (l5 < 16 ? l5 : (first ? 0 : l5 - 32))];
#pragma unroll
    for (int j = 0; j < 16; ++j) xc[j] = X32[vb + j * 512];
    float rsl = rstd_of(q);
    f32x2 hist[W - 1]; f32x2 S = (f32x2){0.f, 0.f};
#pragma unroll
    for (int j = 0; j < W - 1; ++j) { const float r0 = bcast_lane(rsl, 32 - (W - 1) + j), rs = first ? 0.f : r0; hist[j] = (f32x2){bf_lo(xh[j]) * rs, bf_hi(xh[j]) * rs}; S += hist[j]; }
    constexpr float INVW = 1.0f / (float)W;
    for (int c = 0; c < nsub; ++c) {
        const bool more = (c + 1 < nsub);
        f32x2 ext[W - 1 + 16];
#pragma unroll
        for (int j = 0; j < W - 1; ++j) ext[j] = hist[j];
#pragma unroll
        for (int j = 0; j < 16; ++j) { const float rs = bcast_lane(rsl, j); ext[W - 1 + j] = (f32x2){bf_lo(xc[j]) * rs, bf_hi(xc[j]) * rs}; }
        const bool head = first && c == 0;
#pragma unroll
        for (int j = 0; j < 16; ++j) {
            S += ext[W - 1 + j];
            const float inv = head ? (1.0f / (float)((j + 1 < W) ? j + 1 : W)) : INVW;
            const f32x2 p = (S * inv - ext[W - 1 + j]) * g;
            P32[vb + (16 * c + j) * 512] = cvt_pk_bf16(p.x, p.y);
            S -= ext[j];
        }
#pragma unroll
        for (int j = 0; j < W - 1; ++j) hist[j] = ext[16 + j];
        if (more) {
#pragma unroll
            for (int j = 0; j < 16; ++j) xc[j] = X32[vb + (16 * (c + 1) + j) * 512];
            rsl = rstd_of(ssq[rowbase + 16 * (c + 1) + (lane & 15)]);
        }
    }
}
__device__ __forceinline__ void pl_phase(const bf16_t* X, const u64* ssq, const float* gain, bf16_t* PP, int bid, int G, int wave) {
    int lane; asm volatile("v_mbcnt_lo_u32_b32 %0, -1, 0\n\tv_mbcnt_hi_u32_b32 %0, -1, %0" : "=v"(lane)); const int tid = wave * 64 + lane;
    const f32x2 g = *(const f32x2*)(gain + 2 * tid); const int grp = wave >> 1;
    const int ustart = (G == 256) ? (bid & 7) * 128 + (bid >> 3) * 4 : bid, ustep = (G == 256) ? 4 : G, uend = (G == 256) ? ustart + 4 : M / 16, nsub = (G == 256) ? 4 : 1;
    for (int unit = ustart; unit < uend; unit += ustep) {
        if (grp == 0) pl_span<2>(X, ssq, PP, unit, nsub, tid, lane, g);
        else if (grp == 1) pl_span<4>(X, ssq, PP, unit, nsub, tid, lane, g);
        else if (grp == 2) pl_span<8>(X, ssq, PP, unit, nsub, tid, lane, g);
        else pl_span<16>(X, ssq, PP, unit, nsub, tid, lane, g);
    }
}

#define XB_TMO      128
#define XB_XCNT(j)  (256  + 64 * (j))
#define XB_XSUB(j)  (1280 + 64 * (j))
#define XB_XGEN(j)  (2304 + 64 * (j))
#define XB_TOP      3328
#define XB_TOPGEN   3392
#define XB_LSUB(j)  (3456 + 64 * (j))
#define XB_LGEN(j)  (4480 + 64 * (j))
#define XB_GMASK(j) (5504 + (j))
#define XCD_BAR_WORDS 5632
#define XB_SPIN_CAP (1u << 18)
__device__ __forceinline__ unsigned xb_ld(unsigned* p)              { return __hip_atomic_load(p, __ATOMIC_RELAXED, __HIP_MEMORY_SCOPE_AGENT); }
__device__ __forceinline__ unsigned xb_add(unsigned* p, unsigned v) { return __hip_atomic_fetch_add(p, v, __ATOMIC_RELAXED, __HIP_MEMORY_SCOPE_AGENT); }
__device__ __forceinline__ unsigned xb_xcc_id() { return (unsigned)__builtin_amdgcn_s_getreg((3 << 11) | 20) & 0xFu; }
#define XB_SPIN(cond, bar) do { unsigned _sp = 0; while (cond) { __builtin_amdgcn_s_sleep(1); \
    if ((++_sp & 255u) == 0u) { if (xb_ld(&(bar)[XB_TMO])) break; if (_sp > XB_SPIN_CAP) { atomicAdd(&(bar)[XB_TMO], 1u); break; } } } } while (0)
struct XcdBarrier { unsigned* bar; unsigned x; volatile LAS unsigned* st; };
__device__ __forceinline__ void xcd_barrier_complete(unsigned* bar, unsigned x, unsigned& nloc, unsigned& nx) {
    const unsigned G = gridDim.x * gridDim.y * gridDim.z;
    unsigned sum, cnt, mine, sp = 0u;
    for (;;) {
        sum = 0u; cnt = 0u; mine = 0u;
#pragma unroll
        for (unsigned j = 0; j < 16; ++j) { const unsigned c = xb_ld(&bar[XB_XCNT(j)]); sum += c; cnt += (c > 0u) ? 1u : 0u; mine = (j == x) ? c : mine; }
        if (sum == G) break;
        __builtin_amdgcn_s_sleep(1);
        if ((++sp & 255u) == 0u) { if (xb_ld(&bar[XB_TMO])) break; if (sp > XB_SPIN_CAP) { atomicAdd(&bar[XB_TMO], 1u); break; } }
    }
    nloc = mine > 0u ? mine : 1u; nx = cnt > 0u ? cnt : 1u;
}
__device__ __forceinline__ void xcd_barrier(unsigned* bar_, volatile LAS unsigned* st_) {
    XcdBarrier b; b.bar = bar_; b.st = st_; b.x = xb_xcc_id();
    asm volatile("s_waitcnt vmcnt(0)" ::: "memory");
    __syncthreads();
    if (threadIdx.x == 0) {
        unsigned* bar = b.bar;
        __builtin_amdgcn_s_waitcnt(0);
        unsigned nloc = b.st[0], nx = b.st[1];
        if (nloc == 0u) { xcd_barrier_complete(bar, b.x, nloc, nx); b.st[0] = nloc; b.st[1] = nx; }
        const unsigned old = xb_add(&bar[XB_XSUB(b.x)], 1u);
        const unsigned gen = old / nloc;
        if (old + 1u == (gen + 1u) * nloc) {
            __builtin_amdgcn_fence(__ATOMIC_RELEASE, "agent");
            asm volatile("s_waitcnt vmcnt(0)" ::: "memory");
            const unsigned og = xb_add(&bar[XB_TOP], 1u);
            const unsigned tg = og / nx;
            if (og + 1u == (tg + 1u) * nx) xb_add(&bar[XB_TOPGEN], 1u);
            else XB_SPIN(xb_ld(&bar[XB_TOPGEN]) == tg, bar);
            __builtin_amdgcn_fence(__ATOMIC_ACQUIRE, "agent");
            xb_add(&bar[XB_XGEN(b.x)], 1u);
            asm volatile("s_waitcnt vmcnt(0)" ::: "memory");
        } else {
            XB_SPIN(xb_ld(&bar[XB_XGEN(b.x)]) == gen, bar);
            __builtin_amdgcn_fence(__ATOMIC_ACQUIRE, "agent");
            asm volatile("s_waitcnt vmcnt(0)" ::: "memory");
        }
    }
    __syncthreads();
}

__device__ __forceinline__ void xcd_local_barrier(unsigned* bar, unsigned grp, unsigned nloc) {
    asm volatile("s_waitcnt vmcnt(0)" ::: "memory");
    __syncthreads();
    if (threadIdx.x == 0) {
        __builtin_amdgcn_s_waitcnt(0);
        const unsigned old = xb_add(&bar[XB_LSUB(grp)], 1u);
        const unsigned gen = old / nloc;
        if (old + 1u == (gen + 1u) * nloc) xb_add(&bar[XB_LGEN(grp)], 1u);
        else XB_SPIN(xb_ld(&bar[XB_LGEN(grp)]) == gen, bar);
        __builtin_amdgcn_fence(__ATOMIC_ACQUIRE, "agent");
        asm volatile("s_waitcnt vmcnt(0)" ::: "memory");
    }
    __syncthreads();
}

enum { K_PRO = 0, K_KV, K_G1, K_DW, K_G2, K_PL, K_GP, K_GQ, K_S, K_PV, K_WO, K_UP, K_DOWN, K_FINAL };
constexpr int N_PHASES = 2 + 2 * 17 + 1;
__host__ __device__ __forceinline__ void decode_phase(int ph, int& kind, int& layer) {
    if (ph == 0) { kind = K_PRO; layer = 0; return; }
    if (ph == 1) { kind = K_KV; layer = 0; return; }
    if (ph == N_PHASES - 1) { kind = K_FINAL; layer = 0; return; }
    const int q = ph - 2, pair = q / 17, r = q % 17;
    if (r < 9) { layer = 2 * pair; kind = (r < 3) ? (K_G1 + r) : (K_GQ + (r - 3)); }
    else { layer = 2 * pair + 1; const int s = r - 9; kind = (s < 2) ? (K_PL + s) : (K_GQ + (s - 2)); }
}

__global__ void __launch_bounds__(512, 2) fwd_megakernel(Args args) {
    extern __shared__ __attribute__((aligned(16))) unsigned char lds_raw[];
    LAS unsigned char* lds = (LAS unsigned char*)lds_raw;
    const int G0 = gridDim.x, bid0 = blockIdx.x, bid = bid0;
    const int wave_s = __builtin_amdgcn_readfirstlane(threadIdx.x >> 6);
    unsigned char* ws = args.ws;
    u64* SSQ = (u64*)(ws + WS_SSQ);
    float* X = args.out;
    bf16_t* XB = (bf16_t*)(ws + WS_XB);
    bf16_t* KALL = (bf16_t*)(ws + WS_KALL); bf16_t* VT = (bf16_t*)(ws + WS_VT);
    bf16_t* S0 = (bf16_t*)(ws + WS_S0); bf16_t* S1 = (bf16_t*)(ws + WS_S1); bf16_t* S2 = (bf16_t*)(ws + WS_S2); bf16_t* HM = (bf16_t*)(ws + WS_H);
    LAS float* exf = (LAS float*)(lds + EX_OFF);
    if (threadIdx.x < 4) ((volatile LAS unsigned*)(lds + BARST_OFF))[threadIdx.x] = 0u;
    if (threadIdx.x == 0) {
#pragma unroll
        for (int k = 0; k < 23; ++k) ((LAS unsigned long long*)(lds + PTAB_OFF))[k] = (unsigned long long)args.in[k];
    }
    __syncthreads();
    PtrTab tab = (PtrTab)(lds + PTAB_OFF);
    if (threadIdx.x == 0) {
        unsigned* bar0 = (unsigned*)(args.ws + WS_BAR); const unsigned x = xb_xcc_id();
        (void)xb_add(bar0 + XB_XCNT(x), 1u); (void)__hip_atomic_fetch_or(bar0 + XB_GMASK(bid & 7), 1u << x, __ATOMIC_RELAXED, __HIP_MEMORY_SCOPE_AGENT);
    }
    if (args.lo < 0) cg::this_grid().sync();

#pragma unroll 1
    for (int ph = args.lo; ph < args.hi; ++ph) {
        int G = G0, bid = bid0, wave = wave_s; asm volatile("" : "+s"(G), "+s"(bid), "+s"(wave));
        const int gw = bid * 8 + wave, NGW = G * 8;
        LAS float* scr = (LAS float*)(lds + wave * 16384);
        int kind, i; decode_phase(ph, kind, i);
        if (ph >= LAST_PH && ph < N_PHASES - 1) kind = -1;
        const int j = i >> 1;
        unsigned char* lw = ws + WS_LW + (size_t)(i & 1) * LW_SET;
        switch (kind) {
        case K_PRO: {
            int lane; asm volatile("v_mbcnt_lo_u32_b32 %0, -1, 0\n\tv_mbcnt_hi_u32_b32 %0, -1, %0" : "=v"(lane)); const int tid = wave * 64 + lane; (void)tid;
            { unsigned z = 0u; asm volatile("" : "+v"(z));
              for (int u = bid * 512 + tid; u < 12 * M / 2; u += G * 512) ((u32x4*)(SSQ + M))[u] = (u32x4){z, z, z, z}; }
            convert_job(tab, ws, -1, scr, gw, NGW, lane);
            for (int m = gw; m < MEMR; m += NGW) {
                const f32x4* xr = (const f32x4*)(INP(1) + (size_t)m * D) + lane; f32x4 v[4]; float s = 0.f;
#pragma unroll
                for (int q = 0; q < 4; ++q) { v[q] = __builtin_nontemporal_load(xr + 64 * q); s += (v[q].x * v[q].x + v[q].y * v[q].y) + (v[q].z * v[q].z + v[q].w * v[q].w); }
                const float rs = rsqrtf(wave_sum(s, lane) * (1.0f / D) + RMS_EPS);
                u32x2* o8 = (u32x2*)((bf16_t*)(ws + WS_MEMN) + (size_t)m * D) + lane;
#pragma unroll
                for (int q = 0; q < 4; ++q) { const f32x4 gq = ((const f32x4*)INP(2))[lane + 64 * q]; u32x2 w; w.x = cvt_pk_bf16(v[q].x * rs * gq.x, v[q].y * rs * gq.y); w.y = cvt_pk_bf16(v[q].z * rs * gq.z, v[q].w * rs * gq.w); o8[64 * q] = w; }
            }
            const int m0 = (G == 256) ? (bid & 7) * SEQ + (bid >> 3) * 8 + wave : gw, mstep = (G == 256) ? 256 : NGW, mend = (G == 256) ? ((bid & 7) + 1) * SEQ : M;
            for (int m = m0; m < mend; m += mstep) {
                const f32x4* xr = (const f32x4*)(INP(0) + (size_t)m * D) + lane; f32x4 v[4]; float s = 0.f;
                u32x2* o8 = (u32x2*)(XB + (size_t)m * D) + lane;
#pragma unroll
                for (int q = 0; q < 4; ++q) { v[q] = __builtin_nontemporal_load(xr + 64 * q); u32x2 w; w.x = cvt_pk_bf16(v[q].x, v[q].y); w.y = cvt_pk_bf16(v[q].z, v[q].w); o8[64 * q] = w;
                    const float a = bf_lo(w.x), b = bf_hi(w.x), c = bf_lo(w.y), d = bf_hi(w.y); s += (a * a + b * b) + (c * c + d * d); }
                s = wave_sum(s, lane);
                if (lane == 0) SSQ[m] = (u64)(s * SSQ_SCALE);
            }
            convert_job(tab, ws, 0, scr, gw, NGW, lane);
        } break;
        case K_KV: {
            {
                pg8::Gemm g{(const bf16_t*)(ws + WS_MEMN), (const bf16_t*)(ws + WS_WKT), D, D, D, 256L * D, 0, 256L * D, 0};
                pg8::Order S; S.init(MEMR / 256, 4 * D / 256, G, bid);
                pg8::EpiBf E{KALL, 4 * D, nullptr, 1.0f, 0};
                pg8::gemm_phase<pg8::EpiBf, true>(lds, g, S, E, wave);
            }
            {
                pg8::Gemm g{(const bf16_t*)(ws + WS_WVT), (const bf16_t*)(ws + WS_MEMN), D, D, D, 256L * D, 0, 256L * D, 0};
                pg8::Order S; S.init(4 * D / 256, MEMR / 256, G, (bid + G / 2) % G);
                pg8::EpiBf E{VT, MEMR, nullptr, 1.0f, 0};
                pg8::gemm_phase<pg8::EpiBf, true>(lds, g, S, E, wave);
            }
        } break;
        case K_G1: {
            pg8::Gemm g{XB, (const bf16_t*)(lw + LW_WIN), D, D, D, 256L * D, 0, 256L * D, 0};
            pg8::Order S; S.init(M / 256, 2 * D / 256, G, bid);
            pg8::EpiGlu E{S0, INP(7) + j * 2 * D, SSQ + (size_t)(3 * i) * M};
            pg8::gemm_phase<pg8::EpiGlu, true>(lds, g, S, E, wave);
        } break;
        case K_DW: {
            dw_phase(S0, S1, INP(8) + (size_t)j * CW * D, INP(9) + j * D, INP(10) + j * D, INP(11) + j * D, exf, bid, G, wave);
        } break;
        case K_PL: {
            pl_phase(XB, SSQ + (size_t)(3 * i) * M, INP(3) + i * D, S0, bid, G, wave);
        } break;
        case K_G2: case K_GP: case K_WO: case K_DOWN: {
            pg8::Gemm g; pg8::EpiRes E; E.xb = XB; E.bias = nullptr;
            if (kind == K_G2) { g = pg8::Gemm{S1, (const bf16_t*)(lw + LW_WOUT), D, D, D, 256L * D, 0, 256L * D, 0}; E.bias = INP(13) + j * D; E.ssq_next = SSQ + (size_t)(3 * i + 1) * M; }
            else if (kind == K_GP) { g = pg8::Gemm{S0, (const bf16_t*)(lw + LW_WIN), D, 256, 256, 256L * D, 256, 65536, 0}; E.ssq_next = SSQ + (size_t)(3 * i + 1) * M; }
            else if (kind == K_WO) { g = pg8::Gemm{S2, (const bf16_t*)(lw + LW_WO), D, D, D, 256L * D, 0, 256L * D, 0}; E.ssq_next = SSQ + (size_t)(3 * i + 2) * M; }
            else { g = pg8::Gemm{HM, (const bf16_t*)(lw + LW_W2), FF, FF, FF, 256L * FF, 0, 256L * FF, 0}; E.ssq_next = SSQ + (size_t)(3 * i + 3) * M; }
            pg8::Order S; S.init(M / 256, D / 256, G, bid);
            pg8::gemm_phase<pg8::EpiRes, true>(lds, g, S, E, wave);
        } break;
        case K_GQ: case K_UP: case K_PV: {
            pg8::Gemm g; pg8::EpiBf E; int nN = D / 256;
            if (kind == K_GQ) { g = pg8::Gemm{XB, (const bf16_t*)(lw + LW_WQ), D, D, D, 256L * D, 0, 256L * D, 0}; E = pg8::EpiBf{S0, D, SSQ + (size_t)(3 * i + 1) * M, 0.0625f, 0}; }
            else if (kind == K_UP) { g = pg8::Gemm{XB, (const bf16_t*)(lw + LW_W1), D, D, D, 256L * D, 0, 256L * D, 0}; E = pg8::EpiBf{HM, FF, SSQ + (size_t)(3 * i + 2) * M, 1.0f, 1}; nN = FF / 256; }
            else { g = pg8::Gemm{S1, VT + (size_t)i * D * MEMR, D, MEMR, 256, 256L * D, 256, 256L * MEMR, 256}; E = pg8::EpiBf{S2, D, nullptr, 1.0f, 0}; }
            pg8::Order S; S.init(M / 256, nN, G, bid);
            pg8::gemm_phase<pg8::EpiBf, true>(lds, g, S, E, wave);
            if (kind == K_PV && i + 1 < 4) { int lane2; asm volatile("v_mbcnt_lo_u32_b32 %0, -1, 0\n\tv_mbcnt_hi_u32_b32 %0, -1, %0" : "=v"(lane2));
                convert_job(tab, ws, i + 1, scr, gw, NGW, lane2); }
        } break;
        case K_S: {
            pg8::Gemm g{S0, KALL + (size_t)i * D, D, 4 * D, 256, 256L * D, 256, 256, 256L * 4 * D};
            pg8::Order S; S.init(M / 256, D / 256, G, bid);
            pg8::EpiSoftmax E{S1, (LAS f32x2*)exf};
            pg8::gemm_phase<pg8::EpiSoftmax, true>(lds, g, S, E, wave);
        } break;
        case K_FINAL: {
            int lane; asm volatile("v_mbcnt_lo_u32_b32 %0, -1, 0\n\tv_mbcnt_hi_u32_b32 %0, -1, %0" : "=v"(lane)); const int tid = wave * 64 + lane; (void)tid;
            const int m0 = (G == 256) ? (bid & 7) * SEQ + (bid >> 3) * 8 + wave : gw, mstep = (G == 256) ? 256 : NGW, mend = (G == 256) ? ((bid & 7) + 1) * SEQ : M;
            for (int m = m0; m < mend; m += mstep) {
                f32x4* xr = (f32x4*)(X + (size_t)m * D) + lane; const u32x2* xi = (const u32x2*)(XB + (size_t)m * D) + lane; f32x4 v[4]; float s = 0.f;
#pragma unroll
                for (int q = 0; q < 4; ++q) { const u32x2 w = xi[64 * q]; v[q] = (f32x4){bf_lo(w.x), bf_hi(w.x), bf_lo(w.y), bf_hi(w.y)}; s += (v[q].x * v[q].x + v[q].y * v[q].y) + (v[q].z * v[q].z + v[q].w * v[q].w); }
                const float rs = rsqrtf(wave_sum(s, lane) * (1.0f / D) + RMS_EPS);
#pragma unroll
                for (int q = 0; q < 4; ++q) { const f32x4 gq = ((const f32x4*)INP(22))[lane + 64 * q]; f32x4 o = v[q] * rs; o.x *= gq.x; o.y *= gq.y; o.z *= gq.z; o.w *= gq.w; __builtin_nontemporal_store(o, xr + 64 * q); }
            }
        } break;
        }
        if (ph + 1 < args.hi) {
            unsigned* bar = (unsigned*)(args.ws + WS_BAR); volatile LAS unsigned* st = (volatile LAS unsigned*)(lds + BARST_OFF);
            if (kind == K_GQ || kind == K_S) {
                asm volatile("s_waitcnt vmcnt(0)" ::: "memory"); __syncthreads();
                if (threadIdx.x == 0) { __builtin_amdgcn_fence(__ATOMIC_ACQUIRE, "agent"); asm volatile("s_waitcnt vmcnt(0)" ::: "memory"); }
                __syncthreads();
            } else if (ph <= 1 || (kind == K_DOWN && i < 3) || st[2] != 1u) {
                xcd_barrier(bar, st);
                if (ph == 1) {
                    if (threadIdx.x == 0) { bool pure = (G == 256 && st[0] == 32u && st[1] == 8u);
#pragma unroll
                        for (int g8 = 0; g8 < 8; ++g8) pure = pure && (__builtin_popcount(xb_ld(bar + XB_GMASK(g8))) == 1);
                        st[2] = (pure && !FORCE_FALLBACK) ? 1u : 2u; }
                    __syncthreads();
                }
            } else xcd_local_barrier(bar, (unsigned)(bid & 7), 32u);
        }
    }
}

extern "C" void kernel_launch(void* const* d_in, const int* in_sizes, int n_in, void* d_out, int out_size, void* d_ws, size_t ws_size, hipStream_t stream) {
    static int grid = 0;
    if (grid == 0) {
        if (n_in != 23 || out_size != M * D || ws_size < WS_END) { fprintf(stderr, "kernel_launch: unexpected problem (n_in %d out %d ws %zu)\n", n_in, out_size, ws_size); grid = -1; return; }
        int dev = 0, cus = 0, per_cu = 0;
        hipGetDevice(&dev); hipDeviceGetAttribute(&cus, hipDeviceAttributeMultiprocessorCount, dev);
        hipFuncSetAttribute((const void*)fwd_megakernel, hipFuncAttributeMaxDynamicSharedMemorySize, LDS_BYTES);
        if (hipOccupancyMaxActiveBlocksPerMultiprocessor(&per_cu, (const void*)fwd_megakernel, 512, LDS_BYTES) != hipSuccess || per_cu < 1) { fprintf(stderr, "kernel_launch: occupancy query gave %d\n", per_cu); per_cu = 1; }
        (void)hipGetLastError();
        grid = cus * per_cu;
    }
    if (grid < 0) return;
    (void)hipMemsetAsync((unsigned char*)d_ws + WS_BAR, 0, XCD_BAR_WORDS * 4, stream);
    Args a{};
    for (int i = 0; i < 23; ++i) a.in[i] = (const float*)d_in[i];
    a.out = (float*)d_out; a.ws = (unsigned char*)d_ws;
#if MK_PER_PHASE
    for (int ph = 0; ph < N_PHASES; ++ph) { a.lo = ph; a.hi = ph + 1; hipLaunchKernelGGL(fwd_megakernel, dim3(grid), dim3(512), LDS_BYTES, stream, a); }
#else
    a.lo = 0; a.hi = N_PHASES;
    void* kargs[] = {&a};
    hipError_t e = hipLaunchCooperativeKernel((const void*)fwd_megakernel, dim3(grid), dim3(512), kargs, LDS_BYTES, stream);
    if (e != hipSuccess) fprintf(stderr, "cooperative launch failed: %s (grid %d)\n", hipGetErrorString(e), grid);
#endif
}
```

```cpp
#include <hip/hip_runtime.h>
#include <hip/hip_cooperative_groups.h>
#include <cstdio>
#include <cstdint>
namespace cg = cooperative_groups;

#ifndef MK_PER_PHASE
#define MK_PER_PHASE 0
#endif

#ifndef LAST_PH
#define LAST_PH 99
#endif
#ifndef FORCE_FALLBACK
#define FORCE_FALLBACK 0
#endif
#define LAS __attribute__((address_space(3)))
typedef unsigned short bf16_t;
typedef short bf16x8 __attribute__((ext_vector_type(8)));
typedef float f32x4 __attribute__((ext_vector_type(4)));
typedef float f32x2 __attribute__((ext_vector_type(2)));
typedef unsigned u32x4 __attribute__((ext_vector_type(4)));
typedef unsigned u32x2 __attribute__((ext_vector_type(2)));

constexpr int D = 1024, NB = 8, SEQ = 2048, M = NB * SEQ, FF = 4096, MEML = 256, MEMR = NB * MEML, CW = 31;
constexpr float RMS_EPS = 1e-6f, LN_EPS = 1e-5f;
constexpr float LOG2E = 1.4426950408889634f;
typedef unsigned long long u64;
constexpr float SSQ_SCALE = 1048576.0f, SSQ_INV = 1.0f / (1048576.0f * 1024.0f);
__device__ __forceinline__ float rstd_of(u64 q) { return rsqrtf((float)q * SSQ_INV + 1e-6f); }

constexpr size_t MiB = 1u << 20;
constexpr size_t WS_SSQ = 0;
constexpr size_t WS_BAR = 2 * MiB - 32768;
constexpr size_t WS_LW = 2 * MiB;
constexpr size_t LW_SET = 26 * MiB;
constexpr size_t LW_WIN = 0, LW_WOUT = 4 * MiB, LW_WQ = 6 * MiB, LW_WO = 8 * MiB, LW_W1 = 10 * MiB, LW_W2 = 18 * MiB;
constexpr size_t WS_XB = WS_LW + 2 * LW_SET;
constexpr size_t WS_KALL = WS_XB + 32 * MiB;
constexpr size_t WS_VT = WS_KALL + 16 * MiB;
constexpr size_t WS_H = WS_VT + 16 * MiB;
constexpr size_t WS_S0 = WS_H, WS_S1 = WS_H + 32 * MiB, WS_S2 = WS_H + 64 * MiB, WS_S3 = WS_H + 96 * MiB;
constexpr size_t WS_WKT = WS_S3, WS_WVT = WS_S3 + 8 * MiB, WS_MEMN = WS_S3 + 16 * MiB;
constexpr size_t WS_END = WS_H + 128 * MiB;

constexpr int RING_BYTES = 131072, EX_OFF = RING_BYTES, BARST_OFF = RING_BYTES + 8192, PTAB_OFF = BARST_OFF + 64, LDS_BYTES = RING_BYTES + 8192 + 2048;

__device__ __forceinline__ unsigned cvt_pk_bf16(float lo, float hi) { unsigned r; asm volatile("v_cvt_pk_bf16_f32 %0, %1, %2" : "=v"(r) : "v"(lo), "v"(hi)); return r; }
__device__ __forceinline__ float shx(float v, int lane, int o) { return __int_as_float(__builtin_amdgcn_ds_bpermute((lane ^ o) << 2, __float_as_int(v))); }
__device__ __forceinline__ float wave_sum(float v, int lane) {
#pragma unroll
    for (int o = 1; o < 64; o <<= 1) v += shx(v, lane, o);
    return v;
}
template <int CTRL> __device__ __forceinline__ float dpp_mov(float v) { return __int_as_float(__builtin_amdgcn_update_dpp(0, __float_as_int(v), CTRL, 0xf, 0xf, false)); }
__device__ __forceinline__ float row_sum_dpp(float v) {
    v += dpp_mov<0xB1>(v); v += dpp_mov<0x4E>(v); v += dpp_mov<0x141>(v); v += dpp_mov<0x140>(v);
    return v;
}
__device__ __forceinline__ float wave_sum_dpp(float v) {
    v += dpp_mov<0xB1>(v);
    v += dpp_mov<0x4E>(v);
    v += dpp_mov<0x141>(v);
    v += dpp_mov<0x140>(v);
    const int b = __float_as_int(v);
    return (__int_as_float(__builtin_amdgcn_readlane(b, 0)) + __int_as_float(__builtin_amdgcn_readlane(b, 16))) + (__int_as_float(__builtin_amdgcn_readlane(b, 32)) + __int_as_float(__builtin_amdgcn_readlane(b, 48)));
}
__device__ __forceinline__ float bf_lo(unsigned u) { return __uint_as_float(u << 16); }
__device__ __forceinline__ float bf_hi(unsigned u) { return __uint_as_float(u & 0xffff0000u); }

namespace pg8 {
constexpr int BM = 256, BK = 64, HALF = 128, HTB = HALF * BK * 2, STAGE_BYTES = 8 * HTB, NXCD = 8, WGM = 1;
__host__ __device__ __forceinline__ int lds_byte(int r, int c) { const int st = (r >> 4) * 2 + (c >> 5), rr = r & 15, cc = c & 31, ob = rr * 64 + cc * 2; return st * 1024 + (ob ^ (((ob >> 9) & 1) << 5)); }
__host__ __device__ __forceinline__ void stage_rc(int b, int& R, int& C) { const int st = b / 1024, sb = b % 1024, swz = sb ^ (((sb >> 9) & 1) << 5); R = (st >> 1) * 16 + swz / 64; C = (st & 1) * 32 + (swz % 64) / 2; }
__host__ __device__ __forceinline__ int perm32(int rho) { const int n = rho >> 4, i = rho & 15; return 8 * (i >> 2) + 4 * n + (i & 3); }

struct Unit { int pm, pn; };
struct Gemm { const bf16_t* A; const bf16_t* Bt; int lda, ldb, K; long a_pm, a_pn, b_pn, b_b; };

struct Order {
    int nM, nN, nwg, G, c;
    __device__ __forceinline__ void init(int nM_, int nN_, int G_, int c_) { nM = nM_; nN = nN_; nwg = nM * nN; G = G_; c = c_; }
    __device__ __forceinline__ bool next(int i, Unit& u) const {
        const long L = (long)i * G + c; if (L >= nwg) return false;
        int wgid = (int)L; { const int q = nwg / NXCD, r = nwg % NXCD, xcd = wgid % NXCD, off = wgid / NXCD; wgid = (xcd < r ? xcd * (q + 1) : r * (q + 1) + (xcd - r) * q) + off; }
        const int nig = WGM * nN, gid = wgid / nig, fm = gid * WGM, gsz = (nM - fm) < WGM ? (nM - fm) : WGM;
        u.pm = fm + ((wgid % nig) % gsz); u.pn = (wgid % nig) / gsz; return true;
    }
};


struct EpiBf {
    bf16_t* O; int ldc; const u64* ssq; float cs; int act;
    __device__ __forceinline__ void operator()(f32x4 (&acc)[2][2][4][2], const Unit& u, int wid, int lane_) const {
        int lane; asm volatile("v_mbcnt_lo_u32_b32 %0, -1, 0\n\tv_mbcnt_hi_u32_b32 %0, -1, %0" : "=v"(lane));
        (void)lane_;
        const int wr = wid >> 2, wc = wid & 3, fr = lane & 15, fq = lane >> 4;
        const int row0 = u.pm * BM + wr * 64 + fr, col0 = u.pn * BM + wc * 32 + 8 * fq;
#pragma unroll
        for (int ai = 0; ai < 2; ++ai)
#pragma unroll
            for (int m = 0; m < 4; ++m) {
                const int r = row0 + ai * HALF + m * 16;
                float rs = cs; if (ssq) rs *= rstd_of(ssq[r]);
                bf16_t* rowp = O + (size_t)r * ldc + col0;
#pragma unroll
                for (int bj = 0; bj < 2; ++bj) {
                    f32x4 v0 = acc[ai][bj][m][0] * rs, v1 = acc[ai][bj][m][1] * rs;
                    if (act) {
#pragma unroll
                        for (int j = 0; j < 4; ++j) { const float a = fmaxf(v0[j], 0.f), b = fmaxf(v1[j], 0.f); v0[j] = a * a; v1[j] = b * b; }
                    }
                    u32x4 w; w.x = cvt_pk_bf16(v0[0], v0[1]); w.y = cvt_pk_bf16(v0[2], v0[3]); w.z = cvt_pk_bf16(v1[0], v1[1]); w.w = cvt_pk_bf16(v1[2], v1[3]);
                    *(u32x4*)(rowp + bj * HALF) = w;
                }
            }
    }
};
struct EpiGlu {
    bf16_t* O; const float* bias; const u64* ssq;
    __device__ __forceinline__ void operator()(f32x4 (&acc)[2][2][4][2], const Unit& u, int wid, int lane_) const {
        int lane; asm volatile("v_mbcnt_lo_u32_b32 %0, -1, 0\n\tv_mbcnt_hi_u32_b32 %0, -1, %0" : "=v"(lane));
        (void)lane_;
        const int wr = wid >> 2, wc = wid & 3, fr = lane & 15, fq = lane >> 4;
        const int row0 = u.pm * BM + wr * 64 + fr, ch0 = u.pn * HALF + wc * 32 + 8 * fq;
        f32x4 ba[2], bg[2];
#pragma unroll
        for (int n = 0; n < 2; ++n) { ba[n] = *(const f32x4*)(bias + ch0 + 4 * n); bg[n] = *(const f32x4*)(bias + D + ch0 + 4 * n); }
#pragma unroll
        for (int ai = 0; ai < 2; ++ai)
#pragma unroll
            for (int m = 0; m < 4; ++m) {
                const int r = row0 + ai * HALF + m * 16;
                const float rs = rstd_of(ssq[r]);
                f32x4 o[2];
#pragma unroll
                for (int n = 0; n < 2; ++n) {
                    const f32x4 a = acc[ai][0][m][n] * rs + ba[n], g = acc[ai][1][m][n] * rs + bg[n];
#pragma unroll
                    for (int j = 0; j < 4; ++j) o[n][j] = a[j] * __builtin_amdgcn_rcpf(1.0f + __builtin_amdgcn_exp2f(-g[j] * LOG2E));
                }
                u32x4 w; w.x = cvt_pk_bf16(o[0][0], o[0][1]); w.y = cvt_pk_bf16(o[0][2], o[0][3]); w.z = cvt_pk_bf16(o[1][0], o[1][1]); w.w = cvt_pk_bf16(o[1][2], o[1][3]);
                *(u32x4*)(O + (size_t)r * D + ch0) = w;
            }
    }
};
struct EpiRes {
    bf16_t* xb; const float* bias; u64* ssq_next;
    __device__ __forceinline__ void operator()(f32x4 (&acc)[2][2][4][2], const Unit& u, int wid, int lane_) const {
        int lane; asm volatile("v_mbcnt_lo_u32_b32 %0, -1, 0\n\tv_mbcnt_hi_u32_b32 %0, -1, %0" : "=v"(lane));
        (void)lane_;
        const int wr = wid >> 2, wc = wid & 3, fr = lane & 15, fq = lane >> 4;
        const int row0 = u.pm * BM + wr * 64 + fr, col0 = u.pn * BM + wc * 32 + 8 * fq;
        f32x4 bv[2][2];
#pragma unroll
        for (int bj = 0; bj < 2; ++bj)
#pragma unroll
            for (int n = 0; n < 2; ++n) bv[bj][n] = bias ? *(const f32x4*)(bias + col0 + bj * HALF + 4 * n) : (f32x4){0.f, 0.f, 0.f, 0.f};
#pragma unroll
        for (int ai = 0; ai < 2; ++ai)
#pragma unroll
            for (int m = 0; m < 4; ++m) {
                const int r = row0 + ai * HALF + m * 16; const size_t off = (size_t)r * D + col0;
                float ss = 0.f;
#pragma unroll
                for (int bj = 0; bj < 2; ++bj) {
                    const u32x4 xo = *(const u32x4*)(xb + off + bj * HALF);
                    f32x4 x0 = (f32x4){bf_lo(xo.x), bf_hi(xo.x), bf_lo(xo.y), bf_hi(xo.y)}, x1 = (f32x4){bf_lo(xo.z), bf_hi(xo.z), bf_lo(xo.w), bf_hi(xo.w)};
                    x0 += acc[ai][bj][m][0] + bv[bj][0]; x1 += acc[ai][bj][m][1] + bv[bj][1];
                    u32x4 w; w.x = cvt_pk_bf16(x0[0], x0[1]); w.y = cvt_pk_bf16(x0[2], x0[3]); w.z = cvt_pk_bf16(x1[0], x1[1]); w.w = cvt_pk_bf16(x1[2], x1[3]);
                    *(u32x4*)(xb + off + bj * HALF) = w;
                    x0 = (f32x4){bf_lo(w.x), bf_hi(w.x), bf_lo(w.y), bf_hi(w.y)}; x1 = (f32x4){bf_lo(w.z), bf_hi(w.z), bf_lo(w.w), bf_hi(w.w)};
                    ss += (x0[0] * x0[0] + x0[1] * x0[1]) + (x0[2] * x0[2] + x0[3] * x0[3]) + (x1[0] * x1[0] + x1[1] * x1[1]) + (x1[2] * x1[2] + x1[3] * x1[3]);
                }
                ss += shx(ss, lane, 16); ss += shx(ss, lane, 32);
                if (fq == 0) __hip_atomic_fetch_add(ssq_next + r, (u64)(ss * SSQ_SCALE), __ATOMIC_RELAXED, __HIP_MEMORY_SCOPE_AGENT);
            }
    }
};
struct EpiSoftmax {
    bf16_t* P; LAS f32x2* ex;
    __device__ __forceinline__ void operator()(f32x4 (&acc)[2][2][4][2], const Unit& u, int wid, int lane_) const {
        int lane; asm volatile("v_mbcnt_lo_u32_b32 %0, -1, 0\n\tv_mbcnt_hi_u32_b32 %0, -1, %0" : "=v"(lane));
        (void)lane_;
        const int wr = wid >> 2, wc = wid & 3, fr = lane & 15, fq = lane >> 4;
        const int row0 = u.pm * BM + wr * 64 + fr, col0 = u.pn * BM + wc * 32 + 8 * fq;
        float mxs[2][4];
#pragma unroll
        for (int ai = 0; ai < 2; ++ai)
#pragma unroll
            for (int m = 0; m < 4; ++m) {
                float mx = -3.0e38f;
#pragma unroll
                for (int bj = 0; bj < 2; ++bj)
#pragma unroll
                    for (int n = 0; n < 2; ++n) { const f32x4 v = acc[ai][bj][m][n]; mx = fmaxf(mx, fmaxf(fmaxf(v[0], v[1]), fmaxf(v[2], v[3]))); }
                mx = fmaxf(mx, shx(mx, lane, 16)); mx = fmaxf(mx, shx(mx, lane, 32));
                float l = 0.f;
#pragma unroll
                for (int bj = 0; bj < 2; ++bj)
#pragma unroll
                    for (int n = 0; n < 2; ++n) { f32x4 v = acc[ai][bj][m][n];
#pragma unroll
                        for (int j = 0; j < 4; ++j) { v[j] = __builtin_amdgcn_exp2f((v[j] - mx) * LOG2E); l += v[j]; }
                        acc[ai][bj][m][n] = v; }
                l += shx(l, lane, 16); l += shx(l, lane, 32);
                mxs[ai][m] = mx;
                if (fq == 0) ex[(ai * HALF + wr * 64 + m * 16 + fr) * 4 + wc] = (f32x2){mx, l};
            }
        asm volatile("s_waitcnt lgkmcnt(0)" ::: "memory"); __builtin_amdgcn_s_barrier(); asm volatile("" ::: "memory");
#pragma unroll
        for (int ai = 0; ai < 2; ++ai)
#pragma unroll
            for (int m = 0; m < 4; ++m) {
                const int lr = ai * HALF + wr * 64 + m * 16 + fr;
                const f32x2 a = ex[lr * 4 + 0], b = ex[lr * 4 + 1], c = ex[lr * 4 + 2], d = ex[lr * 4 + 3];
                const float MX = fmaxf(fmaxf(a.x, b.x), fmaxf(c.x, d.x));
                const float L = a.y * __builtin_amdgcn_exp2f((a.x - MX) * LOG2E) + b.y * __builtin_amdgcn_exp2f((b.x - MX) * LOG2E)
                              + c.y * __builtin_amdgcn_exp2f((c.x - MX) * LOG2E) + d.y * __builtin_amdgcn_exp2f((d.x - MX) * LOG2E);
                const float f = __builtin_amdgcn_exp2f((mxs[ai][m] - MX) * LOG2E) / L;
                bf16_t* rowp = P + (size_t)(row0 + ai * HALF + m * 16) * D + col0;
#pragma unroll
                for (int bj = 0; bj < 2; ++bj) {
                    const f32x4 v0 = acc[ai][bj][m][0] * f, v1 = acc[ai][bj][m][1] * f;
                    u32x4 w; w.x = cvt_pk_bf16(v0[0], v0[1]); w.y = cvt_pk_bf16(v0[2], v0[3]); w.z = cvt_pk_bf16(v1[0], v1[1]); w.w = cvt_pk_bf16(v1[2], v1[3]);
                    *(u32x4*)(rowp + bj * HALF) = w;
                }
            }
        asm volatile("s_waitcnt lgkmcnt(0)" ::: "memory"); __builtin_amdgcn_s_barrier(); asm volatile("" ::: "memory");
    }
};

template <int LDSIMM, int GOFF>
__device__ __forceinline__ void glds_s(const char* sbase, unsigned voff, unsigned ldsbase) {
    asm volatile("s_add_u32 m0, %2, %3\n\ts_nop 0\n\tglobal_load_lds_dwordx4 %0, %1 offset:%4" :: "v"(voff), "s"(sbase), "s"(ldsbase), "i"(LDSIMM), "i"(GOFF) : "memory", "m0", "scc");
}
template <class Epi, bool ALIGN_EPI>
__device__ __forceinline__ void gemm_phase(LAS unsigned char* lds, const Gemm g, const Order& S, const Epi& E, const int wid) {
    int lane; asm volatile("v_mbcnt_lo_u32_b32 %0, -1, 0\n\tv_mbcnt_hi_u32_b32 %0, -1, %0" : "=v"(lane));
    const int tid = wid * 64 + lane, wr = wid >> 2, wc = wid & 3, fr = lane & 15, fq = lane >> 4;
    const int nt = g.K / BK;
    unsigned voffA[2], voffB[2];
#pragma unroll
    for (int i = 0; i < 2; ++i) { int R, C; stage_rc(tid * 16 + i * 8192, R, C); const int Rb = (R & ~31) + perm32(R & 31);
        voffA[i] = (unsigned)(R * g.lda + C) * 2u; voffB[i] = (unsigned)(Rb * g.ldb + C) * 2u; }
    const size_t kstep = (size_t)(BK * 2);
    const size_t hstepA = (size_t)HALF * g.lda * 2, hstepB = (size_t)HALF * g.ldb * 2;
    const unsigned ldsbase = (unsigned)(size_t)lds + (unsigned)wid * 1024u;
    const int aoff = lds_byte(wr * 64 + fr, fq * 8), boff = lds_byte(wc * 32 + fr, fq * 8);
#define PG8_SA(b, h) (((b) * 2 + (h)) * HTB)
#define PG8_SB(b, h) ((4 + (b) * 2 + (h)) * HTB)
#define PG8_STAGE(bufoff, gbase, voff) do { glds_s<(bufoff), 0>((const char*)(gbase), (voff)[0], ldsbase); glds_s<(bufoff) + 8192, 0>((const char*)(gbase), (voff)[1], ldsbase); } while (0)
#define PG8_LDA(dst, b, h) do { _Pragma("unroll") for (int m = 0; m < 4; ++m) _Pragma("unroll") for (int k = 0; k < 2; ++k) dst[m][k] = *(const LAS bf16x8*)(lds + PG8_SA(b, h) + aoff + m * 2048 + k * 1024); } while (0)
#define PG8_LDB(dst, b, h) do { _Pragma("unroll") for (int n = 0; n < 2; ++n) _Pragma("unroll") for (int k = 0; k < 2; ++k) dst[n][k] = *(const LAS bf16x8*)(lds + PG8_SB(b, h) + boff + n * 2048 + k * 1024); } while (0)
#define PG8_MMA(ai, bj, At, Bt) do { __builtin_amdgcn_s_setprio(1); _Pragma("unroll") for (int m = 0; m < 4; ++m) _Pragma("unroll") for (int n = 0; n < 2; ++n) _Pragma("unroll") for (int k = 0; k < 2; ++k) \
        acc[ai][bj][m][n] = __builtin_amdgcn_mfma_f32_16x16x32_bf16(Bt[n][k], At[m][k], acc[ai][bj][m][n], 0, 0, 0); __builtin_amdgcn_s_setprio(0); } while (0)
#define PG8_WAIT_V(n) asm volatile("s_waitcnt vmcnt(" #n ")" ::: "memory")
#define PG8_WAIT_L(n) asm volatile("s_waitcnt lgkmcnt(" #n ")" ::: "memory")
#define PG8_BAR __builtin_amdgcn_s_barrier()
#define PG8_SCHED __builtin_amdgcn_sched_barrier(0)
#define PG8_ABASE(u) ((const char*)(g.A + (size_t)(u).pm * g.a_pm + (size_t)(u).pn * g.a_pn))
#define PG8_BBASE(u) ((const char*)(g.Bt + (size_t)(u).pn * g.b_pn + (size_t)((u).pm >> 3) * g.b_b))
    Unit cur, nxt; int ui = 0;
    if (!S.next(0, cur)) return;
    f32x4 acc[2][2][4][2];
#pragma unroll
    for (int a = 0; a < 2; ++a)
#pragma unroll
        for (int b = 0; b < 2; ++b)
#pragma unroll
            for (int m = 0; m < 4; ++m)
#pragma unroll
                for (int n = 0; n < 2; ++n) acc[a][b][m][n] = (f32x4){0.f, 0.f, 0.f, 0.f};
    bf16x8 At[4][2], B0[2][2], B1[2][2];
    const char* cA = PG8_ABASE(cur); const char* cB = PG8_BBASE(cur);
    PG8_STAGE(PG8_SB(0, 0), cB, voffB); PG8_STAGE(PG8_SB(0, 1), cB + hstepB, voffB); PG8_STAGE(PG8_SA(0, 0), cA, voffA); PG8_STAGE(PG8_SA(0, 1), cA + hstepA, voffA);
    if (wr == 1) PG8_BAR;
    PG8_WAIT_V(2); PG8_BAR;
    PG8_STAGE(PG8_SB(1, 0), cB + kstep, voffB); PG8_STAGE(PG8_SA(1, 0), cA + kstep, voffA); PG8_STAGE(PG8_SB(1, 1), cB + hstepB + kstep, voffB);
    PG8_WAIT_V(6); PG8_BAR;
    for (;;) {
        const bool has_next = S.next(ui + 1, nxt);
        const char* nA = has_next ? PG8_ABASE(nxt) : cA; const char* nB = has_next ? PG8_BBASE(nxt) : cB;
        for (int t = 0; t < nt; t += 2) {
            const bool last = (t == nt - 2);
            const char* a1 = cA + (size_t)(t + 1) * kstep;
            const char* a2 = last ? nA : cA + (size_t)(t + 2) * kstep; const char* b2 = last ? nB : cB + (size_t)(t + 2) * kstep;
            const char* a3 = a2 + kstep; const char* b3 = b2 + kstep;
            PG8_LDB(B0, 0, 0); PG8_LDB(B1, 0, 1); PG8_SCHED; PG8_LDA(At, 0, 0); PG8_STAGE(PG8_SA(1, 1), a1 + hstepA, voffA);
            PG8_WAIT_V(8); PG8_WAIT_L(0); PG8_BAR; PG8_MMA(0, 0, At, B0); PG8_MMA(0, 1, At, B1); PG8_BAR; PG8_SCHED;
            PG8_LDA(At, 0, 1); PG8_STAGE(PG8_SB(0, 0), b2, voffB); PG8_STAGE(PG8_SB(0, 1), b2 + hstepB, voffB); PG8_STAGE(PG8_SA(0, 0), a2, voffA);
            PG8_WAIT_V(8); PG8_WAIT_L(0); PG8_BAR; PG8_MMA(1, 0, At, B0); PG8_MMA(1, 1, At, B1); PG8_BAR; PG8_SCHED;
            PG8_LDB(B0, 1, 0); PG8_LDB(B1, 1, 1); PG8_SCHED; PG8_LDA(At, 1, 0); PG8_STAGE(PG8_SA(0, 1), a2 + hstepA, voffA);
            PG8_WAIT_V(8); PG8_WAIT_L(0); PG8_BAR; PG8_MMA(0, 0, At, B0); PG8_MMA(0, 1, At, B1); PG8_BAR; PG8_SCHED;
            PG8_LDA(At, 1, 1); PG8_STAGE(PG8_SB(1, 0), b3, voffB); PG8_STAGE(PG8_SB(1, 1), b3 + hstepB, voffB); PG8_STAGE(PG8_SA(1, 0), a3, voffA);
            PG8_WAIT_V(8); PG8_WAIT_L(0); PG8_BAR; PG8_MMA(1, 0, At, B0); PG8_MMA(1, 1, At, B1); PG8_BAR; PG8_SCHED;
        }
        if constexpr (ALIGN_EPI) { if (wr == 0) PG8_BAR; }
        E(acc, cur, wid, lane);
        if (!has_next) break;
#pragma unroll
        for (int a = 0; a < 2; ++a)
#pragma unroll
            for (int b = 0; b < 2; ++b)
#pragma unroll
                for (int m = 0; m < 4; ++m)
#pragma unroll
                    for (int n = 0; n < 2; ++n) acc[a][b][m][n] = (f32x4){0.f, 0.f, 0.f, 0.f};
        cur = nxt; cA = nA; cB = nB; ++ui;
        if constexpr (ALIGN_EPI) { if (wr == 1) PG8_BAR; }
    }
    PG8_WAIT_V(0);
    if constexpr (!ALIGN_EPI) { if (wr == 0) PG8_BAR; }
    PG8_BAR;
#undef PG8_SA
#undef PG8_SB
#undef PG8_STAGE
#undef PG8_LDA
#undef PG8_LDB
#undef PG8_MMA
#undef PG8_WAIT_V
#undef PG8_WAIT_L
#undef PG8_BAR
#undef PG8_SCHED
#undef PG8_ABASE
#undef PG8_BBASE
}
}

struct TrItem { const float* W; int ldw, src_n0, k0; bf16_t* WT; int ldt, dst_n0; const float* rs; const float* cs; };
__device__ __forceinline__ void tr_load(const TrItem& d, float (&v)[32], int lane) {
    const float* wp = d.W + (size_t)(d.k0 + (lane >> 5)) * d.ldw + d.src_n0 + (lane & 31);
#pragma unroll
    for (int i = 0; i < 32; ++i) v[i] = __builtin_nontemporal_load(wp + (size_t)(2 * i) * d.ldw);
}
__device__ __forceinline__ void tr_finish(const TrItem& d, const float (&v)[32], LAS float* scr, int lane) {
    const float csv = d.cs ? d.cs[d.src_n0 + (lane & 31)] : 1.0f;
#pragma unroll
    for (int i = 0; i < 32; ++i) { const int kk = 2 * i + (lane >> 5); float t = v[i]; if (d.rs) t *= d.rs[d.k0 + kk]; scr[kk * 33 + (lane & 31)] = t * csv; }
    asm volatile("s_waitcnt lgkmcnt(0)" ::: "memory");
    const int c = lane & 7;
#pragma unroll
    for (int j = 0; j < 4; ++j) { const int n = (lane >> 3) + 8 * j; const LAS float* s = scr + (8 * c) * 33 + n;
        u32x4 o; o.x = cvt_pk_bf16(s[0 * 33], s[1 * 33]); o.y = cvt_pk_bf16(s[2 * 33], s[3 * 33]); o.z = cvt_pk_bf16(s[4 * 33], s[5 * 33]); o.w = cvt_pk_bf16(s[6 * 33], s[7 * 33]);
        *(u32x4*)(d.WT + (size_t)(d.dst_n0 + n) * d.ldt + d.k0 + 8 * c) = o; }
    asm volatile("s_waitcnt lgkmcnt(0)" ::: "memory");
}
__device__ __forceinline__ bool conv_mat(int& r, const float* W, int K, int N, bf16_t* WT, const float* rs, const float* cs, bool glu, TrItem& d) {
    const int nblk = N / 32, items = (K / 64) * nblk;
    if (r >= items) { r -= items; return false; }
    const int kb = r / nblk, nb = r % nblk, n0 = nb * 32;
    d.W = W; d.ldw = N; d.src_n0 = glu ? ((n0 >> 8) * 128 + (n0 & 127) + ((n0 >> 7) & 1) * D) : n0; d.k0 = kb * 64; d.WT = WT; d.ldt = K; d.dst_n0 = n0; d.rs = rs; d.cs = cs;
    return true;
}

struct Args { const float* in[23]; float* out; unsigned char* ws; int lo, hi; };
typedef LAS const unsigned long long* PtrTab;
__device__ __forceinline__ const float* inptr(PtrTab tab, int k) {
    const unsigned long long v = tab[k];
    typedef const float __attribute__((address_space(1)))* GPF;
    return (const float*)(GPF)(((unsigned long long)(unsigned)__builtin_amdgcn_readfirstlane((int)(v >> 32)) << 32) | (unsigned long long)(unsigned)__builtin_amdgcn_readfirstlane((int)v));
}
#define INP(k) inptr(tab, (k))

__device__ __forceinline__ void decode_item(PtrTab tab, unsigned char* ws_, int i, int it, TrItem& d) {
    int r = it;
    if (i < 0) { constexpr int I1 = (D / 64) * (D / 32); const int mtx = it / I1, l = mtx & 3; r = it % I1;
        conv_mat(r, (mtx < 4 ? INP(17) : INP(18)) + (size_t)l * D * D, D, D, (bf16_t*)(ws_ + (mtx < 4 ? WS_WKT : WS_WVT)) + (size_t)l * D * D, nullptr, nullptr, false, d); return; }
    unsigned char* lw = ws_ + WS_LW + (size_t)(i & 1) * LW_SET; const int j = i >> 1;
    if (!(i & 1)) {
        if (conv_mat(r, INP(6) + (size_t)j * D * 2 * D, D, 2 * D, (bf16_t*)(lw + LW_WIN), INP(3) + i * D, nullptr, true, d)) return;
        if (conv_mat(r, INP(12) + (size_t)j * D * D, D, D, (bf16_t*)(lw + LW_WOUT), nullptr, nullptr, false, d)) return;
    } else {
        const int g = r >> 5;
        if (g < 4) { r &= 31; conv_mat(r, INP(14) + ((size_t)j * 4 + g) * 65536, 256, 256, (bf16_t*)(lw + LW_WIN) + (size_t)g * 65536, nullptr, INP(15) + j * D + g * 256, false, d); return; }
        r -= 128;
    }
    if (conv_mat(r, INP(16) + (size_t)i * D * D, D, D, (bf16_t*)(lw + LW_WQ), INP(4) + i * D, nullptr, false, d)) return;
    if (conv_mat(r, INP(19) + (size_t)i * D * D, D, D, (bf16_t*)(lw + LW_WO), nullptr, nullptr, false, d)) return;
    if (conv_mat(r, INP(20) + (size_t)i * D * FF, D, FF, (bf16_t*)(lw + LW_W1), INP(5) + i * D, nullptr, false, d)) return;
    conv_mat(r, INP(21) + (size_t)i * FF * D, FF, D, (bf16_t*)(lw + LW_W2), nullptr, nullptr, false, d);
}
__device__ __forceinline__ void convert_job(PtrTab tab, unsigned char* ws_, int i, LAS float* scr, int gw, int NGW, int lane) {
    const int I_MIX = !(i & 1) ? (D / 64) * (2 * D / 32) + (D / 64) * (D / 32) : 4 * (256 / 64) * (256 / 32);
    const int NITEMS = (i < 0) ? 8 * (D / 64) * (D / 32) : I_MIX + 2 * (D / 64) * (D / 32) + 2 * (D / 64) * (FF / 32);
    int it = gw; if (it >= NITEMS) return;
    TrItem d0; float v0[32];
    decode_item(tab, ws_, i, it, d0); tr_load(d0, v0, lane);
    for (;;) {
        const int it2 = it + NGW; const bool has = it2 < NITEMS;
        TrItem d1; float v1[32];
        if (has) { decode_item(tab, ws_, i, it2, d1); tr_load(d1, v1, lane); }
        tr_finish(d0, v0, scr, lane);
        if (!has) break;
        d0 = d1; it = it2;
#pragma unroll
        for (int q = 0; q < 32; ++q) v0[q] = v1[q];
    }
}

__device__ __forceinline__ void dw_phase(const bf16_t* GLU, bf16_t* V, const float* wdw, const float* bdw, const float* lng, const float* lnb, LAS float* red, int bid, int G, int wave) {
    int laneA; asm volatile("v_mbcnt_lo_u32_b32 %0, -1, 0\n\tv_mbcnt_hi_u32_b32 %0, -1, %0" : "=v"(laneA));
    const int tid = wave * 64 + laneA;
    f32x2 wk[CW];
#pragma unroll
    for (int k = 0; k < CW; ++k) wk[k] = *(const f32x2*)(wdw + k * D + 2 * tid);
    const f32x2 bd = *(const f32x2*)(bdw + 2 * tid), lg = *(const f32x2*)(lng + 2 * tid), lb = *(const f32x2*)(lnb + 2 * tid);
    const unsigned* G32 = (const unsigned*)GLU; unsigned* V32 = (unsigned*)V;
    LAS f32x2* part = (LAS f32x2*)red;
    LAS f32x2* stat = (LAS f32x2*)(red + 1024);
    const int ustart = (G == 256) ? (bid & 7) * 128 + (bid >> 3) * 4 : bid, ustep = (G == 256) ? 1 : G, uend = (G == 256) ? ustart + 4 : M / 16;
    unsigned raw[46];
    if (ustart < uend) { const int t0 = (ustart & 127) * 16; int vb = (ustart * 16 - 30) * 512 + tid; asm volatile("" : "+v"(vb));
#pragma unroll
        for (int r = 0; r < 46; ++r) raw[r] = (t0 - 30 + r >= 0) ? G32[vb + r * 512] : 0u; }
    for (int unit = ustart; unit < uend; unit += ustep) {
        const int t0 = (unit & 127) * 16, rowbase = unit * 16;
        f32x2 win[46];
#pragma unroll
        for (int r = 0; r < 46; ++r) win[r] = (f32x2){bf_lo(raw[r]), bf_hi(raw[r])};
        f32x2 o[16];
#pragma unroll
        for (int t = 0; t < 16; ++t) { f32x2 a = bd;
#pragma unroll
            for (int k = 0; k < CW; ++k) a = __builtin_elementwise_fma(wk[k], win[t + k], a);
            o[t] = a; }
        if (unit + ustep < uend) { const int nu = unit + ustep, nt0 = (nu & 127) * 16; int vb = (nu * 16 - 30) * 512 + tid; asm volatile("" : "+v"(vb));
#pragma unroll
            for (int r = 0; r < 46; ++r) raw[r] = (nt0 - 30 + r >= 0) ? G32[vb + r * 512] : 0u; }
        int lane; asm volatile("v_mbcnt_lo_u32_b32 %0, -1, 0\n\tv_mbcnt_hi_u32_b32 %0, -1, %0" : "=v"(lane)); const int tidB = wave * 64 + lane;
#pragma unroll
        for (int t = 0; t < 16; ++t) {
            const float s1 = row_sum_dpp(o[t].x + o[t].y), s2 = row_sum_dpp(o[t].x * o[t].x + o[t].y * o[t].y);
            if ((lane & 15) == 0) part[(wave * 4 + (lane >> 4)) * 16 + t] = (f32x2){s1, s2};
        }
        asm volatile("s_waitcnt lgkmcnt(0)" ::: "memory"); __builtin_amdgcn_s_barrier(); asm volatile("" ::: "memory");
        if (tidB < 16) { float s1 = 0.f, s2 = 0.f;
#pragma unroll
            for (int w = 0; w < 32; ++w) { const f32x2 p = part[w * 16 + tidB]; s1 += p.x; s2 += p.y; }
            const float mean = s1 * (1.0f / D), var = fmaxf(s2 * (1.0f / D) - mean * mean, 0.f);
            stat[tidB] = (f32x2){mean, rsqrtf(var + LN_EPS)}; }
        asm volatile("s_waitcnt lgkmcnt(0)" ::: "memory"); __builtin_amdgcn_s_barrier(); asm volatile("" ::: "memory");
#pragma unroll
        for (int t = 0; t < 16; ++t) {
            const f32x2 st = stat[t];
            float y0 = (o[t].x - st.x) * st.y * lg.x + lb.x, y1 = (o[t].y - st.x) * st.y * lg.y + lb.y;
            y0 = y0 * __builtin_amdgcn_rcpf(1.0f + __builtin_amdgcn_exp2f(-y0 * LOG2E)); y1 = y1 * __builtin_amdgcn_rcpf(1.0f + __builtin_amdgcn_exp2f(-y1 * LOG2E));
            V32[(size_t)(rowbase + t) * 512 + tidB] = cvt_pk_bf16(y0, y1);
        }
        asm volatile("s_waitcnt lgkmcnt(0)" ::: "memory"); __builtin_amdgcn_s_barrier(); asm volatile("" ::: "memory");
    }
}

__device__ __forceinline__ float bcast_lane(float v, int k) { return __int_as_float(__builtin_amdgcn_readlane(__float_as_int(v), k)); }
template <int W>
__device__ __forceinline__ void pl_span(const bf16_t* XBs, const u64* ssq, bf16_t* PP, int unit0, int nsub, int tid, int lane, f32x2 g) {
    const unsigned* X32 = (const unsigned*)XBs; unsigned* P32 = (unsigned*)PP;
    const int t0 = (unit0 & 127) * 16, rowbase = unit0 * 16;
    const bool first = (t0 == 0);
    int vb = rowbase * 512 + tid; asm volatile("" : "+v"(vb));
    unsigned xh[W - 1], xc[16];
#pragma unroll
    for (int j = 0; j < W - 1; ++j) xh[j] = X32[vb + (first ? 0 : (j - (W - 1))) * 512];
    const int l5 = lane & 31;
    u64 q = ssq[rowbase + (l5 < 16 ? l5 : (first ? 0 : l5 - 32))];
#pragma unroll
    for (int j = 0; j < 16; ++j) xc[j] = X32[vb + j * 512];
    float rsl = rstd_of(q);
    f32x2 hist[W - 1]; f32x2 S = (f32x2){0.f, 0.f};
#pragma unroll
    for (int j = 0; j < W - 1; ++j) { const float r0 = bcast_lane(rsl, 32 - (W - 1) + j), rs = first ? 0.f : r0; hist[j] = (f32x2){bf_lo(xh[j]) * rs, bf_hi(xh[j]) * rs}; S += hist[j]; }
    constexpr float INVW = 1.0f / (float)W;
    for (int c = 0; c < nsub; ++c) {
        const bool more = (c + 1 < nsub);
        f32x2 ext[W - 1 + 16];
#pragma unroll
        for (int j = 0; j < W - 1; ++j) ext[j] = hist[j];
#pragma unroll
        for (int j = 0; j < 16; ++j) { const float rs = bcast_lane(rsl, j); ext[W - 1 + j] = (f32x2){bf_lo(xc[j]) * rs, bf_hi(xc[j]) * rs}; }
        const bool head = first && c == 0;
#pragma unroll
        for (int j = 0; j < 16; ++j) {
            S += ext[W - 1 + j];
            const float inv = head ? (1.0f / (float)((j + 1 < W) ? j + 1 : W)) : INVW;
            const f32x2 p = (S * inv - ext[W - 1 + j]) * g;
            P32[vb + (16 * c + j) * 512] = cvt_pk_bf16(p.x, p.y);
            S -= ext[j];
        }
#pragma unroll
        for (int j = 0; j < W - 1; ++j) hist[j] = ext[16 + j];
        if (more) {
#pragma unroll
            for (int j = 0; j < 16; ++j) xc[j] = X32[vb + (16 * (c + 1) + j) * 512];
            rsl = rstd_of(ssq[rowbase + 16 * (c + 1) + (lane & 15)]);
        }
    }
}
__device__ __forceinline__ void pl_phase(const bf16_t* X, const u64* ssq, const float* gain, bf16_t* PP, int bid, int G, int wave) {
    int lane; asm volatile("v_mbcnt_lo_u32_b32 %0, -1, 0\n\tv_mbcnt_hi_u32_b32 %0, -1, %0" : "=v"(lane)); const int tid = wave * 64 + lane;
    const f32x2 g = *(const f32x2*)(gain + 2 * tid); const int grp = wave >> 1;
    const int ustart = (G == 256) ? (bid & 7) * 128 + (bid >> 3) * 4 : bid, ustep = (G == 256) ? 4 : G, uend = (G == 256) ? ustart + 4 : M / 16, nsub = (G == 256) ? 4 : 1;
    for (int unit = ustart; unit < uend; unit += ustep) {
        if (grp == 0) pl_span<2>(X, ssq, PP, unit, nsub, tid, lane, g);
        else if (grp == 1) pl_span<4>(X, ssq, PP, unit, nsub, tid, lane, g);
        else if (grp == 2) pl_span<8>(X, ssq, PP, unit, nsub, tid, lane, g);
        else pl_span<16>(X, ssq, PP, unit, nsub, tid, lane, g);
    }
}

#define XB_TMO      128
#define XB_XCNT(j)  (256  + 64 * (j))
#define XB_XSUB(j)  (1280 + 64 * (j))
#define XB_XGEN(j)  (2304 + 64 * (j))
#define XB_TOP      3328
#define XB_TOPGEN   3392
#define XB_LSUB(j)  (3456 + 64 * (j))
#define XB_LGEN(j)  (4480 + 64 * (j))
#define XB_GMASK(j) (5504 + (j))
#define XCD_BAR_WORDS 5632
#define XB_SPIN_CAP (1u << 18)
__device__ __forceinline__ unsigned xb_ld(unsigned* p)              { return __hip_atomic_load(p, __ATOMIC_RELAXED, __HIP_MEMORY_SCOPE_AGENT); }
__device__ __forceinline__ unsigned xb_add(unsigned* p, unsigned v) { return __hip_atomic_fetch_add(p, v, __ATOMIC_RELAXED, __HIP_MEMORY_SCOPE_AGENT); }
__device__ __forceinline__ unsigned xb_xcc_id() { return (unsigned)__builtin_amdgcn_s_getreg((3 << 11) | 20) & 0xFu; }
#define XB_SPIN(cond, bar) do { unsigned _sp = 0; while (cond) { __builtin_amdgcn_s_sleep(1); \
    if ((++_sp & 255u) == 0u) { if (xb_ld(&(bar)[XB_TMO])) break; if (_sp > XB_SPIN_CAP) { atomicAdd(&(bar)[XB_TMO], 1u); break; } } } } while (0)
struct XcdBarrier { unsigned* bar; unsigned x; volatile LAS unsigned* st; };
__device__ __forceinline__ void xcd_barrier_complete(unsigned* bar, unsigned x, unsigned& nloc, unsigned& nx) {
    const unsigned G = gridDim.x * gridDim.y * gridDim.z;
    unsigned sum, cnt, mine, sp = 0u;
    for (;;) {
        sum = 0u; cnt = 0u; mine = 0u;
#pragma unroll
        for (unsigned j = 0; j < 16; ++j) { const unsigned c = xb_ld(&bar[XB_XCNT(j)]); sum += c; cnt += (c > 0u) ? 1u : 0u; mine = (j == x) ? c : mine; }
        if (sum == G) break;
        __builtin_amdgcn_s_sleep(1);
        if ((++sp & 255u) == 0u) { if (xb_ld(&bar[XB_TMO])) break; if (sp > XB_SPIN_CAP) { atomicAdd(&bar[XB_TMO], 1u); break; } }
    }
    nloc = mine > 0u ? mine : 1u; nx = cnt > 0u ? cnt : 1u;
}
__device__ __forceinline__ void xcd_barrier(unsigned* bar_, volatile LAS unsigned* st_) {
    XcdBarrier b; b.bar = bar_; b.st = st_; b.x = xb_xcc_id();
    asm volatile("s_waitcnt vmcnt(0)" ::: "memory");
    __syncthreads();
    if (threadIdx.x == 0) {
        unsigned* bar = b.bar;
        __builtin_amdgcn_s_waitcnt(0);
        unsigned nloc = b.st[0], nx = b.st[1];
        if (nloc == 0u) { xcd_barrier_complete(bar, b.x, nloc, nx); b.st[0] = nloc; b.st[1] = nx; }
        const unsigned old = xb_add(&bar[XB_XSUB(b.x)], 1u);
        const unsigned gen = old / nloc;
        if (old + 1u == (gen + 1u) * nloc) {
            __builtin_amdgcn_fence(__ATOMIC_RELEASE, "agent");
            asm volatile("s_waitcnt vmcnt(0)" ::: "memory");
            const unsigned og = xb_add(&bar[XB_TOP], 1u);
            const unsigned tg = og / nx;
            if (og + 1u == (tg + 1u) * nx) xb_add(&bar[XB_TOPGEN], 1u);
            else XB_SPIN(xb_ld(&bar[XB_TOPGEN]) == tg, bar);
            __builtin_amdgcn_fence(__ATOMIC_ACQUIRE, "agent");
            xb_add(&bar[XB_XGEN(b.x)], 1u);
            asm volatile("s_waitcnt vmcnt(0)" ::: "memory");
        } else {
            XB_SPIN(xb_ld(&bar[XB_XGEN(b.x)]) == gen, bar);
            __builtin_amdgcn_fence(__ATOMIC_ACQUIRE, "agent");
            asm volatile("s_waitcnt vmcnt(0)" ::: "memory");
        }
    }
    __syncthreads();
}

__device__ __forceinline__ void xcd_local_barrier(unsigned* bar, unsigned grp, unsigned nloc) {
    asm volatile("s_waitcnt vmcnt(0)" ::: "memory");
    __syncthreads();
    if (threadIdx.x == 0) {
        __builtin_amdgcn_s_waitcnt(0);
        const unsigned old = xb_add(&bar[XB_LSUB(grp)], 1u);
        const unsigned gen = old / nloc;
        if (old + 1u == (gen + 1u) * nloc) xb_add(&bar[XB_LGEN(grp)], 1u);
        else XB_SPIN(xb_ld(&bar[XB_LGEN(grp)]) == gen, bar);
        __builtin_amdgcn_fence(__ATOMIC_ACQUIRE, "agent");
        asm volatile("s_waitcnt vmcnt(0)" ::: "memory");
    }
    __syncthreads();
}

enum { K_PRO = 0, K_KV, K_G1, K_DW, K_G2, K_PL, K_GP, K_GQ, K_S, K_PV, K_WO, K_UP, K_DOWN, K_FINAL };
constexpr int N_PHASES = 2 + 2 * 17 + 1;
__host__ __device__ __forceinline__ void decode_phase(int ph, int& kind, int& layer) {
    if (ph == 0) { kind = K_PRO; layer = 0; return; }
    if (ph == 1) { kind = K_KV; layer = 0; return; }
    if (ph == N_PHASES - 1) { kind = K_FINAL; layer = 0; return; }
    const int q = ph - 2, pair = q / 17, r = q % 17;
    if (r < 9) { layer = 2 * pair; kind = (r < 3) ? (K_G1 + r) : (K_GQ + (r - 3)); }
    else { layer = 2 * pair + 1; const int s = r - 9; kind = (s < 2) ? (K_PL + s) : (K_GQ + (s - 2)); }
}

__global__ void __launch_bounds__(512, 2) fwd_megakernel(Args args) {
    extern __shared__ __attribute__((aligned(16))) unsigned char lds_raw[];
    LAS unsigned char* lds = (LAS unsigned char*)lds_raw;
    const int G0 = gridDim.x, bid0 = blockIdx.x, bid = bid0;
    const int wave_s = __builtin_amdgcn_readfirstlane(threadIdx.x >> 6);
    unsigned char* ws = args.ws;
    u64* SSQ = (u64*)(ws + WS_SSQ);
    float* X = args.out;
    bf16_t* XB = (bf16_t*)(ws + WS_XB);
    bf16_t* KALL = (bf16_t*)(ws + WS_KALL); bf16_t* VT = (bf16_t*)(ws + WS_VT);
    bf16_t* S0 = (bf16_t*)(ws + WS_S0); bf16_t* S1 = (bf16_t*)(ws + WS_S1); bf16_t* S2 = (bf16_t*)(ws + WS_S2); bf16_t* HM = (bf16_t*)(ws + WS_H);
    LAS float* exf = (LAS float*)(lds + EX_OFF);
    if (threadIdx.x < 4) ((volatile LAS unsigned*)(lds + BARST_OFF))[threadIdx.x] = 0u;
    if (threadIdx.x == 0) {
#pragma unroll
        for (int k = 0; k < 23; ++k) ((LAS unsigned long long*)(lds + PTAB_OFF))[k] = (unsigned long long)args.in[k];
    }
    __syncthreads();
    PtrTab tab = (PtrTab)(lds + PTAB_OFF);
    if (threadIdx.x == 0) {
        unsigned* bar0 = (unsigned*)(args.ws + WS_BAR); const unsigned x = xb_xcc_id();
        (void)xb_add(bar0 + XB_XCNT(x), 1u); (void)__hip_atomic_fetch_or(bar0 + XB_GMASK(bid & 7), 1u << x, __ATOMIC_RELAXED, __HIP_MEMORY_SCOPE_AGENT);
    }
    if (args.lo < 0) cg::this_grid().sync();

#pragma unroll 1
    for (int ph = args.lo; ph < args.hi; ++ph) {
        int G = G0, bid = bid0, wave = wave_s; asm volatile("" : "+s"(G), "+s"(bid), "+s"(wave));
        const int gw = bid * 8 + wave, NGW = G * 8;
        LAS float* scr = (LAS float*)(lds + wave * 16384);
        int kind, i; decode_phase(ph, kind, i);
        if (ph >= LAST_PH && ph < N_PHASES - 1) kind = -1;
        const int j = i >> 1;
        unsigned char* lw = ws + WS_LW + (size_t)(i & 1) * LW_SET;
        switch (kind) {
        case K_PRO: {
            int lane; asm volatile("v_mbcnt_lo_u32_b32 %0, -1, 0\n\tv_mbcnt_hi_u32_b32 %0, -1, %0" : "=v"(lane)); const int tid = wave * 64 + lane; (void)tid;
            { unsigned z = 0u; asm volatile("" : "+v"(z));
              for (int u = bid * 512 + tid; u < 12 * M / 2; u += G * 512) ((u32x4*)(SSQ + M))[u] = (u32x4){z, z, z, z}; }
            convert_job(tab, ws, -1, scr, gw, NGW, lane);
            for (int m = gw; m < MEMR; m += NGW) {
                const f32x4* xr = (const f32x4*)(INP(1) + (size_t)m * D) + lane; f32x4 v[4]; float s = 0.f;
#pragma unroll
                for (int q = 0; q < 4; ++q) { v[q] = __builtin_nontemporal_load(xr + 64 * q); s += (v[q].x * v[q].x + v[q].y * v[q].y) + (v[q].z * v[q].z + v[q].w * v[q].w); }
                const float rs = rsqrtf(wave_sum(s, lane) * (1.0f / D) + RMS_EPS);
                u32x2* o8 = (u32x2*)((bf16_t*)(ws + WS_MEMN) + (size_t)m * D) + lane;
#pragma unroll
                for (int q = 0; q < 4; ++q) { const f32x4 gq = ((const f32x4*)INP(2))[lane + 64 * q]; u32x2 w; w.x = cvt_pk_bf16(v[q].x * rs * gq.x, v[q].y * rs * gq.y); w.y = cvt_pk_bf16(v[q].z * rs * gq.z, v[q].w * rs * gq.w); o8[64 * q] = w; }
            }
            const int m0 = (G == 256) ? (bid & 7) * SEQ + (bid >> 3) * 8 + wave : gw, mstep = (G == 256) ? 256 : NGW, mend = (G == 256) ? ((bid & 7) + 1) * SEQ : M;
            for (int m = m0; m < mend; m += mstep) {
                const f32x4* xr = (const f32x4*)(INP(0) + (size_t)m * D) + lane; f32x4 v[4]; float s = 0.f;
                u32x2* o8 = (u32x2*)(XB + (size_t)m * D) + lane;
#pragma unroll
                for (int q = 0; q < 4; ++q) { v[q] = __builtin_nontemporal_load(xr + 64 * q); u32x2 w; w.x = cvt_pk_bf16(v[q].x, v[q].y); w.y = cvt_pk_bf16(v[q].z, v[q].w); o8[64 * q] = w;
                    const float a = bf_lo(w.x), b = bf_hi(w.x), c = bf_lo(w.y), d = bf_hi(w.y); s += (a * a + b * b) + (c * c + d * d); }
                s = wave_sum(s, lane);
                if (lane == 0) SSQ[m] = (u64)(s * SSQ_SCALE);
            }
            convert_job(tab, ws, 0, scr, gw, NGW, lane);
        } break;
        case K_KV: {
            {
                pg8::Gemm g{(const bf16_t*)(ws + WS_MEMN), (const bf16_t*)(ws + WS_WKT), D, D, D, 256L * D, 0, 256L * D, 0};
                pg8::Order S; S.init(MEMR / 256, 4 * D / 256, G, bid);
                pg8::EpiBf E{KALL, 4 * D, nullptr, 1.0f, 0};
                pg8::gemm_phase<pg8::EpiBf, true>(lds, g, S, E, wave);
            }
            {
                pg8::Gemm g{(const bf16_t*)(ws + WS_WVT), (const bf16_t*)(ws + WS_MEMN), D, D, D, 256L * D, 0, 256L * D, 0};
                pg8::Order S; S.init(4 * D / 256, MEMR / 256, G, (bid + G / 2) % G);
                pg8::EpiBf E{VT, MEMR, nullptr, 1.0f, 0};
                pg8::gemm_phase<pg8::EpiBf, true>(lds, g, S, E, wave);
            }
        } break;
        case K_G1: {
            pg8::Gemm g{XB, (const bf16_t*)(lw + LW_WIN), D, D, D, 256L * D, 0, 256L * D, 0};
            pg8::Order S; S.init(M / 256, 2 * D / 256, G, bid);
            pg8::EpiGlu E{S0, INP(7) + j * 2 * D, SSQ + (size_t)(3 * i) * M};
            pg8::gemm_phase<pg8::EpiGlu, true>(lds, g, S, E, wave);
        } break;
        case K_DW: {
            dw_phase(S0, S1, INP(8) + (size_t)j * CW * D, INP(9) + j * D, INP(10) + j * D, INP(11) + j * D, exf, bid, G, wave);
        } break;
        case K_PL: {
            pl_phase(XB, SSQ + (size_t)(3 * i) * M, INP(3) + i * D, S0, bid, G, wave);
        } break;
        case K_G2: case K_GP: case K_WO: case K_DOWN: {
            pg8::Gemm g; pg8::EpiRes E; E.xb = XB; E.bias = nullptr;
            if (kind == K_G2) { g = pg8::Gemm{S1, (const bf16_t*)(lw + LW_WOUT), D, D, D, 256L * D, 0, 256L * D, 0}; E.bias = INP(13) + j * D; E.ssq_next = SSQ + (size_t)(3 * i + 1) * M; }
            else if (kind == K_GP) { g = pg8::Gemm{S0, (const bf16_t*)(lw + LW_WIN), D, 256, 256, 256L * D, 256, 65536, 0}; E.ssq_next = SSQ + (size_t)(3 * i + 1) * M; }
            else if (kind == K_WO) { g = pg8::Gemm{S2, (const bf16_t*)(lw + LW_WO), D, D, D, 256L * D, 0, 256L * D, 0}; E.ssq_next = SSQ + (size_t)(3 * i + 2) * M; }
            else { g = pg8::Gemm{HM, (const bf16_t*)(lw + LW_W2), FF, FF, FF, 256L * FF, 0, 256L * FF, 0}; E.ssq_next = SSQ + (size_t)(3 * i + 3) * M; }
            pg8::Order S; S.init(M / 256, D / 256, G, bid);
            pg8::gemm_phase<pg8::EpiRes, true>(lds, g, S, E, wave);
        } break;
        case K_GQ: case K_UP: case K_PV: {
            pg8::Gemm g; pg8::EpiBf E; int nN = D / 256;
            if (kind == K_GQ) { g = pg8::Gemm{XB, (const bf16_t*)(lw + LW_WQ), D, D, D, 256L * D, 0, 256L * D, 0}; E = pg8::EpiBf{S0, D, SSQ + (size_t)(3 * i + 1) * M, 0.0625f, 0}; }
            else if (kind == K_UP) { g = pg8::Gemm{XB, (const bf16_t*)(lw + LW_W1), D, D, D, 256L * D, 0, 256L * D, 0}; E = pg8::EpiBf{HM, FF, SSQ + (size_t)(3 * i + 2) * M, 1.0f, 1}; nN = FF / 256; }
            else { g = pg8::Gemm{S1, VT + (size_t)i * D * MEMR, D, MEMR, 256, 256L * D, 256, 256L * MEMR, 256}; E = pg8::EpiBf{S2, D, nullptr, 1.0f, 0}; }
            pg8::Order S; S.init(M / 256, nN, G, bid);
            pg8::gemm_phase<pg8::EpiBf, true>(lds, g, S, E, wave);
            if (kind == K_PV && i + 1 < 4) { int lane2; asm volatile("v_mbcnt_lo_u32_b32 %0, -1, 0\n\tv_mbcnt_hi_u32_b32 %0, -1, %0" : "=v"(lane2));
                convert_job(tab, ws, i + 1, scr, gw, NGW, lane2); }
        } break;
        case K_S: {
            pg8::Gemm g{S0, KALL + (size_t)i * D, D, 4 * D, 256, 256L * D, 256, 256, 256L * 4 * D};
            pg8::Order S; S.init(M / 256, D / 256, G, bid);
            pg8::EpiSoftmax E{S1, (LAS f32x2*)exf};
            pg8::gemm_phase<pg8::EpiSoftmax, true>(lds, g, S, E, wave);
        } break;
        case K_FINAL: {
            int lane; asm volatile("v_mbcnt_lo_u32_b32 %0, -1, 0\n\tv_mbcnt_hi_u32_b32 %0, -1, %0" : "=v"(lane)); const int tid = wave * 64 + lane; (void)tid;
            const int m0 = (G == 256) ? (bid & 7) * SEQ + (bid >> 3) * 8 + wave : gw, mstep = (G == 256) ? 256 : NGW, mend = (G == 256) ? ((bid & 7) + 1) * SEQ : M;
            for (int m = m0; m < mend; m += mstep) {
                f32x4* xr = (f32x4*)(X + (size_t)m * D) + lane; const u32x2* xi = (const u32x2*)(XB + (size_t)m * D) + lane; f32x4 v[4]; float s = 0.f;
#pragma unroll
                for (int q = 0; q < 4; ++q) { const u32x2 w = xi[64 * q]; v[q] = (f32x4){bf_lo(w.x), bf_hi(w.x), bf_lo(w.y), bf_hi(w.y)}; s += (v[q].x * v[q].x + v[q].y * v[q].y) + (v[q].z * v[q].z + v[q].w * v[q].w); }
                const float rs = rsqrtf(wave_sum(s, lane) * (1.0f / D) + RMS_EPS);
#pragma unroll
                for (int q = 0; q < 4; ++q) { const f32x4 gq = ((const f32x4*)INP(22))[lane + 64 * q]; f32x4 o = v[q] * rs; o.x *= gq.x; o.y *= gq.y; o.z *= gq.z; o.w *= gq.w; __builtin_nontemporal_store(o, xr + 64 * q); }
            }
        } break;
        }
        if (ph + 1 < args.hi) {
            unsigned* bar = (unsigned*)(args.ws + WS_BAR); volatile LAS unsigned* st = (volatile LAS unsigned*)(lds + BARST_OFF);
            if (kind == K_GQ || kind == K_S) {
                asm volatile("s_waitcnt vmcnt(0)" ::: "memory"); __syncthreads();
                if (threadIdx.x == 0) { __builtin_amdgcn_fence(__ATOMIC_ACQUIRE, "agent"); asm volatile("s_waitcnt vmcnt(0)" ::: "memory"); }
                __syncthreads();
            } else if (ph <= 1 || (kind == K_DOWN && i < 3) || st[2] != 1u) {
                xcd_barrier(bar, st);
                if (ph == 1) {
                    if (threadIdx.x == 0) { bool pure = (G == 256 && st[0] == 32u && st[1] == 8u);
#pragma unroll
                        for (int g8 = 0; g8 < 8; ++g8) pure = pure && (__builtin_popcount(xb_ld(bar + XB_GMASK(g8))) == 1);
                        st[2] = (pure && !FORCE_FALLBACK) ? 1u : 2u; }
                    __syncthreads();
                }
            } else xcd_local_barrier(bar, (unsigned)(bid & 7), 32u);
        }
    }
}

extern "C" void kernel_launch(void* const* d_in, const int* in_sizes, int n_in, void* d_out, int out_size, void* d_ws, size_t ws_size, hipStream_t stream) {
    static int grid = 0;
    if (grid == 0) {
        if (n_in != 23 || out_size != M * D || ws_size < WS_END) { fprintf(stderr, "kernel_launch: unexpected problem (n_in %d out %d ws %zu)\n", n_in, out_size, ws_size); grid = -1; return; }
        int dev = 0, cus = 0, per_cu = 0;
        hipGetDevice(&dev); hipDeviceGetAttribute(&cus, hipDeviceAttributeMultiprocessorCount, dev);
        hipFuncSetAttribute((const void*)fwd_megakernel, hipFuncAttributeMaxDynamicSharedMemorySize, LDS_BYTES);
        if (hipOccupancyMaxActiveBlocksPerMultiprocessor(&per_cu, (const void*)fwd_megakernel, 512, LDS_BYTES) != hipSuccess || per_cu < 1) { fprintf(stderr, "kernel_launch: occupancy query gave %d\n", per_cu); per_cu = 1; }
        (void)hipGetLastError();
        grid = cus * per_cu;
    }
    if (grid < 0) return;
    (void)hipMemsetAsync((unsigned char*)d_ws + WS_BAR, 0, XCD_BAR_WORDS * 4, stream);
    Args a{};
    for (int i = 0; i < 23; ++i) a.in[i] = (const float*)d_in[i];
    a.out = (float*)d_out; a.ws = (unsigned char*)d_ws;
#if MK_PER_PHASE
    for (int ph = 0; ph < N_PHASES; ++ph) { a.lo = ph; a.hi = ph + 1; hipLaunchKernelGGL(fwd_megakernel, dim3(grid), dim3(512), LDS_BYTES, stream, a); }
#else
    a.lo = 0; a.hi = N_PHASES;
    void* kargs[] = {&a};
    hipError_t e = hipLaunchCooperativeKernel((const void*)fwd_megakernel, dim3(grid), dim3(512), kargs, LDS_BYTES, stream);
    if (e != hipSuccess) fprintf(stderr, "cooperative launch failed: %s (grid %d)\n", hipGetErrorString(e), grid);
#endif
}
```
